# Optimizing an MI355X kernel written in HIP

```python
import math
import jax, jax.numpy as jnp
from jax import lax
import numpy as np

D_MODEL = 1024
BATCH = 8
SEQ = 2048
DEPTH = 2

D_MIX = D_MODEL
ATTN_HEADS = 8
HEAD_DIM = 64
ATTN_WIDTH = ATTN_HEADS * HEAD_DIM
SSD_HEADS = 8
SSD_HEAD_DIM = 64
SSD_WIDTH = SSD_HEADS * SSD_HEAD_DIM
SSD_GROUPS = 2
SSD_STATE = 128
CONV_K = 4
CHUNK = 128
Q_BLOCK = 128
CONV_DIM = SSD_WIDTH + 2 * SSD_GROUPS * SSD_STATE
D_IN_PROJ = 3 * ATTN_WIDTH + SSD_WIDTH + CONV_DIM + SSD_HEADS
D_FF = 2816
N_EXPERTS = 8
TOP_K = 2
D_FF_EXPERT = 3584
N_DENSE = (DEPTH + 1) // 2
N_MOE = DEPTH // 2
EPS = 1e-5

kernel_name = "hymba_sbattn_ssd_moe_block"


def rmsnorm(x, g):
    xf = x.astype(jnp.float32)
    var = jnp.mean(xf * xf, axis=-1, keepdims=True)
    return (xf * lax.rsqrt(var + EPS) * g.astype(jnp.float32)).astype(x.dtype)


def stick_breaking_attention(q, k, v):
    seq = q.shape[1]
    scale = HEAD_DIM ** -0.5
    outs = []
    for blk in range(seq // Q_BLOCK):
        q0 = blk * Q_BLOCK
        q1 = q0 + Q_BLOCK
        qb = q[:, q0:q1]
        kb = k[:, :q1]
        vb = v[:, :q1]
        z = jnp.einsum("bthd,bshd->bhts", qb, kb).astype(jnp.float32) * scale
        t_pos = q0 + jnp.arange(Q_BLOCK)[:, None]
        s_pos = jnp.arange(q1)[None, :]
        causal = s_pos < t_pos
        neg_log_1m_beta = jnp.where(causal, jax.nn.softplus(z), 0.0)
        later = lax.cumsum(neg_log_1m_beta, axis=3, reverse=True) - neg_log_1m_beta
        w = jnp.where(causal, jnp.exp(jax.nn.log_sigmoid(z) - later), 0.0)
        outs.append(jnp.einsum("bhts,bshd->bthd", w.astype(v.dtype), vb))
    return jnp.concatenate(outs, axis=1)


def segsum(a):
    t = a.shape[-1]
    ar = jnp.broadcast_to(a[..., :, None], a.shape + (t,))
    strict = jnp.tril(jnp.ones((t, t), dtype=bool), -1)
    cs = jnp.cumsum(jnp.where(strict, ar, 0.0), axis=-2)
    incl = jnp.tril(jnp.ones((t, t), dtype=bool), 0)
    return jnp.where(incl, cs, -jnp.inf)


def ssd_chunked(x, dt, a, b_in, c_in):
    bsz, seq = x.shape[0], x.shape[1]
    nc = seq // CHUNK
    r = SSD_HEADS // SSD_GROUPS
    xc = (x * dt[..., None]).reshape(bsz, nc, CHUNK, SSD_GROUPS, r, SSD_HEAD_DIM)
    ac = (dt * a).reshape(bsz, nc, CHUNK, SSD_GROUPS, r).transpose(0, 3, 4, 1, 2)
    bc = b_in.reshape(bsz, nc, CHUNK, SSD_GROUPS, SSD_STATE)
    cc = c_in.reshape(bsz, nc, CHUNK, SSD_GROUPS, SSD_STATE)
    a_cum = jnp.cumsum(ac, axis=-1)
    decay = jnp.exp(segsum(ac))
    cb = jnp.einsum("bclgn,bcsgn->bgcls", cc, bc)
    y_diag = jnp.einsum("bgcls,bgrcls,bcsgrp->bclgrp", cb, decay, xc)
    decay_states = jnp.exp(a_cum[..., -1:] - a_cum)
    states = jnp.einsum("bclgn,bgrcl,bclgrp->bcgrpn", bc, decay_states, xc)
    states = jnp.concatenate([jnp.zeros_like(states[:, :1]), states], axis=1)
    last = jnp.pad(a_cum[..., -1], ((0, 0), (0, 0), (0, 0), (1, 0)))
    chunk_decay = jnp.exp(segsum(last))
    new_states = jnp.einsum("bgrzc,bcgrpn->bzgrpn", chunk_decay, states)
    states = new_states[:, :-1]
    y_off = jnp.einsum("bclgn,bcgrpn,bgrcl->bclgrp", cc, states, jnp.exp(a_cum))
    return (y_diag + y_off).reshape(bsz, seq, SSD_HEADS, SSD_HEAD_DIM)


def causal_depthwise_conv(u, w, b):
    out = lax.conv_general_dilated(
        u, w[:, None, :].astype(u.dtype), window_strides=(1,), padding=[(CONV_K - 1, 0)],
        dimension_numbers=("NWC", "WIO", "NWC"), feature_group_count=CONV_DIM)
    return out + b.astype(u.dtype)


def hybrid_mixer(h, w_in, conv_w, conv_b, dt_bias, a_log, d_skip, attn_norm_g, ssd_norm_g, w_out):
    bsz, seq = h.shape[0], h.shape[1]
    proj = h @ w_in
    o1 = ATTN_WIDTH
    o2 = o1 + ATTN_WIDTH
    o3 = o2 + ATTN_WIDTH
    o4 = o3 + SSD_WIDTH
    o5 = o4 + CONV_DIM
    q, k, v, z, xbc, dt_raw = jnp.split(proj, [o1, o2, o3, o4, o5], axis=-1)
    hs = (bsz, seq, ATTN_HEADS, HEAD_DIM)
    attn = stick_breaking_attention(q.reshape(hs), k.reshape(hs), v.reshape(hs))
    attn = rmsnorm(attn.reshape(bsz, seq, ATTN_WIDTH), attn_norm_g)
    xbc = jax.nn.silu(causal_depthwise_conv(xbc, conv_w, conv_b))
    xs, bs, cs = jnp.split(xbc, [SSD_WIDTH, SSD_WIDTH + SSD_GROUPS * SSD_STATE], axis=-1)
    xs = xs.astype(jnp.float32).reshape(bsz, seq, SSD_HEADS, SSD_HEAD_DIM)
    bs = bs.astype(jnp.float32).reshape(bsz, seq, SSD_GROUPS, SSD_STATE)
    cs = cs.astype(jnp.float32).reshape(bsz, seq, SSD_GROUPS, SSD_STATE)
    dt = jax.nn.softplus(dt_raw.astype(jnp.float32) + dt_bias.astype(jnp.float32))
    a = -jnp.exp(a_log.astype(jnp.float32))
    y = ssd_chunked(xs, dt, a, bs, cs) + d_skip.astype(jnp.float32)[:, None] * xs
    y = y.reshape(bsz, seq, SSD_WIDTH) * jax.nn.silu(z.astype(jnp.float32))
    yg = y.reshape(bsz, seq, SSD_GROUPS, SSD_WIDTH // SSD_GROUPS)
    yg = yg * lax.rsqrt(jnp.mean(yg * yg, axis=-1, keepdims=True) + EPS)
    y = (yg.reshape(bsz, seq, SSD_WIDTH) * ssd_norm_g.astype(jnp.float32)).astype(h.dtype)
    return jnp.concatenate([attn, y], axis=-1) @ w_out


def swiglu(h, wg, wu, wd):
    return (jax.nn.silu(h @ wg) * (h @ wu)) @ wd


def moe_swiglu(h, router_w, wg, wu, wd):
    logits = (h @ router_w).astype(jnp.float32)
    top_vals, top_idx = lax.top_k(logits, TOP_K)
    top_w = jax.nn.softmax(top_vals, axis=-1)
    gates = jnp.sum(jax.nn.one_hot(top_idx, N_EXPERTS, dtype=jnp.float32) * top_w[..., None], axis=-2)
    gates = gates.astype(h.dtype)
    out = jnp.zeros_like(h)
    for e in range(N_EXPERTS):
        out = out + gates[..., e:e + 1] * swiglu(h, wg[e], wu[e], wd[e])
    return out


def setup_inputs(seed: int = 0) -> dict:
    key = jax.random.key(seed)
    ks = jax.random.split(key, 24)
    f32 = jnp.float32

    def nrm(k, shape, fan_in):
        return jax.random.normal(k, shape, f32) * (fan_in ** -0.5)

    def gain(k, shape):
        return 1.0 + 0.02 * jax.random.normal(k, shape, f32)

    dt0 = jnp.exp(jax.random.uniform(ks[5], (DEPTH, SSD_HEADS), f32, math.log(1e-3), math.log(1e-1)))
    dt_bias = dt0 + jnp.log(-jnp.expm1(-dt0))
    return {
        "x": jax.random.normal(ks[0], (BATCH, SEQ, D_MODEL), f32),
        "mix_norm_g": gain(ks[1], (DEPTH, D_MODEL)),
        "w_in": nrm(ks[2], (DEPTH, D_MODEL, D_IN_PROJ), D_MODEL),
        "conv_w": nrm(ks[3], (DEPTH, CONV_K, CONV_DIM), CONV_K),
        "conv_b": 0.01 * jax.random.normal(ks[4], (DEPTH, CONV_DIM), f32),
        "dt_bias": dt_bias,
        "a_log": jnp.log(jax.random.uniform(ks[6], (DEPTH, SSD_HEADS), f32, 1.0, 16.0)),
        "d_skip": gain(ks[7], (DEPTH, SSD_HEADS)),
        "attn_norm_g": gain(ks[8], (DEPTH, ATTN_WIDTH)),
        "ssd_norm_g": gain(ks[9], (DEPTH, SSD_WIDTH)),
        "w_out": nrm(ks[10], (DEPTH, D_MIX, D_MODEL), D_MIX),
        "ffn_norm_g": gain(ks[11], (DEPTH, D_MODEL)),
        "dense_w_gate": nrm(ks[12], (N_DENSE, D_MODEL, D_FF), D_MODEL),
        "dense_w_up": nrm(ks[13], (N_DENSE, D_MODEL, D_FF), D_MODEL),
        "dense_w_down": nrm(ks[14], (N_DENSE, D_FF, D_MODEL), D_FF),
        "router_w": nrm(ks[15], (N_MOE, D_MODEL, N_EXPERTS), D_MODEL),
        "moe_w_gate": nrm(ks[16], (N_MOE, N_EXPERTS, D_MODEL, D_FF_EXPERT), D_MODEL),
        "moe_w_up": nrm(ks[17], (N_MOE, N_EXPERTS, D_MODEL, D_FF_EXPERT), D_MODEL),
        "moe_w_down": nrm(ks[18], (N_MOE, N_EXPERTS, D_FF_EXPERT, D_MODEL), D_FF_EXPERT),
        "final_norm_g": gain(ks[19], (D_MODEL,)),
    }


def reference(x, mix_norm_g, w_in, conv_w, conv_b, dt_bias, a_log, d_skip, attn_norm_g, ssd_norm_g,
              w_out, ffn_norm_g, dense_w_gate, dense_w_up, dense_w_down, router_w, moe_w_gate,
              moe_w_up, moe_w_down, final_norm_g):
    for layer in range(DEPTH):
        h = rmsnorm(x, mix_norm_g[layer])
        x = x + hybrid_mixer(h, w_in[layer], conv_w[layer], conv_b[layer], dt_bias[layer], a_log[layer],
                             d_skip[layer], attn_norm_g[layer], ssd_norm_g[layer], w_out[layer])
        h = rmsnorm(x, ffn_norm_g[layer])
        i = layer // 2
        if layer % 2 == 0:
            x = x + swiglu(h, dense_w_gate[i], dense_w_up[i], dense_w_down[i])
        else:
            x = x + moe_swiglu(h, router_w[i], moe_w_gate[i], moe_w_up[i], moe_w_down[i])
    return rmsnorm(x, final_norm_g)
```

```cpp
#include <hip/hip_runtime.h>
#include <cstdio>
#include <cstdint>
namespace pg8 {
#define PG8_LAS __attribute__((address_space(3)))
typedef unsigned short bf16_t;
typedef short bf16x8 __attribute__((ext_vector_type(8)));
typedef float f32x4 __attribute__((ext_vector_type(4)));
typedef unsigned u32x4 __attribute__((ext_vector_type(4)));
constexpr int BM = 256, BK = 64, HALF = 128, HTB = HALF * BK * 2  , STAGE_BYTES = 8 * HTB, NXCD = 8, WGM = 8;

__host__ __device__ __forceinline__ int lds_byte(int r, int c) { const int st = (r >> 4) * 2 + (c >> 5), rr = r & 15, cc = c & 31, ob = rr * 64 + cc * 2; return st * 1024 + (ob ^ (((ob >> 9) & 1) << 5)); }
__host__ __device__ __forceinline__ void stage_rc(int b, int& R, int& C) { const int st = b / 1024, sb = b % 1024, swz = sb ^ (((sb >> 9) & 1) << 5); R = (st >> 1) * 16 + swz / 64; C = (st & 1) * 32 + (swz % 64) / 2; }
__host__ __device__ __forceinline__ int perm32(int rho) { const int n = rho >> 4, i = rho & 15; return 8 * (i >> 2) + 4 * n + (i & 3); }

struct Unit { int pm, pn; long boff; };
struct Gemm { const bf16_t* A; const bf16_t* Bt; int M, N, K; };

struct StaticOrder {
    int nM, nN, nwg, G, c;
    __host__ __device__ void init(int M, int N, int G_, int c_) { nM = M / BM; nN = N / BM; nwg = nM * nN; G = G_; c = c_; }
    __host__ __device__ bool next(int i, Unit& u) const {
        const long L = (long)i * G + c; if (L >= nwg) return false;
        int wgid = (int)L; { const int q = nwg / NXCD, r = nwg % NXCD, xcd = wgid % NXCD, off = wgid / NXCD; wgid = (xcd < r ? xcd * (q + 1) : r * (q + 1) + (xcd - r) * q) + off; }
        const int nig = WGM * nN, gid = wgid / nig, fm = gid * WGM, gsz = (nM - fm) < WGM ? (nM - fm) : WGM;
        u.pm = fm + ((wgid % nig) % gsz); u.pn = (wgid % nig) / gsz; u.boff = 0; return true;
    }
    __device__ __forceinline__ void a_ready(const Unit&) const {}
    __device__ __forceinline__ void done(const Unit&) const {}
};

__device__ __forceinline__ unsigned cvt_pk_bf16(float lo, float hi) { unsigned r; asm volatile("v_cvt_pk_bf16_f32 %0, %1, %2" : "=v"(r) : "v"(lo), "v"(hi)); return r; }
typedef float f32x2 __attribute__((ext_vector_type(2)));

struct EpiBf16 {
    static constexpr bool PERM = true, AFTER_DRAIN = false;
    bf16_t* O; int ldc; int scale_cols; float scale0;
    __device__ __forceinline__ void operator()(const f32x4 (&acc)[2][2][4][2], const Unit& u, int wr, int wc, int fr, int fq) const {
        const int row0 = u.pm * BM + wr * 64 + fr; const int colt = u.pn * BM;
        const float sc = (colt < scale_cols) ? scale0 : 1.f;
        const int col0 = colt + wc * 32 + 8 * fq;
#pragma unroll
        for (int ai = 0; ai < 2; ++ai)
#pragma unroll
            for (int m = 0; m < 4; ++m) { bf16_t* rowp = O + (size_t)(row0 + ai * HALF + m * 16) * ldc + col0;
#pragma unroll
                for (int bj = 0; bj < 2; ++bj) { f32x4 v0 = acc[ai][bj][m][0] * sc, v1 = acc[ai][bj][m][1] * sc;
                    u32x4 w; w.x = cvt_pk_bf16(v0[0], v0[1]); w.y = cvt_pk_bf16(v0[2], v0[3]); w.z = cvt_pk_bf16(v1[0], v1[1]); w.w = cvt_pk_bf16(v1[2], v1[3]);
                    *(u32x4*)(rowp + bj * HALF) = w; } }
    }
};
__device__ __forceinline__ float silu_mul(float g, float u) { return g * u * __builtin_amdgcn_rcpf(1.f + __builtin_amdgcn_exp2f(-1.4426950408889634f * g)); }
struct EpiSwiGLU {
    static constexpr bool PERM = true, AFTER_DRAIN = false;
    bf16_t* O; int ldc;
    __device__ __forceinline__ void operator()(const f32x4 (&acc)[2][2][4][2], const Unit& u, int wr, int wc, int fr, int fq) const {
        const int row0 = u.pm * BM + wr * 64 + fr; const int col0 = u.pn * HALF + wc * 32 + 8 * fq;
#pragma unroll
        for (int ai = 0; ai < 2; ++ai)
#pragma unroll
            for (int m = 0; m < 4; ++m) { bf16_t* rowp = O + (size_t)(row0 + ai * HALF + m * 16) * ldc + col0;
                const f32x4 g0 = acc[ai][0][m][0], g1 = acc[ai][0][m][1], u0 = acc[ai][1][m][0], u1 = acc[ai][1][m][1];
                u32x4 w; w.x = cvt_pk_bf16(silu_mul(g0[0], u0[0]), silu_mul(g0[1], u0[1])); w.y = cvt_pk_bf16(silu_mul(g0[2], u0[2]), silu_mul(g0[3], u0[3]));
                w.z = cvt_pk_bf16(silu_mul(g1[0], u1[0]), silu_mul(g1[1], u1[1])); w.w = cvt_pk_bf16(silu_mul(g1[2], u1[2]), silu_mul(g1[3], u1[3]));
                *(u32x4*)rowp = w; }
    }
};
struct EpiResAdd {
    static constexpr bool PERM = false, AFTER_DRAIN = false;
    const float* base; float* out; int ldc;
    __device__ __forceinline__ void operator()(const f32x4 (&acc)[2][2][4][2], const Unit& u, int wr, int wc, int fr, int fq) const {
        const int col0 = u.pn * BM + wc * 32 + 4 * fq;
#pragma unroll
        for (int ai = 0; ai < 2; ++ai)
#pragma unroll
            for (int m = 0; m < 4; ++m) { const size_t off = (size_t)(u.pm * BM + ai * HALF + wr * 64 + m * 16 + fr) * ldc + col0;
#pragma unroll
                for (int bj = 0; bj < 2; ++bj)
#pragma unroll
                    for (int n = 0; n < 2; ++n) { const f32x4 bs = *(const f32x4*)(base + off + bj * HALF + n * 16); *(f32x4*)(out + off + bj * HALF + n * 16) = bs + acc[ai][bj][m][n]; } }
    }
};
struct EpiRowScaleBf16 {
    static constexpr bool PERM = true, AFTER_DRAIN = false;
    bf16_t* O; int ldc; const float* rowgate;
    __device__ __forceinline__ void operator()(const f32x4 (&acc)[2][2][4][2], const Unit& u, int wr, int wc, int fr, int fq) const {
        const int row0 = u.pm * BM + wr * 64 + fr; const int col0 = u.pn * BM + wc * 32 + 8 * fq;
#pragma unroll
        for (int ai = 0; ai < 2; ++ai)
#pragma unroll
            for (int m = 0; m < 4; ++m) { const int row = row0 + ai * HALF + m * 16; const float sc = rowgate[row]; bf16_t* rowp = O + (size_t)row * ldc + col0;
#pragma unroll
                for (int bj = 0; bj < 2; ++bj) { f32x4 v0 = acc[ai][bj][m][0] * sc, v1 = acc[ai][bj][m][1] * sc;
                    u32x4 w; w.x = cvt_pk_bf16(v0[0], v0[1]); w.y = cvt_pk_bf16(v0[2], v0[3]); w.z = cvt_pk_bf16(v1[0], v1[1]); w.w = cvt_pk_bf16(v1[2], v1[3]);
                    *(u32x4*)(rowp + bj * HALF) = w; } }
    }
};
struct GroupedOrder {
    int nM, nN, nwg, G, c; const int* ptab; long estride;
    __device__ void init(int nM_, int nN_, int G_, int c_, const int* ptab_, long estride_) { nM = nM_; nN = nN_; nwg = nM * nN; G = G_; c = c_; ptab = ptab_; estride = estride_; }
    __device__ bool next(int i, Unit& u) const {
        const long L = (long)i * G + c; if (L >= nwg) return false;
        int wgid = (int)L; { const int q = nwg / NXCD, r = nwg % NXCD, xcd = wgid % NXCD, off = wgid / NXCD; wgid = (xcd < r ? xcd * (q + 1) : r * (q + 1) + (xcd - r) * q) + off; }
        const int nig = WGM * nN, gid = wgid / nig, fm = gid * WGM, gsz = (nM - fm) < WGM ? (nM - fm) : WGM;
        u.pm = fm + ((wgid % nig) % gsz); u.pn = (wgid % nig) / gsz;
        u.boff = (long)__builtin_amdgcn_readfirstlane(ptab[u.pm]) * estride; return true;
    }
    __device__ __forceinline__ void a_ready(const Unit&) const {}
    __device__ __forceinline__ void done(const Unit&) const {}
};

template <class Epi, class Sched, bool ALIGN_EPI = false, bool SP2 = false>
__device__ __forceinline__ void gemm_phase(PG8_LAS unsigned char* lds, const Gemm g, const Sched& S, const Epi& E) {
    const int tid = threadIdx.x, wid = __builtin_amdgcn_readfirstlane(tid >> 6), lane = tid & 63, wr = wid >> 2, wc = wid & 3, fr = lane & 15, fq = lane >> 4;
    const int K = g.K, nt = K / BK;
    unsigned voffA[2], voffB[2];
#pragma unroll
    for (int i = 0; i < 2; ++i) { int R, C; stage_rc(tid * 16 + i * 8192, R, C); const int Rb = Epi::PERM ? ((R & ~31) + perm32(R & 31)) : R;
        voffA[i] = (unsigned)(R * K + C) * 2u; voffB[i] = (unsigned)(Rb * K + C) * 2u; }
    const size_t kstep = (size_t)(BK * 2);
    const size_t hstep = (size_t)HALF * K * 2;
    const size_t tstep = 2 * hstep;
    const unsigned ldsw = (unsigned)wid * 1024u;
    const int aoff = lds_byte(wr * 64 + fr, fq * 8), boff = lds_byte(wc * 32 + fr, fq * 8);
#define PG8_SA(b, h) (((b) * 2 + (h)) * HTB)
#define PG8_SB(b, h) ((4 + (b) * 2 + (h)) * HTB)
#define PG8_STAGE(bufoff, gbase, voff) do { _Pragma("unroll") for (int _i = 0; _i < 2; ++_i) \
        __builtin_amdgcn_global_load_lds((const unsigned*)((const char*)(gbase) + (voff)[_i]), (PG8_LAS unsigned*)(lds + (bufoff) + ldsw + _i * 8192), 16, 0, 0); } while (0)
#define PG8_LDA(dst, b, h) do { _Pragma("unroll") for (int m = 0; m < 4; ++m) _Pragma("unroll") for (int k = 0; k < 2; ++k) dst[m][k] = *(const PG8_LAS bf16x8*)(lds + PG8_SA(b, h) + aoff + m * 2048 + k * 1024); } while (0)
#define PG8_LDB(dst, b, h) do { _Pragma("unroll") for (int n = 0; n < 2; ++n) _Pragma("unroll") for (int k = 0; k < 2; ++k) dst[n][k] = *(const PG8_LAS bf16x8*)(lds + PG8_SB(b, h) + boff + n * 2048 + k * 1024); } while (0)
#define PG8_MMA(ai, bj, At, Bt) do { __builtin_amdgcn_s_setprio(1); _Pragma("unroll") for (int m = 0; m < 4; ++m) _Pragma("unroll") for (int n = 0; n < 2; ++n) _Pragma("unroll") for (int k = 0; k < 2; ++k) \
        acc[ai][bj][m][n] = __builtin_amdgcn_mfma_f32_16x16x32_bf16(Bt[n][k], At[m][k], acc[ai][bj][m][n], 0, 0, 0); __builtin_amdgcn_s_setprio(0); } while (0)
#define PG8_WAIT_V(n) asm volatile("s_waitcnt vmcnt(" #n ")" ::: "memory")
#define PG8_WAIT_L(n) asm volatile("s_waitcnt lgkmcnt(" #n ")" ::: "memory")
#define PG8_BAR __builtin_amdgcn_s_barrier()
#define PG8_SCHED __builtin_amdgcn_sched_barrier(0)
    Unit cur, nxt; int ui = 0;
    if (!S.next(0, cur)) return;
    f32x4 acc[2][2][4][2];
#pragma unroll
    for (int a = 0; a < 2; ++a)
#pragma unroll
        for (int b = 0; b < 2; ++b)
#pragma unroll
            for (int m = 0; m < 4; ++m)
#pragma unroll
                for (int n = 0; n < 2; ++n) acc[a][b][m][n] = (f32x4){0.f, 0.f, 0.f, 0.f};
    bf16x8 At[4][2], B0[2][2], B1[2][2];
    const char* cA = (const char*)g.A + (size_t)cur.pm * tstep; const char* cB = (const char*)g.Bt + (size_t)cur.pn * tstep + cur.boff;
    S.a_ready(cur);
    if constexpr (SP2) {
        PG8_STAGE(PG8_SB(0, 0), cB, voffB); PG8_STAGE(PG8_SB(0, 1), cB + hstep, voffB); PG8_STAGE(PG8_SA(0, 0), cA, voffA); PG8_STAGE(PG8_SA(0, 1), cA + hstep, voffA);
        if (wr == 1) PG8_BAR;
        PG8_WAIT_V(2); PG8_BAR;
        PG8_STAGE(PG8_SB(1, 0), cB + kstep, voffB); PG8_STAGE(PG8_SA(1, 0), cA + kstep, voffA); PG8_STAGE(PG8_SB(1, 1), cB + hstep + kstep, voffB);
        PG8_WAIT_V(6); PG8_BAR;
    } else {
        PG8_STAGE(PG8_SB(0, 0), cB, voffB); PG8_STAGE(PG8_SA(0, 0), cA, voffA); PG8_STAGE(PG8_SB(0, 1), cB + hstep, voffB); PG8_STAGE(PG8_SA(0, 1), cA + hstep, voffA);
        if (wr == 1) PG8_BAR;
        PG8_WAIT_V(4); PG8_BAR;
        PG8_STAGE(PG8_SB(1, 0), cB + kstep, voffB); PG8_STAGE(PG8_SA(1, 0), cA + kstep, voffA); PG8_STAGE(PG8_SB(1, 1), cB + hstep + kstep, voffB);
        PG8_WAIT_V(6); PG8_BAR;
    }
    for (;;) {
        const bool has_next = S.next(ui + 1, nxt);
        const char* nA = has_next ? (const char*)g.A + (size_t)nxt.pm * tstep : cA; const char* nB = has_next ? (const char*)g.Bt + (size_t)nxt.pn * tstep + nxt.boff : cB;
        for (int t = 0; t < nt; t += 2) {
            const bool last = (t == nt - 2);
            const char* a1 = cA + (size_t)(t + 1) * kstep;
            const char* a2 = last ? nA : cA + (size_t)(t + 2) * kstep; const char* b2 = last ? nB : cB + (size_t)(t + 2) * kstep;
            const char* a3 = a2 + kstep; const char* b3 = b2 + kstep;
            if (last && has_next) S.a_ready(nxt);
            if constexpr (SP2) {
            PG8_LDB(B0, 0, 0); PG8_LDB(B1, 0, 1); PG8_SCHED; PG8_LDA(At, 0, 0); PG8_STAGE(PG8_SA(1, 1), a1 + hstep, voffA);
            PG8_WAIT_V(8); PG8_WAIT_L(0); PG8_BAR; PG8_MMA(0, 0, At, B0); PG8_MMA(0, 1, At, B1); PG8_BAR; PG8_SCHED;
            PG8_LDA(At, 0, 1); PG8_STAGE(PG8_SB(0, 0), b2, voffB); PG8_STAGE(PG8_SB(0, 1), b2 + hstep, voffB); PG8_STAGE(PG8_SA(0, 0), a2, voffA);
            PG8_WAIT_V(8); PG8_WAIT_L(0); PG8_BAR; PG8_MMA(1, 0, At, B0); PG8_MMA(1, 1, At, B1); PG8_BAR; PG8_SCHED;
            PG8_LDB(B0, 1, 0); PG8_LDB(B1, 1, 1); PG8_SCHED; PG8_LDA(At, 1, 0); PG8_STAGE(PG8_SA(0, 1), a2 + hstep, voffA);
            PG8_WAIT_V(8); PG8_WAIT_L(0); PG8_BAR; PG8_MMA(0, 0, At, B0); PG8_MMA(0, 1, At, B1); PG8_BAR; PG8_SCHED;
            PG8_LDA(At, 1, 1); PG8_STAGE(PG8_SB(1, 0), b3, voffB); PG8_STAGE(PG8_SB(1, 1), b3 + hstep, voffB); PG8_STAGE(PG8_SA(1, 0), a3, voffA);
            PG8_WAIT_V(8); PG8_WAIT_L(0); PG8_BAR; PG8_MMA(1, 0, At, B0); PG8_MMA(1, 1, At, B1); PG8_BAR; PG8_SCHED;
            } else {
            PG8_LDB(B0, 0, 0); PG8_SCHED; PG8_LDA(At, 0, 0); PG8_STAGE(PG8_SA(1, 1), a1 + hstep, voffA);
            PG8_WAIT_L(8); PG8_BAR; PG8_WAIT_L(0); PG8_MMA(0, 0, At, B0); PG8_BAR; PG8_SCHED;
            PG8_LDB(B1, 0, 1); PG8_STAGE(PG8_SB(0, 0), b2, voffB);
            PG8_BAR; PG8_WAIT_L(0); PG8_MMA(0, 1, At, B1); PG8_BAR;
            PG8_LDA(At, 0, 1); PG8_STAGE(PG8_SA(0, 0), a2, voffA);
            PG8_BAR; PG8_WAIT_L(0); PG8_MMA(1, 0, At, B0); PG8_BAR; PG8_SCHED;
            PG8_STAGE(PG8_SB(0, 1), b2 + hstep, voffB);
            PG8_WAIT_V(6); PG8_BAR; PG8_MMA(1, 1, At, B1); PG8_BAR;
            PG8_LDB(B0, 1, 0); PG8_SCHED; PG8_LDA(At, 1, 0); PG8_STAGE(PG8_SA(0, 1), a2 + hstep, voffA);
            PG8_WAIT_L(8); PG8_BAR; PG8_WAIT_L(0); PG8_MMA(0, 0, At, B0); PG8_BAR; PG8_SCHED;
            PG8_LDB(B1, 1, 1); PG8_STAGE(PG8_SB(1, 0), b3, voffB);
            PG8_BAR; PG8_WAIT_L(0); PG8_MMA(0, 1, At, B1); PG8_BAR;
            PG8_LDA(At, 1, 1); PG8_STAGE(PG8_SA(1, 0), a3, voffA);
            PG8_BAR; PG8_WAIT_L(0); PG8_MMA(1, 0, At, B0); PG8_BAR; PG8_SCHED;
            PG8_STAGE(PG8_SB(1, 1), b3 + hstep, voffB);
            PG8_WAIT_V(6); PG8_BAR; PG8_MMA(1, 1, At, B1); PG8_BAR;
            }
        }
        if constexpr (ALIGN_EPI) { if (wr == 0) PG8_BAR; }
        if constexpr (!Epi::AFTER_DRAIN) { E(acc, cur, wr, wc, fr, fq); S.done(cur); }
        if (!has_next) break;
#pragma unroll
        for (int a = 0; a < 2; ++a)
#pragma unroll
            for (int b = 0; b < 2; ++b)
#pragma unroll
                for (int m = 0; m < 4; ++m)
#pragma unroll
                    for (int n = 0; n < 2; ++n) acc[a][b][m][n] = (f32x4){0.f, 0.f, 0.f, 0.f};
        cur = nxt; cA = nA; cB = nB; ++ui;
        if constexpr (ALIGN_EPI) { if (wr == 1) PG8_BAR; }
    }
    PG8_WAIT_V(0);
    if constexpr (!ALIGN_EPI) { if (wr == 0) PG8_BAR; }
    PG8_BAR;
    if constexpr (Epi::AFTER_DRAIN) { E.fused(acc, cur, wr, wc, fr, fq, lds, wid, lane); S.done(cur); }
#undef PG8_SA
#undef PG8_SB
#undef PG8_STAGE
#undef PG8_LDA
#undef PG8_LDB
#undef PG8_MMA
#undef PG8_WAIT_V
#undef PG8_WAIT_L
#undef PG8_BAR
#undef PG8_SCHED
}
}

#define GAS __attribute__((address_space(1)))
#define LAS __attribute__((address_space(3)))
typedef unsigned short bf16;
typedef unsigned v4u __attribute__((ext_vector_type(4)));
typedef float f32x4 __attribute__((ext_vector_type(4)));
typedef short bf16x8 __attribute__((ext_vector_type(8)));
typedef GAS unsigned gu32;
typedef GAS unsigned long long gu64;
#define RLX_AGENT __ATOMIC_RELAXED, __HIP_MEMORY_SCOPE_AGENT
#define LDS_WAIT() asm volatile("s_waitcnt lgkmcnt(0)" ::: "memory")
#define VM_WAIT() asm volatile("s_waitcnt vmcnt(0)" ::: "memory")
__device__ __forceinline__ unsigned long long rt() { return __builtin_amdgcn_s_memrealtime(); }
__device__ __forceinline__ unsigned f2bf(float f) { unsigned u = __builtin_bit_cast(unsigned, f); return (u + 0x7fffu + ((u >> 16) & 1u)) >> 16; }
__device__ __forceinline__ unsigned pk2(float lo, float hi) { return f2bf(lo) | (f2bf(hi) << 16); }

#define XB_TMO      128
#define XB_XCNT(j)  (256  + 64 * (j))
#define XB_XSUB(j)  (1280 + 64 * (j))
#define XB_XGEN(j)  (2304 + 64 * (j))
#define XB_TOP      3328
#define XB_TOPGEN   3392
#define XCD_BAR_WORDS 3456
#define XB_SPIN_CAP (1u << 18)

__device__ __forceinline__ unsigned xb_ld(unsigned* p)              { return __hip_atomic_load(p, __ATOMIC_RELAXED, __HIP_MEMORY_SCOPE_AGENT); }
__device__ __forceinline__ unsigned xb_add(unsigned* p, unsigned v) { return __hip_atomic_fetch_add(p, v, __ATOMIC_RELAXED, __HIP_MEMORY_SCOPE_AGENT); }
__device__ __forceinline__ unsigned xb_xcc_id() { return (unsigned)__builtin_amdgcn_s_getreg((3 << 11) | 20) & 0xFu; }
#define XB_SPIN(cond, bar) do { unsigned _sp = 0; while (cond) { __builtin_amdgcn_s_sleep(1); \
    if ((++_sp & 255u) == 0u) { if (xb_ld(&(bar)[XB_TMO])) break; if (_sp > XB_SPIN_CAP) { atomicAdd(&(bar)[XB_TMO], 1u); break; } } } } while (0)

struct XcdBarrier {
    unsigned* bar; unsigned x;
    volatile LAS unsigned* st;
};

__device__ __forceinline__ XcdBarrier xcd_barrier_post(unsigned* bar, volatile LAS unsigned* st) {
    XcdBarrier b; b.bar = bar; b.x = xb_xcc_id(); b.st = st;
    if (threadIdx.x == 0) (void)xb_add(&bar[XB_XCNT(b.x)], 1u);
    return b;
}
__device__ __forceinline__ void xcd_barrier_complete(unsigned* bar, unsigned x, unsigned& nloc, unsigned& nx) {
    const unsigned G = gridDim.x * gridDim.y * gridDim.z;
    unsigned sum, cnt, mine, sp = 0u;
    for (;;) {
        sum = 0u; cnt = 0u; mine = 0u;
#pragma unroll
        for (unsigned j = 0; j < 16; ++j) { const unsigned c = xb_ld(&bar[XB_XCNT(j)]); sum += c; cnt += (c > 0u) ? 1u : 0u; mine = (j == x) ? c : mine; }
        if (sum == G) break;
        __builtin_amdgcn_s_sleep(1);
        if ((++sp & 255u) == 0u) { if (xb_ld(&bar[XB_TMO])) break; if (sp > XB_SPIN_CAP) { atomicAdd(&bar[XB_TMO], 1u); break; } }
    }
    nloc = mine > 0u ? mine : 1u; nx = cnt > 0u ? cnt : 1u;
}

__device__ __forceinline__ void xcd_barrier(const XcdBarrier& b) {
    asm volatile("s_waitcnt vmcnt(0)" ::: "memory");
    __syncthreads();
    if (threadIdx.x == 0) {
        unsigned* bar = b.bar;
        __builtin_amdgcn_s_waitcnt(0);
        unsigned nloc = b.st[0], nx = b.st[1];
        if (nloc == 0u) { xcd_barrier_complete(bar, b.x, nloc, nx); b.st[0] = nloc; b.st[1] = nx; }
        const unsigned old = xb_add(&bar[XB_XSUB(b.x)], 1u);
        const unsigned gen = old / nloc;
        if (old + 1u == (gen + 1u) * nloc) {
            __builtin_amdgcn_fence(__ATOMIC_RELEASE, "agent");
            asm volatile("s_waitcnt vmcnt(0)" ::: "memory");
            const unsigned og = xb_add(&bar[XB_TOP], 1u);
            const unsigned tg = og / nx;
            if (og + 1u == (tg + 1u) * nx) xb_add(&bar[XB_TOPGEN], 1u);
            else XB_SPIN(xb_ld(&bar[XB_TOPGEN]) == tg, bar);
            __builtin_amdgcn_fence(__ATOMIC_ACQUIRE, "agent");
            xb_add(&bar[XB_XGEN(b.x)], 1u);
            asm volatile("s_waitcnt vmcnt(0)" ::: "memory");
        } else {
            XB_SPIN(xb_ld(&bar[XB_XGEN(b.x)]) == gen, bar);
            __builtin_amdgcn_fence(__ATOMIC_ACQUIRE, "agent");
            asm volatile("s_waitcnt vmcnt(0)" ::: "memory");
        }
    }
    __syncthreads();
}

__device__ __forceinline__ float bf2f(bf16 v) { return __builtin_bit_cast(float, (unsigned)v << 16); }
__device__ __forceinline__ float bfbits2f(unsigned bits) { return __builtin_bit_cast(float, bits << 16); }

constexpr int NWAVES = 8;
constexpr int BATCH = 8, SEQ = 2048, DM = 1024, MT = BATCH * SEQ;
constexpr int DINP = 3080, NPROJ = 3072;
constexpr int OQ = 0, OK_ = 512, OV = 1024, OZ = 1536, OXBC = 2048;
constexpr int NH = 8, HD = 64, SSTATE = 128;
constexpr int DFF = 2816, DFFE = 3584, NE = 8;
constexpr int MOE_ROWS = 2 * MT + NE * 256;
constexpr float EPS = 1e-5f;

constexpr size_t MiB = 1u << 20;
constexpr size_t WS_CTL = 0, CTL_ZERO_BYTES = 1 * MiB;
constexpr size_t WS_DTRAW = 1 * MiB, WS_DTV = WS_DTRAW + 512 * 1024;
constexpr size_t WS_TOKE = 2 * MiB, WS_TOKR = WS_TOKE + 128 * 1024, WS_TOKG = WS_TOKR + 128 * 1024, WS_TOKP = WS_TOKG + 128 * 1024;
constexpr size_t WS_ROWG = 2 * MiB + 512 * 1024, WS_PTAB = 3 * MiB;
constexpr size_t WS_R1 = 4 * MiB;
constexpr size_t WS_WIN = 116 * MiB, WS_WOUT = 128 * MiB, WS_WDGU = 132 * MiB, WS_WDD = 143 * MiB;
constexpr size_t WS_AO = 149 * MiB;
constexpr size_t WS_R2 = 116 * MiB;
constexpr size_t WS_R3 = 184 * MiB;
constexpr size_t WS_PROJ = WS_R3, WS_HB = WS_R3, WS_XN = 280 * MiB;
constexpr size_t WS_XBCC = 312 * MiB, WS_ATTRAW = 344 * MiB, WS_YRAW = 376 * MiB;
constexpr size_t WS_END = 422 * MiB;
static_assert(WS_R3 + (size_t)MOE_ROWS * DFFE * 2 <= WS_END && WS_R2 + (size_t)MOE_ROWS * DM * 2 <= WS_R3 && WS_WDD + (size_t)DM * DFF * 2 <= WS_AO, "ws map");
constexpr int CW_TMO = 0, CW_CODE = 1, CW_BAR = 4096, CW_ECNT = 16384;

constexpr int RING_OFF = 0, RING_BYTES = 131072;
constexpr int LDSCTL_OFF = RING_BYTES, MISC_OFF = LDSCTL_OFF + 320;
constexpr int LDS_BYTES = 147456;

typedef const float* cfp;
struct Args { const float* in[20]; float* out; unsigned char* ws; int ph_lo, ph_hi; };
static_assert(sizeof(Args) == 184, "Args layout");

__device__ __forceinline__ float wave_sum(float v) {
#pragma unroll
    for (int o = 1; o < 64; o <<= 1) v += __shfl_xor(v, o);
    return v;
}
__device__ __forceinline__ void transpose_item(const float* W, int ldw, bf16* WT, int K, int k0, int n0, int drow0, LAS float* scr, int lane) {
#pragma unroll 8
    for (int i = 0; i < 32; ++i) { const int kk = 2 * i + (lane >> 5); scr[kk * 33 + (lane & 31)] = W[(size_t)(k0 + kk) * ldw + n0 + (lane & 31)]; }
    LDS_WAIT(); asm volatile("" ::: "memory");
    const int c = lane & 7;
#pragma unroll
    for (int j = 0; j < 4; ++j) { const int n = (lane >> 3) + 8 * j; const LAS float* s = scr + (8 * c) * 33 + n;
        v4u o; o.x = pk2(s[0 * 33], s[1 * 33]); o.y = pk2(s[2 * 33], s[3 * 33]); o.z = pk2(s[4 * 33], s[5 * 33]); o.w = pk2(s[6 * 33], s[7 * 33]);
        *(GAS v4u*)(WT + (size_t)(drow0 + n) * K + k0 + 8 * c) = o; }
    LDS_WAIT(); asm volatile("" ::: "memory");
}
__device__ __forceinline__ void conv_plain(const float* W, int ldw, int K, int N, bf16* WT, int it, LAS float* scr, int lane) {
    const int nblk = N / 32, kb = it / nblk, nb = it % nblk;
    transpose_item(W, ldw, WT, K, 64 * kb, 32 * nb, 32 * nb, scr, lane);
}
__device__ __forceinline__ void conv_gu(const float* Wg, const float* Wu, int K, int F, bf16* WT, int it, LAS float* scr, int lane) {
    const int nblk = F / 32, per = (K / 64) * nblk, half = it / per, r = it % per, kb = r / nblk, nb = r % nblk, f0 = 32 * nb;
    transpose_item(half ? Wu : Wg, F, WT, K, 64 * kb, f0, (f0 / 128) * 256 + half * 128 + (f0 % 128), scr, lane);
}

template <bool ROUTE>
__device__ __forceinline__ void norm_rows(const float* X, const float* g, bf16* XN, const LAS float* tab, float* OUT8, int* toke, int* tokr, float* tokg, gu32* ecnt, int gw, int NGW, int lane) {
    f32x4 gv[4];
#pragma unroll
    for (int j = 0; j < 4; ++j) gv[j] = *((const GAS f32x4*)g + lane + 64 * j);
    for (int m = gw; m < MT; m += NGW) {
        const GAS f32x4* xr = (const GAS f32x4*)(X + (size_t)m * DM) + lane;
        f32x4 v[4]; float s = 0.f;
#pragma unroll
        for (int j = 0; j < 4; ++j) { v[j] = xr[64 * j]; s += (v[j].x * v[j].x + v[j].y * v[j].y) + (v[j].z * v[j].z + v[j].w * v[j].w); }
        const float rstd = 1.f / sqrtf(wave_sum(s) * (1.f / DM) + EPS);
        GAS unsigned long long* o8 = (GAS unsigned long long*)(XN + (size_t)m * DM) + lane;
        float d[8];
#pragma unroll
        for (int q = 0; q < 8; ++q) d[q] = 0.f;
#pragma unroll
        for (int j = 0; j < 4; ++j) { v[j] = v[j] * rstd * gv[j];
            o8[64 * j] = (unsigned long long)pk2(v[j].x, v[j].y) | ((unsigned long long)pk2(v[j].z, v[j].w) << 32);
#pragma unroll
            for (int q = 0; q < 8; ++q) { const f32x4 t = *(const LAS f32x4*)(tab + q * 1024 + 4 * lane + 256 * j); d[q] += (v[j].x * t.x + v[j].y * t.y) + (v[j].z * t.z + v[j].w * t.w); } }
#pragma unroll
        for (int q = 0; q < 8; ++q) d[q] = wave_sum(d[q]);
        if (!ROUTE) { if (lane < 8) { float o = d[0];
#pragma unroll
                for (int q = 1; q < 8; ++q) o = (lane == q) ? d[q] : o;
                OUT8[(size_t)m * 8 + lane] = o; } }
        else if (lane == 0) {
            int e1 = 0; float v1 = d[0];
#pragma unroll
            for (int q = 1; q < 8; ++q) if (d[q] > v1) { v1 = d[q]; e1 = q; }
            int e2 = -1; float v2 = -3.0e38f;
#pragma unroll
            for (int q = 0; q < 8; ++q) if (q != e1 && d[q] > v2) { v2 = d[q]; e2 = q; }
            const float g1 = 1.f / (1.f + expf(v2 - v1)), g2 = 1.f - g1;
            const int r1 = (int)__hip_atomic_fetch_add(ecnt + 64 * e1, 1u, RLX_AGENT), r2 = (int)__hip_atomic_fetch_add(ecnt + 64 * e2, 1u, RLX_AGENT);
            toke[2 * m] = e1; toke[2 * m + 1] = e2; tokr[2 * m] = r1; tokr[2 * m + 1] = r2; tokg[2 * m] = g1; tokg[2 * m + 1] = g2;
        }
    }
}
__device__ __forceinline__ void load_tab8(const float* W, int ldw, LAS float* tab, int tid) {
    for (int i = tid; i < 8192; i += NWAVES * 64) { const int k = i >> 3, j = i & 7; tab[j * 1024 + k] = W[(size_t)k * ldw + j]; }
    LDS_WAIT(); __syncthreads();
}

__global__ void k_conv(const bf16* PROJ, const float* cw, const float* cb, const float* dtraw, const float* dtbias, bf16* XBCC, float* DTV) {
    const int idx = blockIdx.x * blockDim.x + threadIdx.x;
    const int m = idx >> 10, ch = idx & 1023, tt = m & (SEQ - 1);
    float a = cb[ch];
#pragma unroll
    for (int k = 0; k < 4; ++k) { const int ts = tt - 3 + k; if (ts >= 0) a += cw[k * 1024 + ch] * bf2f(PROJ[(size_t)(m - 3 + k) * NPROJ + OXBC + ch]); }
    const float s = a / (1.f + expf(-a));
    XBCC[(size_t)m * 1024 + ch] = (bf16)f2bf(s);
    if (ch < 8) { const float z = dtraw[m * 8 + ch] + dtbias[ch]; DTV[m * 8 + ch] = (z > 20.f) ? z : log1pf(expf(z)); }
}
__global__ void __launch_bounds__(64) k_attn_simple(const bf16* PROJ, float* ATT) {
    const int bh = blockIdx.x >> 5, b = bh >> 3, h = bh & 7, t = (blockIdx.x & 31) * 64 + threadIdx.x;
    const size_t row = (size_t)b * SEQ + t;
    float q[64], o[64];
#pragma unroll
    for (int d = 0; d < 64; ++d) { q[d] = bf2f(PROJ[row * NPROJ + OQ + h * 64 + d]); o[d] = 0.f; }
    float R = 0.f;
    for (int j = 1; j <= SEQ; ++j) {
        const int s = t - j; const bool act = (s >= 0) && (R < 120.f);
        if (!__any(act)) break;
        if (act) {
            const bf16* kr = PROJ + ((size_t)b * SEQ + s) * NPROJ + OK_ + h * 64; const bf16* vr = kr + (OV - OK_);
            float z = 0.f;
#pragma unroll
            for (int d = 0; d < 64; ++d) z += q[d] * bf2f(kr[d]);
            const float sp = fmaxf(z, 0.f) + log1pf(expf(-fabsf(z)));
            const float w = expf(z - sp - R);
            R += sp;
#pragma unroll
            for (int d = 0; d < 64; ++d) o[d] += w * bf2f(vr[d]);
        }
    }
#pragma unroll
    for (int d = 0; d < 64; ++d) ATT[row * 512 + h * 64 + d] = o[d];
}
__global__ void __launch_bounds__(64) k_ssd_simple(const bf16* XBCC, const bf16* PROJ, const float* DTV, const float* alog, const float* dskip, float* YRAW) {
    __shared__ float sB[32][128], sC[32][128];
    const int b = blockIdx.x >> 3, h = blockIdx.x & 7, g = h >> 2, p = threadIdx.x;
    const float a = -expf(alog[h]), D = dskip[h];
    float st[128];
#pragma unroll
    for (int n = 0; n < 128; ++n) st[n] = 0.f;
    for (int t0 = 0; t0 < SEQ; t0 += 32) {
        __syncthreads();
        for (int i = p; i < 32 * 128; i += 64) { const int tt = i >> 7, n = i & 127; const size_t r = (size_t)b * SEQ + t0 + tt;
            sB[tt][n] = bf2f(XBCC[r * 1024 + 512 + g * 128 + n]); sC[tt][n] = bf2f(XBCC[r * 1024 + 768 + g * 128 + n]); }
        __syncthreads();
        for (int tt = 0; tt < 32; ++tt) {
            const size_t r = (size_t)b * SEQ + t0 + tt;
            const float dt = DTV[r * 8 + h], dA = expf(dt * a), xv = bf2f(XBCC[r * 1024 + h * 64 + p]), xd = xv * dt;
            float y = 0.f;
#pragma unroll
            for (int n = 0; n < 128; ++n) { st[n] = st[n] * dA + xd * sB[tt][n]; y += st[n] * sC[tt][n]; }
            y += D * xv;
            const float z = bf2f(PROJ[r * NPROJ + OZ + h * 64 + p]);
            YRAW[r * 512 + h * 64 + p] = y * (z / (1.f + expf(-z)));
        }
    }
}
__global__ void k_mixnorm(const float* ATT, const float* YRAW, const float* ga, const float* gs, bf16* AO) {
    const int m = blockIdx.x * 4 + (threadIdx.x >> 6), lane = threadIdx.x & 63;
    float a[8], y[8]; float sa = 0.f, sy = 0.f;
#pragma unroll
    for (int i = 0; i < 8; ++i) { a[i] = ATT[(size_t)m * 512 + lane * 8 + i]; y[i] = YRAW[(size_t)m * 512 + lane * 8 + i]; sa += a[i] * a[i]; sy += y[i] * y[i]; }
    sa = wave_sum(sa);
#pragma unroll
    for (int o = 1; o < 32; o <<= 1) sy += __shfl_xor(sy, o);
    const float ra = 1.f / sqrtf(sa * (1.f / 512.f) + EPS), ry = 1.f / sqrtf(sy * (1.f / 256.f) + EPS);
#pragma unroll
    for (int i = 0; i < 8; ++i) { AO[(size_t)m * 1024 + lane * 8 + i] = (bf16)f2bf(a[i] * ra * ga[lane * 8 + i]); AO[(size_t)m * 1024 + 512 + lane * 8 + i] = (bf16)f2bf(y[i] * ry * gs[lane * 8 + i]); }
}

#define KARGP ((const __attribute__((address_space(4))) char*)__builtin_amdgcn_kernarg_segment_ptr())
enum { PH_PRO = 0, PH_L0 = 1, PH_L1 = 9, PH_GATHER = 15, PH_MOEUP = 16, PH_MOEWD = 17, PH_MOEDN = 18, PH_FINAL = 19, PH_N = 20 };
#define ws (*(unsigned char* const __attribute__((address_space(4)))*)(KARGP + 168))
#define ctl ((gu32*)(ws + WS_CTL))
#define IN(k) (lo <= (k) && (k) < hi)
#define KARG_F(i) (*(const float* const __attribute__((address_space(4)))*)(KARGP + 8 * (i)))
#define x_in KARG_F(0)
#define mix_g KARG_F(1)
#define w_in KARG_F(2)
#define attn_g KARG_F(8)
#define ssd_g KARG_F(9)
#define w_out KARG_F(10)
#define ffn_g KARG_F(11)
#define dwg KARG_F(12)
#define dwu KARG_F(13)
#define dwd KARG_F(14)
#define router_w KARG_F(15)
#define mwg KARG_F(16)
#define mwu KARG_F(17)
#define mwd KARG_F(18)
#define final_g KARG_F(19)
#define X (*(float* const __attribute__((address_space(4)))*)(KARGP + 160))
#define WIN_T ((bf16*)(ws + WS_WIN))
#define WOUT_T ((bf16*)(ws + WS_WOUT))
#define WDGU_T ((bf16*)(ws + WS_WDGU))
#define WDD_T ((bf16*)(ws + WS_WDD))
#define WMGU_T ((bf16*)(ws + WS_R1))
#define WMD_T ((bf16*)(ws + WS_R1))
#define XN ((bf16*)(ws + WS_XN))
#define PROJ ((bf16*)(ws + WS_PROJ))
#define AO ((bf16*)(ws + WS_AO))
#define HB ((bf16*)(ws + WS_HB))
#define HPERM ((bf16*)(ws + WS_R2))
#define YB ((bf16*)(ws + WS_R2))
#define HID ((bf16*)(ws + WS_R3))
#define DTRAW ((float*)(ws + WS_DTRAW))
#define TOKE ((int*)(ws + WS_TOKE))
#define TOKR ((int*)(ws + WS_TOKR))
#define TOKG ((float*)(ws + WS_TOKG))
#define TOKP ((int*)(ws + WS_TOKP))
#define ROWG ((float*)(ws + WS_ROWG))
#define PTAB ((int*)(ws + WS_PTAB))
#define ECNT (ctl + CW_ECNT)

template <int layer>
__device__ __forceinline__ void layer_phases(LAS unsigned char* L, const int lo, const int hi, const int tid, const int lane, const int wave, const int G, const int bx, const int gw, const int NGW) {
        const int pb = layer ? PH_L1 : PH_L0;
        const float* Xin = layer ? (const float*)X : x_in;
        if (IN(pb + 0)) {
            LAS float* tab = (LAS float*)(L + RING_OFF);
            load_tab8(w_in + (size_t)layer * DM * DINP + NPROJ, DINP, tab, tid);
            norm_rows<false>(Xin, mix_g + layer * DM, XN, tab, DTRAW, nullptr, nullptr, nullptr, nullptr, gw, NGW, lane);
        }
        if (IN(pb + 1)) {
            pg8::Gemm g{XN, WIN_T + (size_t)layer * NPROJ * DM, MT, NPROJ, DM}; pg8::StaticOrder S; S.init(MT, NPROJ, G, bx);
            pg8::EpiBf16 E{PROJ, NPROJ, 512, 0.125f};
            pg8::gemm_phase<pg8::EpiBf16, pg8::StaticOrder, true, true>(L + RING_OFF, g, S, E);
        }
        if (IN(pb + 4)) {
            pg8::Gemm g{AO, WOUT_T + (size_t)layer * DM * DM, MT, DM, DM}; pg8::StaticOrder S; S.init(MT, DM, G, bx);
            pg8::EpiResAdd E{Xin, X, DM};
            pg8::gemm_phase<pg8::EpiResAdd, pg8::StaticOrder, true, true>(L + RING_OFF, g, S, E);
        }
        if (IN(pb + 5)) {
            LAS float* tab = (LAS float*)(L + RING_OFF);
            if (layer == 0) { for (int i = tid; i < 8192; i += NWAVES * 64) tab[i] = 0.f; LDS_WAIT(); __syncthreads();
                norm_rows<false>(X, ffn_g, XN, tab, DTRAW, nullptr, nullptr, nullptr, nullptr, gw, NGW, lane); }
            else { load_tab8(router_w, 8, tab, tid);
                norm_rows<true>(X, ffn_g + DM, XN, tab, nullptr, TOKE, TOKR, TOKG, ECNT, gw, NGW, lane); }
        }
    }
__global__ void __launch_bounds__(NWAVES * 64, 2) mk_fwd(Args args) {
    extern __shared__ __attribute__((aligned(16))) unsigned char lds[];
    LAS unsigned char* L = (LAS unsigned char*)lds;
    const int tid = threadIdx.x, lane = tid & 63, wave = __builtin_amdgcn_readfirstlane(tid >> 6);
    const int G = gridDim.x; const int bx = blockIdx.x; const int vcu = (G % 8 == 0) ? (bx % 8) * (G / 8) + bx / 8 : bx;
    const int gw = vcu * NWAVES + wave, NGW = G * NWAVES;
    for (int u = tid; u < (LDS_BYTES - LDSCTL_OFF) / 4; u += NWAVES * 64) ((LAS unsigned*)(L + LDSCTL_OFF))[u] = 0u;
    __syncthreads();
    const int lo = *(const __attribute__((address_space(4))) int*)(KARGP + 176), hi = *(const __attribute__((address_space(4))) int*)(KARGP + 180);
    if (IN(PH_PRO)) {
        LAS float* scr = (LAS float*)(L + RING_OFF + wave * 16384);
        constexpr int I_IN = (DM / 64) * (NPROJ / 32), I_OUT = (DM / 64) * (DM / 32), I_DGU = 2 * (DM / 64) * (DFF / 32), I_DD = (DFF / 64) * (DM / 32), I_MGU = 2 * (DM / 64) * (DFFE / 32);
        constexpr int NITEMS = 2 * I_IN + 2 * I_OUT + I_DGU + I_DD + NE * I_MGU;
        for (int it = gw; it < NITEMS; it += NGW) {
            int r = it;
            if (r < 2 * I_IN) { const int l = r / I_IN; conv_plain(w_in + (size_t)l * DM * DINP, DINP, DM, NPROJ, WIN_T + (size_t)l * NPROJ * DM, r % I_IN, scr, lane); continue; } r -= 2 * I_IN;
            if (r < 2 * I_OUT) { const int l = r / I_OUT; conv_plain(w_out + (size_t)l * DM * DM, DM, DM, DM, WOUT_T + (size_t)l * DM * DM, r % I_OUT, scr, lane); continue; } r -= 2 * I_OUT;
            if (r < I_DGU) { conv_gu(dwg, dwu, DM, DFF, WDGU_T, r, scr, lane); continue; } r -= I_DGU;
            if (r < I_DD) { conv_plain(dwd, DM, DFF, DM, WDD_T, r, scr, lane); continue; } r -= I_DD;
            { const int e = r / I_MGU; conv_gu(mwg + (size_t)e * DM * DFFE, mwu + (size_t)e * DM * DFFE, DM, DFFE, WMGU_T + (size_t)e * 2 * DFFE * DM, r % I_MGU, scr, lane); }
        }
    }
    layer_phases<0>(L, lo, hi, tid, lane, wave, G, bx, gw, NGW);
    if (IN(PH_L0 + 6)) {
        pg8::Gemm g{XN, WDGU_T, MT, 2 * DFF, DM}; pg8::StaticOrder S; S.init(MT, 2 * DFF, G, bx);
        pg8::EpiSwiGLU E{HB, DFF};
        pg8::gemm_phase<pg8::EpiSwiGLU, pg8::StaticOrder, true, true>(L + RING_OFF, g, S, E);
    }
    if (IN(PH_L0 + 7)) {
        pg8::Gemm g{HB, WDD_T, MT, DM, DFF}; pg8::StaticOrder S; S.init(MT, DM, G, bx);
        pg8::EpiResAdd E{X, X, DM};
        pg8::gemm_phase<pg8::EpiResAdd, pg8::StaticOrder, true, true>(L + RING_OFF, g, S, E);
    }
    layer_phases<1>(L, lo, hi, tid, lane, wave, G, bx, gw, NGW);
    if (IN(PH_GATHER)) {
        int off[NE + 1]; off[0] = 0;
#pragma unroll
        for (int e = 0; e < NE; ++e) { const int c = (int)__hip_atomic_load(ECNT + 64 * e, RLX_AGENT); off[e + 1] = off[e] + ((c + 255) & ~255); }
        const int P = off[NE] >> 8;
        if (bx == 0) { if (tid < 256) { int e = 0;
#pragma unroll
                for (int q = 1; q < NE; ++q) e += (tid * 256 >= off[q]) ? 1 : 0;
                PTAB[tid] = (tid < P) ? e : 0; }
            if (tid == 0) PTAB[256] = P; }
        for (int i = gw; i < 2 * MT; i += NGW) {
            const int m = i >> 1, e = TOKE[i], r = TOKR[i];
            int o = 0;
#pragma unroll
            for (int q = 0; q < NE; ++q) o = (e == q) ? off[q] : o;
            const int pos = o + r;
            if (lane == 0) { TOKP[i] = pos; ROWG[pos] = TOKG[i]; }
            const GAS v4u* src = (const GAS v4u*)(XN + (size_t)m * DM); GAS v4u* dst = (GAS v4u*)(HPERM + (size_t)pos * DM);
            dst[lane] = src[lane]; dst[lane + 64] = src[lane + 64];
        }
        for (int i = gw; i < NE * 256; i += NGW) {
            const int e = i >> 8, j = i & 255; int c0 = 0, c1 = 0;
#pragma unroll
            for (int q = 0; q < NE; ++q) { if (e == q) { c0 = off[q]; c1 = off[q + 1]; } }
            const int pos = c0 + (int)__hip_atomic_load(ECNT + 64 * e, RLX_AGENT) + j;
            if (pos < c1) { if (lane == 0) ROWG[pos] = 0.f; GAS v4u* dst = (GAS v4u*)(HPERM + (size_t)pos * DM); const v4u z = {0u, 0u, 0u, 0u}; dst[lane] = z; dst[lane + 64] = z; }
        }
    }
    if (IN(PH_MOEUP)) {
        const int P = PTAB[256];
        pg8::Gemm g{HPERM, WMGU_T, P * 256, 2 * DFFE, DM}; pg8::GroupedOrder S; S.init(P, 2 * DFFE / 256, G, bx, PTAB, (long)2 * DFFE * DM * 2);
        pg8::EpiSwiGLU E{HID, DFFE};
        pg8::gemm_phase<pg8::EpiSwiGLU, pg8::GroupedOrder, true, true>(L + RING_OFF, g, S, E);
    }
    if (IN(PH_MOEWD)) {
        LAS float* scr = (LAS float*)(L + RING_OFF + wave * 16384);
        constexpr int I_MD = (DFFE / 64) * (DM / 32);
        for (int it = gw; it < NE * I_MD; it += NGW) { const int e = it / I_MD; conv_plain(mwd + (size_t)e * DFFE * DM, DM, DFFE, DM, WMD_T + (size_t)e * DM * DFFE, it % I_MD, scr, lane); }
    }
    if (IN(PH_MOEDN)) {
        const int P = PTAB[256];
        pg8::Gemm g{HID, WMD_T, P * 256, DM, DFFE}; pg8::GroupedOrder S; S.init(P, DM / 256, G, bx, PTAB, (long)DM * DFFE * 2);
        pg8::EpiRowScaleBf16 E{YB, DM, ROWG};
        pg8::gemm_phase<pg8::EpiRowScaleBf16, pg8::GroupedOrder, true, true>(L + RING_OFF, g, S, E);
    }
    if (IN(PH_FINAL)) {
        f32x4 gv[4];
#pragma unroll
        for (int j = 0; j < 4; ++j) gv[j] = *((const GAS f32x4*)final_g + lane + 64 * j);
        for (int m = gw; m < MT; m += NGW) {
            GAS f32x4* xr = (GAS f32x4*)(X + (size_t)m * DM) + lane;
            const int pa = TOKP[2 * m], pc = TOKP[2 * m + 1];
            const GAS unsigned long long* ya = (const GAS unsigned long long*)(YB + (size_t)pa * DM) + lane; const GAS unsigned long long* yc = (const GAS unsigned long long*)(YB + (size_t)pc * DM) + lane;
            f32x4 v[4]; float s = 0.f;
#pragma unroll
            for (int j = 0; j < 4; ++j) { v[j] = xr[64 * j]; const unsigned long long a = ya[64 * j], c = yc[64 * j];
                v[j].x += bfbits2f((unsigned)a & 0xffffu) + bfbits2f((unsigned)c & 0xffffu); v[j].y += bfbits2f(((unsigned)a >> 16)) + bfbits2f(((unsigned)c >> 16));
                v[j].z += bfbits2f((unsigned)(a >> 32) & 0xffffu) + bfbits2f((unsigned)(c >> 32) & 0xffffu); v[j].w += bfbits2f((unsigned)(a >> 48)) + bfbits2f((unsigned)(c >> 48));
                s += (v[j].x * v[j].x + v[j].y * v[j].y) + (v[j].z * v[j].z + v[j].w * v[j].w); }
            const float rstd = 1.f / sqrtf(wave_sum(s) * (1.f / DM) + EPS);
#pragma unroll
            for (int j = 0; j < 4; ++j) xr[64 * j] = v[j] * rstd * gv[j];
        }
    }
#undef IN
}

#undef ws
#undef ctl
#undef X
extern "C" void kernel_launch(void* const* d_in, const int* in_sizes, int n_in, void* d_out, int out_size, void* d_ws, size_t ws_size, hipStream_t stream) {
    static int grid = 0;
    if (grid == 0) {
        if (n_in != 20 || in_sizes[0] != MT * DM || out_size != MT * DM || ws_size < WS_END) { fprintf(stderr, "kernel_launch: unexpected shapes / workspace (n_in %d, ws %zu < %zu); nothing launched\n", n_in, ws_size, (size_t)WS_END); grid = -1; return; }
        int dev = 0, cus = 0;
        if (hipGetDevice(&dev) != hipSuccess || hipDeviceGetAttribute(&cus, hipDeviceAttributeMultiprocessorCount, dev) != hipSuccess) { grid = -1; return; }
        if (hipFuncSetAttribute((const void*)mk_fwd, hipFuncAttributeMaxDynamicSharedMemorySize, LDS_BYTES) != hipSuccess) { fprintf(stderr, "kernel_launch: hipFuncSetAttribute failed\n"); grid = -1; return; }
        (void)hipGetLastError();
        grid = cus;
    }
    if (grid < 0) return;
    (void)hipMemsetAsync((char*)d_ws + WS_CTL, 0, CTL_ZERO_BYTES, stream);
    Args a{};
    for (int i = 0; i < 20; ++i) a.in[i] = (const float*)d_in[i];
    a.out = (float*)d_out; a.ws = (unsigned char*)d_ws;
    unsigned char* wsb = (unsigned char*)d_ws;
    auto run = [&](int lo, int hi) { a.ph_lo = lo; a.ph_hi = hi; hipLaunchKernelGGL(mk_fwd, dim3(grid), dim3(NWAVES * 64), LDS_BYTES, stream, a); };
    run(PH_PRO, PH_PRO + 1);
    for (int layer = 0; layer < 2; ++layer) {
        const int pb = layer ? PH_L1 : PH_L0;
        run(pb + 0, pb + 1); run(pb + 1, pb + 2);
        hipLaunchKernelGGL(k_conv, dim3(MT * 1024 / 256), dim3(256), 0, stream, (const bf16*)(wsb + WS_PROJ), (const float*)d_in[3] + layer * 4096, (const float*)d_in[4] + layer * 1024,
                           (const float*)(wsb + WS_DTRAW), (const float*)d_in[5] + layer * 8, (bf16*)(wsb + WS_XBCC), (float*)(wsb + WS_DTV));
        hipLaunchKernelGGL(k_attn_simple, dim3(64 * 32), dim3(64), 0, stream, (const bf16*)(wsb + WS_PROJ), (float*)(wsb + WS_ATTRAW));
        hipLaunchKernelGGL(k_ssd_simple, dim3(64), dim3(64), 0, stream, (const bf16*)(wsb + WS_XBCC), (const bf16*)(wsb + WS_PROJ), (const float*)(wsb + WS_DTV), (const float*)d_in[6] + layer * 8,
                           (const float*)d_in[7] + layer * 8, (float*)(wsb + WS_YRAW));
        hipLaunchKernelGGL(k_mixnorm, dim3(MT / 4), dim3(256), 0, stream, (const float*)(wsb + WS_ATTRAW), (const float*)(wsb + WS_YRAW), (const float*)d_in[8] + layer * 512, (const float*)d_in[9] + layer * 512, (bf16*)(wsb + WS_AO));
        run(pb + 4, pb + 5); run(pb + 5, pb + 6);
        if (layer == 0) { run(pb + 6, pb + 7); run(pb + 7, pb + 8); }
    }
    run(PH_GATHER, PH_GATHER + 1); run(PH_MOEUP, PH_MOEUP + 1); run(PH_MOEWD, PH_MOEWD + 1); run(PH_MOEDN, PH_MOEDN + 1); run(PH_FINAL, PH_FINAL + 1);
}
```

```cpp
#include <hip/hip_runtime.h>
#include <cstdio>
#include <cstdint>
namespace pg8 {
#define PG8_LAS __attribute__((address_space(3)))
typedef unsigned short bf16_t;
typedef short bf16x8 __attribute__((ext_vector_type(8)));
typedef float f32x4 __attribute__((ext_vector_type(4)));
typedef unsigned u32x4 __attribute__((ext_vector_type(4)));
constexpr int BM = 256, BK = 64, HALF = 128, HTB = HALF * BK * 2  , STAGE_BYTES = 8 * HTB, NXCD = 8, WGM = 8;

__host__ __device__ __forceinline__ int lds_byte(int r, int c) { const int st = (r >> 4) * 2 + (c >> 5), rr = r & 15, cc = c & 31, ob = rr * 64 + cc * 2; return st * 1024 + (ob ^ (((ob >> 9) & 1) << 5)); }
__host__ __device__ __forceinline__ void stage_rc(int b, int& R, int& C) { const int st = b / 1024, sb = b % 1024, swz = sb ^ (((sb >> 9) & 1) << 5); R = (st >> 1) * 16 + swz / 64; C = (st & 1) * 32 + (swz % 64) / 2; }
__host__ __device__ __forceinline__ int perm32(int rho) { const int n = rho >> 4, i = rho & 15; return 8 * (i >> 2) + 4 * n + (i & 3); }

struct Unit { int pm, pn; long boff; };
struct Gemm { const bf16_t* A; const bf16_t* Bt; int M, N, K; };

struct StaticOrder {
    int nM, nN, nwg, G, c;
    __host__ __device__ void init(int M, int N, int G_, int c_) { nM = M / BM; nN = N / BM; nwg = nM * nN; G = G_; c = c_; }
    __host__ __device__ bool next(int i, Unit& u) const {
        const long L = (long)i * G + c; if (L >= nwg) return false;
        int wgid = (int)L; { const int q = nwg / NXCD, r = nwg % NXCD, xcd = wgid % NXCD, off = wgid / NXCD; wgid = (xcd < r ? xcd * (q + 1) : r * (q + 1) + (xcd - r) * q) + off; }
        const int nig = WGM * nN, gid = wgid / nig, fm = gid * WGM, gsz = (nM - fm) < WGM ? (nM - fm) : WGM;
        u.pm = fm + ((wgid % nig) % gsz); u.pn = (wgid % nig) / gsz; u.boff = 0; return true;
    }
    __device__ __forceinline__ void a_ready(const Unit&) const {}
    __device__ __forceinline__ void done(const Unit&) const {}
};

__device__ __forceinline__ unsigned cvt_pk_bf16(float lo, float hi) { unsigned r; asm volatile("v_cvt_pk_bf16_f32 %0, %1, %2" : "=v"(r) : "v"(lo), "v"(hi)); return r; }
typedef float f32x2 __attribute__((ext_vector_type(2)));

struct EpiBf16 {
    static constexpr bool PERM = true, AFTER_DRAIN = false;
    bf16_t* O; int ldc; int scale_cols; float scale0;
    __device__ __forceinline__ void operator()(const f32x4 (&acc)[2][2][4][2], const Unit& u, int wr, int wc, int fr, int fq) const {
        const int row0 = u.pm * BM + wr * 64 + fr; const int colt = u.pn * BM;
        const float sc = (colt < scale_cols) ? scale0 : 1.f;
        const int col0 = colt + wc * 32 + 8 * fq;
#pragma unroll
        for (int ai = 0; ai < 2; ++ai)
#pragma unroll
            for (int m = 0; m < 4; ++m) { bf16_t* rowp = O + (size_t)(row0 + ai * HALF + m * 16) * ldc + col0;
#pragma unroll
                for (int bj = 0; bj < 2; ++bj) { f32x4 v0 = acc[ai][bj][m][0] * sc, v1 = acc[ai][bj][m][1] * sc;
                    u32x4 w; w.x = cvt_pk_bf16(v0[0], v0[1]); w.y = cvt_pk_bf16(v0[2], v0[3]); w.z = cvt_pk_bf16(v1[0], v1[1]); w.w = cvt_pk_bf16(v1[2], v1[3]);
                    *(u32x4*)(rowp + bj * HALF) = w; } }
    }
};
__device__ __forceinline__ float silu_mul(float g, float u) { return g * u * __builtin_amdgcn_rcpf(1.f + __builtin_amdgcn_exp2f(-1.4426950408889634f * g)); }
struct EpiSwiGLU {
    static constexpr bool PERM = true, AFTER_DRAIN = false;
    bf16_t* O; int ldc;
    __device__ __forceinline__ void operator()(const f32x4 (&acc)[2][2][4][2], const Unit& u, int wr, int wc, int fr, int fq) const {
        const int row0 = u.pm * BM + wr * 64 + fr; const int col0 = u.pn * HALF + wc * 32 + 8 * fq;
#pragma unroll
        for (int ai = 0; ai < 2; ++ai)
#pragma unroll
            for (int m = 0; m < 4; ++m) { bf16_t* rowp = O + (size_t)(row0 + ai * HALF + m * 16) * ldc + col0;
                const f32x4 g0 = acc[ai][0][m][0], g1 = acc[ai][0][m][1], u0 = acc[ai][1][m][0], u1 = acc[ai][1][m][1];
                u32x4 w; w.x = cvt_pk_bf16(silu_mul(g0[0], u0[0]), silu_mul(g0[1], u0[1])); w.y = cvt_pk_bf16(silu_mul(g0[2], u0[2]), silu_mul(g0[3], u0[3]));
                w.z = cvt_pk_bf16(silu_mul(g1[0], u1[0]), silu_mul(g1[1], u1[1])); w.w = cvt_pk_bf16(silu_mul(g1[2], u1[2]), silu_mul(g1[3], u1[3]));
                *(u32x4*)rowp = w; }
    }
};
struct EpiResAdd {
    static constexpr bool PERM = false, AFTER_DRAIN = false;
    const float* base; float* out; int ldc;
    __device__ __forceinline__ void operator()(const f32x4 (&acc)[2][2][4][2], const Unit& u, int wr, int wc, int fr, int fq) const {
        const int col0 = u.pn * BM + wc * 32 + 4 * fq;
#pragma unroll
        for (int ai = 0; ai < 2; ++ai)
#pragma unroll
            for (int m = 0; m < 4; ++m) { const size_t off = (size_t)(u.pm * BM + ai * HALF + wr * 64 + m * 16 + fr) * ldc + col0;
#pragma unroll
                for (int bj = 0; bj < 2; ++bj)
#pragma unroll
                    for (int n = 0; n < 2; ++n) { const f32x4 bs = *(const f32x4*)(base + off + bj * HALF + n * 16); *(f32x4*)(out + off + bj * HALF + n * 16) = bs + acc[ai][bj][m][n]; } }
    }
};
struct EpiRowScaleBf16 {
    static constexpr bool PERM = true, AFTER_DRAIN = false;
    bf16_t* O; int ldc; const float* rowgate;
    __device__ __forceinline__ void operator()(const f32x4 (&acc)[2][2][4][2], const Unit& u, int wr, int wc, int fr, int fq) const {
        const int row0 = u.pm * BM + wr * 64 + fr; const int col0 = u.pn * BM + wc * 32 + 8 * fq;
#pragma unroll
        for (int ai = 0; ai < 2; ++ai)
#pragma unroll
            for (int m = 0; m < 4; ++m) { const int row = row0 + ai * HALF + m * 16; const float sc = rowgate[row]; bf16_t* rowp = O + (size_t)row * ldc + col0;
#pragma unroll
                for (int bj = 0; bj < 2; ++bj) { f32x4 v0 = acc[ai][bj][m][0] * sc, v1 = acc[ai][bj][m][1] * sc;
                    u32x4 w; w.x = cvt_pk_bf16(v0[0], v0[1]); w.y = cvt_pk_bf16(v0[2], v0[3]); w.z = cvt_pk_bf16(v1[0], v1[1]); w.w = cvt_pk_bf16(v1[2], v1[3]);
                    *(u32x4*)(rowp + bj * HALF) = w; } }
    }
};
struct GroupedOrder {
    int nM, nN, nwg, G, c; const int* ptab; long estride;
    __device__ void init(int nM_, int nN_, int G_, int c_, const int* ptab_, long estride_) { nM = nM_; nN = nN_; nwg = nM * nN; G = G_; c = c_; ptab = ptab_; estride = estride_; }
    __device__ bool next(int i, Unit& u) const {
        const long L = (long)i * G + c; if (L >= nwg) return false;
        int wgid = (int)L; { const int q = nwg / NXCD, r = nwg % NXCD, xcd = wgid % NXCD, off = wgid / NXCD; wgid = (xcd < r ? xcd * (q + 1) : r * (q + 1) + (xcd - r) * q) + off; }
        const int nig = WGM * nN, gid = wgid / nig, fm = gid * WGM, gsz = (nM - fm) < WGM ? (nM - fm) : WGM;
        u.pm = fm + ((wgid % nig) % gsz); u.pn = (wgid % nig) / gsz;
        u.boff = (long)__builtin_amdgcn_readfirstlane(ptab[u.pm]) * estride; return true;
    }
    __device__ __forceinline__ void a_ready(const Unit&) const {}
    __device__ __forceinline__ void done(const Unit&) const {}
};

template <class Epi, class Sched, bool ALIGN_EPI = false, bool SP2 = false>
__device__ __forceinline__ void gemm_phase(PG8_LAS unsigned char* lds, const Gemm g, const Sched& S, const Epi& E) {
    const int tid = threadIdx.x, wid = __builtin_amdgcn_readfirstlane(tid >> 6), lane = tid & 63, wr = wid >> 2, wc = wid & 3, fr = lane & 15, fq = lane >> 4;
    const int K = g.K, nt = K / BK;
    unsigned voffA[2], voffB[2];
#pragma unroll
    for (int i = 0; i < 2; ++i) { int R, C; stage_rc(tid * 16 + i * 8192, R, C); const int Rb = Epi::PERM ? ((R & ~31) + perm32(R & 31)) : R;
        voffA[i] = (unsigned)(R * K + C) * 2u; voffB[i] = (unsigned)(Rb * K + C) * 2u; }
    const size_t kstep = (size_t)(BK * 2);
    const size_t hstep = (size_t)HALF * K * 2;
    const size_t tstep = 2 * hstep;
    const unsigned ldsw = (unsigned)wid * 1024u;
    const int aoff = lds_byte(wr * 64 + fr, fq * 8), boff = lds_byte(wc * 32 + fr, fq * 8);
#define PG8_SA(b, h) (((b) * 2 + (h)) * HTB)
#define PG8_SB(b, h) ((4 + (b) * 2 + (h)) * HTB)
#define PG8_STAGE(bufoff, gbase, voff) do { _Pragma("unroll") for (int _i = 0; _i < 2; ++_i) \
        __builtin_amdgcn_global_load_lds((const unsigned*)((const char*)(gbase) + (voff)[_i]), (PG8_LAS unsigned*)(lds + (bufoff) + ldsw + _i * 8192), 16, 0, 0); } while (0)
#define PG8_LDA(dst, b, h) do { _Pragma("unroll") for (int m = 0; m < 4; ++m) _Pragma("unroll") for (int k = 0; k < 2; ++k) dst[m][k] = *(const PG8_LAS bf16x8*)(lds + PG8_SA(b, h) + aoff + m * 2048 + k * 1024); } while (0)
#define PG8_LDB(dst, b, h) do { _Pragma("unroll") for (int n = 0; n < 2; ++n) _Pragma("unroll") for (int k = 0; k < 2; ++k) dst[n][k] = *(const PG8_LAS bf16x8*)(lds + PG8_SB(b, h) + boff + n * 2048 + k * 1024); } while (0)
#define PG8_MMA(ai, bj, At, Bt) do { __builtin_amdgcn_s_setprio(1); _Pragma("unroll") for (int m = 0; m < 4; ++m) _Pragma("unroll") for (int n = 0; n < 2; ++n) _Pragma("unroll") for (int k = 0; k < 2; ++k) \
        acc[ai][bj][m][n] = __builtin_amdgcn_mfma_f32_16x16x32_bf16(Bt[n][k], At[m][k], acc[ai][bj][m][n], 0, 0, 0); __builtin_amdgcn_s_setprio(0); } while (0)
#define PG8_WAIT_V(n) asm volatile("s_waitcnt vmcnt(" #n ")" ::: "memory")
#define PG8_WAIT_L(n) asm volatile("s_waitcnt lgkmcnt(" #n ")" ::: "memory")
#define PG8_BAR __builtin_amdgcn_s_barrier()
#define PG8_SCHED __builtin_amdgcn_sched_barrier(0)
    Unit cur, nxt; int ui = 0;
    if (!S.next(0, cur)) return;
    f32x4 acc[2][2][4][2];
#pragma unroll
    for (int a = 0; a < 2; ++a)
#pragma unroll
        for (int b = 0; b < 2; ++b)
#pragma unroll
            for (int m = 0; m < 4; ++m)
#pragma unroll
                for (int n = 0; n < 2; ++n) acc[a][b][m][n] = (f32x4){0.f, 0.f, 0.f, 0.f};
    bf16x8 At[4][2], B0[2][2], B1[2][2];
    const char* cA = (const char*)g.A + (size_t)cur.pm * tstep; const char* cB = (const char*)g.Bt + (size_t)cur.pn * tstep + cur.boff;
    S.a_ready(cur);
    if constexpr (SP2) {
        PG8_STAGE(PG8_SB(0, 0), cB, voffB); PG8_STAGE(PG8_SB(0, 1), cB + hstep, voffB); PG8_STAGE(PG8_SA(0, 0), cA, voffA); PG8_STAGE(PG8_SA(0, 1), cA + hstep, voffA);
        if (wr == 1) PG8_BAR;
        PG8_WAIT_V(2); PG8_BAR;
        PG8_STAGE(PG8_SB(1, 0), cB + kstep, voffB); PG8_STAGE(PG8_SA(1, 0), cA + kstep, voffA); PG8_STAGE(PG8_SB(1, 1), cB + hstep + kstep, voffB);
        PG8_WAIT_V(6); PG8_BAR;
    } else {
        PG8_STAGE(PG8_SB(0, 0), cB, voffB); PG8_STAGE(PG8_SA(0, 0), cA, voffA); PG8_STAGE(PG8_SB(0, 1), cB + hstep, voffB); PG8_STAGE(PG8_SA(0, 1), cA + hstep, voffA);
        if (wr == 1) PG8_BAR;
        PG8_WAIT_V(4); PG8_BAR;
        PG8_STAGE(PG8_SB(1, 0), cB + kstep, voffB); PG8_STAGE(PG8_SA(1, 0), cA + kstep, voffA); PG8_STAGE(PG8_SB(1, 1), cB + hstep + kstep, voffB);
        PG8_WAIT_V(6); PG8_BAR;
    }
    for (;;) {
        const bool has_next = S.next(ui + 1, nxt);
        const char* nA = has_next ? (const char*)g.A + (size_t)nxt.pm * tstep : cA; const char* nB = has_next ? (const char*)g.Bt + (size_t)nxt.pn * tstep + nxt.boff : cB;
        for (int t = 0; t < nt; t += 2) {
            const bool last = (t == nt - 2);
            const char* a1 = cA + (size_t)(t + 1) * kstep;
            const char* a2 = last ? nA : cA + (size_t)(t + 2) * kstep; const char* b2 = last ? nB : cB + (size_t)(t + 2) * kstep;
            const char* a3 = a2 + kstep; const char* b3 = b2 + kstep;
            if (last && has_next) S.a_ready(nxt);
            if constexpr (SP2) {
            PG8_LDB(B0, 0, 0); PG8_LDB(B1, 0, 1); PG8_SCHED; PG8_LDA(At, 0, 0); PG8_STAGE(PG8_SA(1, 1), a1 + hstep, voffA);
            PG8_WAIT_V(8); PG8_WAIT_L(0); PG8_BAR; PG8_MMA(0, 0, At, B0); PG8_MMA(0, 1, At, B1); PG8_BAR; PG8_SCHED;
            PG8_LDA(At, 0, 1); PG8_STAGE(PG8_SB(0, 0), b2, voffB); PG8_STAGE(PG8_SB(0, 1), b2 + hstep, voffB); PG8_STAGE(PG8_SA(0, 0), a2, voffA);
            PG8_WAIT_V(8); PG8_WAIT_L(0); PG8_BAR; PG8_MMA(1, 0, At, B0); PG8_MMA(1, 1, At, B1); PG8_BAR; PG8_SCHED;
            PG8_LDB(B0, 1, 0); PG8_LDB(B1, 1, 1); PG8_SCHED; PG8_LDA(At, 1, 0); PG8_STAGE(PG8_SA(0, 1), a2 + hstep, voffA);
            PG8_WAIT_V(8); PG8_WAIT_L(0); PG8_BAR; PG8_MMA(0, 0, At, B0); PG8_MMA(0, 1, At, B1); PG8_BAR; PG8_SCHED;
            PG8_LDA(At, 1, 1); PG8_STAGE(PG8_SB(1, 0), b3, voffB); PG8_STAGE(PG8_SB(1, 1), b3 + hstep, voffB); PG8_STAGE(PG8_SA(1, 0), a3, voffA);
            PG8_WAIT_V(8); PG8_WAIT_L(0); PG8_BAR; PG8_MMA(1, 0, At, B0); PG8_MMA(1, 1, At, B1); PG8_BAR; PG8_SCHED;
            } else {
            PG8_LDB(B0, 0, 0); PG8_SCHED; PG8_LDA(At, 0, 0); PG8_STAGE(PG8_SA(1, 1), a1 + hstep, voffA);
            PG8_WAIT_L(8); PG8_BAR; PG8_WAIT_L(0); PG8_MMA(0, 0, At, B0); PG8_BAR; PG8_SCHED;
            PG8_LDB(B1, 0, 1); PG8_STAGE(PG8_SB(0, 0), b2, voffB);
            PG8_BAR; PG8_WAIT_L(0); PG8_MMA(0, 1, At, B1); PG8_BAR;
            PG8_LDA(At, 0, 1); PG8_STAGE(PG8_SA(0, 0), a2, voffA);
            PG8_BAR; PG8_WAIT_L(0); PG8_MMA(1, 0, At, B0); PG8_BAR; PG8_SCHED;
            PG8_STAGE(PG8_SB(0, 1), b2 + hstep, voffB);
            PG8_WAIT_V(6); PG8_BAR; PG8_MMA(1, 1, At, B1); PG8_BAR;
            PG8_LDB(B0, 1, 0); PG8_SCHED; PG8_LDA(At, 1, 0); PG8_STAGE(PG8_SA(0, 1), a2 + hstep, voffA);
            PG8_WAIT_L(8); PG8_BAR; PG8_WAIT_L(0); PG8_MMA(0, 0, At, B0); PG8_BAR; PG8_SCHED;
            PG8_LDB(B1, 1, 1); PG8_STAGE(PG8_SB(1, 0), b3, voffB);
            PG8_BAR; PG8_WAIT_L(0); PG8_MMA(0, 1, At, B1); PG8_BAR;
            PG8_LDA(At, 1, 1); PG8_STAGE(PG8_SA(1, 0), a3, voffA);
            PG8_BAR; PG8_WAIT_L(0); PG8_MMA(1, 0, At, B0); PG8_BAR; PG8_SCHED;
            PG8_STAGE(PG8_SB(1, 1), b3 + hstep, voffB);
            PG8_WAIT_V(6); PG8_BAR; PG8_MMA(1, 1, At, B1); PG8_BAR;
            }
        }
        if constexpr (ALIGN_EPI) { if (wr == 0) PG8_BAR; }
        if constexpr (!Epi::AFTER_DRAIN) { E(acc, cur, wr, wc, fr, fq); S.done(cur); }
        if (!has_next) break;
#pragma unroll
        for (int a = 0; a < 2; ++a)
#pragma unroll
            for (int b = 0; b < 2; ++b)
#pragma unroll
                for (int m = 0; m < 4; ++m)
#pragma unroll
                    for (int n = 0; n < 2; ++n) acc[a][b][m][n] = (f32x4){0.f, 0.f, 0.f, 0.f};
        cur = nxt; cA = nA; cB = nB; ++ui;
        if constexpr (ALIGN_EPI) { if (wr == 1) PG8_BAR; }
    }
    PG8_WAIT_V(0);
    if constexpr (!ALIGN_EPI) { if (wr == 0) PG8_BAR; }
    PG8_BAR;
    if constexpr (Epi::AFTER_DRAIN) { E.fused(acc, cur, wr, wc, fr, fq, lds, wid, lane); S.done(cur); }
#undef PG8_SA
#undef PG8_SB
#undef PG8_STAGE
#undef PG8_LDA
#undef PG8_LDB
#undef PG8_MMA
#undef PG8_WAIT_V
#undef PG8_WAIT_L
#undef PG8_BAR
#undef PG8_SCHED
}
}

#define GAS __attribute__((address_space(1)))
#define LAS __attribute__((address_space(3)))
typedef unsigned short bf16;
typedef unsigned v4u __attribute__((ext_vector_type(4)));
typedef float f32x4 __attribute__((ext_vector_type(4)));
typedef short bf16x8 __attribute__((ext_vector_type(8)));
typedef GAS unsigned gu32;
typedef GAS unsigned long long gu64;
#define RLX_AGENT __ATOMIC_RELAXED, __HIP_MEMORY_SCOPE_AGENT
#define LDS_WAIT() asm volatile("s_waitcnt lgkmcnt(0)" ::: "memory")
#define VM_WAIT() asm volatile("s_waitcnt vmcnt(0)" ::: "memory")
__device__ __forceinline__ unsigned long long rt() { return __builtin_amdgcn_s_memrealtime(); }
__device__ __forceinline__ unsigned f2bf(float f) { unsigned u = __builtin_bit_cast(unsigned, f); return (u + 0x7fffu + ((u >> 16) & 1u)) >> 16; }
__device__ __forceinline__ unsigned pk2(float lo, float hi) { return f2bf(lo) | (f2bf(hi) << 16); }

#define XB_TMO      128
#define XB_XCNT(j)  (256  + 64 * (j))
#define XB_XSUB(j)  (1280 + 64 * (j))
#define XB_XGEN(j)  (2304 + 64 * (j))
#define XB_TOP      3328
#define XB_TOPGEN   3392
#define XCD_BAR_WORDS 3456
#define XB_SPIN_CAP (1u << 18)

__device__ __forceinline__ unsigned xb_ld(unsigned* p)              { return __hip_atomic_load(p, __ATOMIC_RELAXED, __HIP_MEMORY_SCOPE_AGENT); }
__device__ __forceinline__ unsigned xb_add(unsigned* p, unsigned v) { return __hip_atomic_fetch_add(p, v, __ATOMIC_RELAXED, __HIP_MEMORY_SCOPE_AGENT); }
__device__ __forceinline__ unsigned xb_xcc_id() { return (unsigned)__builtin_amdgcn_s_getreg((3 << 11) | 20) & 0xFu; }
#define XB_SPIN(cond, bar) do { unsigned _sp = 0; while (cond) { __builtin_amdgcn_s_sleep(1); \
    if ((++_sp & 255u) == 0u) { if (xb_ld(&(bar)[XB_TMO])) break; if (_sp > XB_SPIN_CAP) { atomicAdd(&(bar)[XB_TMO], 1u); break; } } } } while (0)

struct XcdBarrier {
    unsigned* bar; unsigned x;
    volatile LAS unsigned* st;
};

__device__ __forceinline__ XcdBarrier xcd_barrier_post(unsigned* bar, volatile LAS unsigned* st) {
    XcdBarrier b; b.bar = bar; b.x = xb_xcc_id(); b.st = st;
    if (threadIdx.x == 0) (void)xb_add(&bar[XB_XCNT(b.x)], 1u);
    return b;
}
__device__ __forceinline__ void xcd_barrier_complete(unsigned* bar, unsigned x, unsigned& nloc, unsigned& nx) {
    const unsigned G = gridDim.x * gridDim.y * gridDim.z;
    unsigned sum, cnt, mine, sp = 0u;
    for (;;) {
        sum = 0u; cnt = 0u; mine = 0u;
#pragma unroll
        for (unsigned j = 0; j < 16; ++j) { const unsigned c = xb_ld(&bar[XB_XCNT(j)]); sum += c; cnt += (c > 0u) ? 1u : 0u; mine = (j == x) ? c : mine; }
        if (sum == G) break;
        __builtin_amdgcn_s_sleep(1);
        if ((++sp & 255u) == 0u) { if (xb_ld(&bar[XB_TMO])) break; if (sp > XB_SPIN_CAP) { atomicAdd(&bar[XB_TMO], 1u); break; } }
    }
    nloc = mine > 0u ? mine : 1u; nx = cnt > 0u ? cnt : 1u;
}

__device__ __forceinline__ void xcd_barrier(const XcdBarrier& b) {
    asm volatile("s_waitcnt vmcnt(0)" ::: "memory");
    __syncthreads();
    if (threadIdx.x == 0) {
        unsigned* bar = b.bar;
        __builtin_amdgcn_s_waitcnt(0);
        unsigned nloc = b.st[0], nx = b.st[1];
        if (nloc == 0u) { xcd_barrier_complete(bar, b.x, nloc, nx); b.st[0] = nloc; b.st[1] = nx; }
        const unsigned old = xb_add(&bar[XB_XSUB(b.x)], 1u);
        const unsigned gen = old / nloc;
        if (old + 1u == (gen + 1u) * nloc) {
            __builtin_amdgcn_fence(__ATOMIC_RELEASE, "agent");
            asm volatile("s_waitcnt vmcnt(0)" ::: "memory");
            const unsigned og = xb_add(&bar[XB_TOP], 1u);
            const unsigned tg = og / nx;
            if (og + 1u == (tg + 1u) * nx) xb_add(&bar[XB_TOPGEN], 1u);
            else XB_SPIN(xb_ld(&bar[XB_TOPGEN]) == tg, bar);
            __builtin_amdgcn_fence(__ATOMIC_ACQUIRE, "agent");
            xb_add(&bar[XB_XGEN(b.x)], 1u);
            asm volatile("s_waitcnt vmcnt(0)" ::: "memory");
        } else {
            XB_SPIN(xb_ld(&bar[XB_XGEN(b.x)]) == gen, bar);
            __builtin_amdgcn_fence(__ATOMIC_ACQUIRE, "agent");
            asm volatile("s_waitcnt vmcnt(0)" ::: "memory");
        }
    }
    __syncthreads();
}

__device__ __forceinline__ float bf2f(bf16 v) { return __builtin_bit_cast(float, (unsigned)v << 16); }
__device__ __forceinline__ float bfbits2f(unsigned bits) { return __builtin_bit_cast(float, bits << 16); }

constexpr int NWAVES = 8;
constexpr int BATCH = 8, SEQ = 2048, DM = 1024, MT = BATCH * SEQ;
constexpr int DINP = 3080, NPROJ = 3072;
constexpr int OQ = 0, OK_ = 512, OV = 1024, OZ = 1536, OXBC = 2048;
constexpr int NH = 8, HD = 64, SSTATE = 128;
constexpr int DFF = 2816, DFFE = 3584, NE = 8;
constexpr int MOE_ROWS = 2 * MT + NE * 256;
constexpr float EPS = 1e-5f;

constexpr size_t MiB = 1u << 20;
constexpr size_t WS_CTL = 0, CTL_ZERO_BYTES = 1 * MiB;
constexpr size_t WS_DTRAW = 1 * MiB, WS_DTV = WS_DTRAW + 512 * 1024;
constexpr size_t WS_TOKE = 2 * MiB, WS_TOKR = WS_TOKE + 128 * 1024, WS_TOKG = WS_TOKR + 128 * 1024, WS_TOKP = WS_TOKG + 128 * 1024;
constexpr size_t WS_ROWG = 2 * MiB + 512 * 1024, WS_PTAB = 3 * MiB;
constexpr size_t WS_R1 = 4 * MiB;
constexpr size_t WS_WIN = 116 * MiB, WS_WOUT = 128 * MiB, WS_WDGU = 132 * MiB, WS_WDD = 143 * MiB;
constexpr size_t WS_AO = 149 * MiB;
constexpr size_t WS_R2 = 116 * MiB;
constexpr size_t WS_R3 = 184 * MiB;
constexpr size_t WS_PROJ = WS_R3, WS_HB = WS_R3, WS_XN = 280 * MiB;
constexpr size_t WS_XBCC = 312 * MiB, WS_ATTRAW = 344 * MiB, WS_YRAW = 376 * MiB;
constexpr size_t WS_END = 422 * MiB;
static_assert(WS_R3 + (size_t)MOE_ROWS * DFFE * 2 <= WS_END && WS_R2 + (size_t)MOE_ROWS * DM * 2 <= WS_R3 && WS_WDD + (size_t)DM * DFF * 2 <= WS_AO, "ws map");
constexpr int CW_TMO = 0, CW_CODE = 1, CW_BAR = 4096, CW_ECNT = 16384;

constexpr int RING_OFF = 0, RING_BYTES = 131072;
constexpr int LDSCTL_OFF = RING_BYTES, MISC_OFF = LDSCTL_OFF + 320;
constexpr int LDS_BYTES = 147456;

typedef const float* cfp;
struct Args { const float* in[20]; float* out; unsigned char* ws; int ph_lo, ph_hi; };
static_assert(sizeof(Args) == 184, "Args layout");

__device__ __forceinline__ float wave_sum(float v) {
#pragma unroll
    for (int o = 1; o < 64; o <<= 1) v += __shfl_xor(v, o);
    return v;
}
__device__ __forceinline__ void transpose_item(const float* W, int ldw, bf16* WT, int K, int k0, int n0, int drow0, LAS float* scr, int lane) {
#pragma unroll 8
    for (int i = 0; i < 32; ++i) { const int kk = 2 * i + (lane >> 5); scr[kk * 33 + (lane & 31)] = W[(size_t)(k0 + kk) * ldw + n0 + (lane & 31)]; }
    LDS_WAIT(); asm volatile("" ::: "memory");
    const int c = lane & 7;
#pragma unroll
    for (int j = 0; j < 4; ++j) { const int n = (lane >> 3) + 8 * j; const LAS float* s = scr + (8 * c) * 33 + n;
        v4u o; o.x = pk2(s[0 * 33], s[1 * 33]); o.y = pk2(s[2 * 33], s[3 * 33]); o.z = pk2(s[4 * 33], s[5 * 33]); o.w = pk2(s[6 * 33], s[7 * 33]);
        *(GAS v4u*)(WT + (size_t)(drow0 + n) * K + k0 + 8 * c) = o; }
    LDS_WAIT(); asm volatile("" ::: "memory");
}
__device__ __forceinline__ void conv_plain(const float* W, int ldw, int K, int N, bf16* WT, int it, LAS float* scr, int lane) {
    const int nblk = N / 32, kb = it / nblk, nb = it % nblk;
    transpose_item(W, ldw, WT, K, 64 * kb, 32 * nb, 32 * nb, scr, lane);
}
__device__ __forceinline__ void conv_gu(const float* Wg, const float* Wu, int K, int F, bf16* WT, int it, LAS float* scr, int lane) {
    const int nblk = F / 32, per = (K / 64) * nblk, half = it / per, r = it % per, kb = r / nblk, nb = r % nblk, f0 = 32 * nb;
    transpose_item(half ? Wu : Wg, F, WT, K, 64 * kb, f0, (f0 / 128) * 256 + half * 128 + (f0 % 128), scr, lane);
}

template <bool ROUTE>
__device__ __forceinline__ void norm_rows(const float* X, const float* g, bf16* XN, const LAS float* tab, float* OUT8, int* toke, int* tokr, float* tokg, gu32* ecnt, int gw, int NGW, int lane) {
    f32x4 gv[4];
#pragma unroll
    for (int j = 0; j < 4; ++j) gv[j] = *((const GAS f32x4*)g + lane + 64 * j);
    for (int m = gw; m < MT; m += NGW) {
        const GAS f32x4* xr = (const GAS f32x4*)(X + (size_t)m * DM) + lane;
        f32x4 v[4]; float s = 0.f;
#pragma unroll
        for (int j = 0; j < 4; ++j) { v[j] = xr[64 * j]; s += (v[j].x * v[j].x + v[j].y * v[j].y) + (v[j].z * v[j].z + v[j].w * v[j].w); }
        const float rstd = 1.f / sqrtf(wave_sum(s) * (1.f / DM) + EPS);
        GAS unsigned long long* o8 = (GAS unsigned long long*)(XN + (size_t)m * DM) + lane;
        float d[8];
#pragma unroll
        for (int q = 0; q < 8; ++q) d[q] = 0.f;
#pragma unroll
        for (int j = 0; j < 4; ++j) { v[j] = v[j] * rstd * gv[j];
            o8[64 * j] = (unsigned long long)pk2(v[j].x, v[j].y) | ((unsigned long long)pk2(v[j].z, v[j].w) << 32);
#pragma unroll
            for (int q = 0; q < 8; ++q) { const f32x4 t = *(const LAS f32x4*)(tab + q * 1024 + 4 * lane + 256 * j); d[q] += (v[j].x * t.x + v[j].y * t.y) + (v[j].z * t.z + v[j].w * t.w); } }
#pragma unroll
        for (int q = 0; q < 8; ++q) d[q] = wave_sum(d[q]);
        if (!ROUTE) { if (lane < 8) { float o = d[0];
#pragma unroll
                for (int q = 1; q < 8; ++q) o = (lane == q) ? d[q] : o;
                OUT8[(size_t)m * 8 + lane] = o; } }
        else if (lane == 0) {
            int e1 = 0; float v1 = d[0];
#pragma unroll
            for (int q = 1; q < 8; ++q) if (d[q] > v1) { v1 = d[q]; e1 = q; }
            int e2 = -1; float v2 = -3.0e38f;
#pragma unroll
            for (int q = 0; q < 8; ++q) if (q != e1 && d[q] > v2) { v2 = d[q]; e2 = q; }
            const float g1 = 1.f / (1.f + expf(v2 - v1)), g2 = 1.f - g1;
            const int r1 = (int)__hip_atomic_fetch_add(ecnt + 64 * e1, 1u, RLX_AGENT), r2 = (int)__hip_atomic_fetch_add(ecnt + 64 * e2, 1u, RLX_AGENT);
            toke[2 * m] = e1; toke[2 * m + 1] = e2; tokr[2 * m] = r1; tokr[2 * m + 1] = r2; tokg[2 * m] = g1; tokg[2 * m + 1] = g2;
        }
    }
}
__device__ __forceinline__ void load_tab8(const float* W, int ldw, LAS float* tab, int tid) {
    for (int i = tid; i < 8192; i += NWAVES * 64) { const int k = i >> 3, j = i & 7; tab[j * 1024 + k] = W[(size_t)k * ldw + j]; }
    LDS_WAIT(); __syncthreads();
}

__device__ __forceinline__ void conv_phase_simple(const bf16* P, const float* cw, const float* cb, const float* dtraw, const float* dtbias, bf16* XB, float* DTV, int gtid, int nthr) {
    for (long idx = gtid; idx < (long)MT * 1024; idx += nthr) {
        const int m = (int)(idx >> 10), ch = (int)(idx & 1023), tt = m & (SEQ - 1);
        float a = cb[ch];
#pragma unroll
        for (int k = 0; k < 4; ++k) { const int ts = tt - 3 + k; if (ts >= 0) a += cw[k * 1024 + ch] * bf2f(P[(size_t)(m - 3 + k) * NPROJ + OXBC + ch]); }
        const float s = a / (1.f + expf(-a));
        XB[(size_t)m * 1024 + ch] = (bf16)f2bf(s);
        if (ch < 8) { const float z = dtraw[m * 8 + ch] + dtbias[ch]; DTV[m * 8 + ch] = (z > 20.f) ? z : log1pf(expf(z)); }
    }
}
__device__ __forceinline__ void attn_phase_simple(const bf16* P, float* ATT, int gtid, int nthr) {
    for (int u = gtid; u < 64 * SEQ; u += nthr) {
        const int bh = u >> 11, b = bh >> 3, h = bh & 7, t = u & (SEQ - 1);
        const size_t row = (size_t)b * SEQ + t;
        float q[64], o[64];
#pragma unroll
        for (int d = 0; d < 64; ++d) { q[d] = bf2f(P[row * NPROJ + OQ + h * 64 + d]); o[d] = 0.f; }
        float R = 0.f;
        for (int j = 1; j <= SEQ; ++j) {
            const int s = t - j; const bool act = (s >= 0) && (R < 120.f);
            if (!__any(act)) break;
            if (act) {
                const bf16* kr = P + ((size_t)b * SEQ + s) * NPROJ + OK_ + h * 64; const bf16* vr = kr + (OV - OK_);
                float z = 0.f;
#pragma unroll
                for (int d = 0; d < 64; ++d) z += q[d] * bf2f(kr[d]);
                const float sp = fmaxf(z, 0.f) + log1pf(expf(-fabsf(z)));
                const float w = expf(z - sp - R);
                R += sp;
#pragma unroll
                for (int d = 0; d < 64; ++d) o[d] += w * bf2f(vr[d]);
            }
        }
#pragma unroll
        for (int d = 0; d < 64; ++d) ATT[row * 512 + h * 64 + d] = o[d];
    }
}
__device__ __forceinline__ void ssd_unit_simple(int unit, const bf16* XB, const bf16* P, const float* DTV, const float* alog, const float* dskip, float* YR, LAS float* sB, LAS float* sC, int tid) {
    const int b = unit >> 3, h = unit & 7, g = h >> 2, p = tid & 63;
    const float a = -expf(alog[h]), D = dskip[h];
    float st[128];
#pragma unroll
    for (int n = 0; n < 128; ++n) st[n] = 0.f;
    for (int t0 = 0; t0 < SEQ; t0 += 32) {
        __syncthreads();
        for (int i = tid; i < 32 * 128; i += NWAVES * 64) { const int tt = i >> 7, n = i & 127; const size_t r = (size_t)b * SEQ + t0 + tt;
            sB[tt * 128 + n] = bf2f(XB[r * 1024 + 512 + g * 128 + n]); sC[tt * 128 + n] = bf2f(XB[r * 1024 + 768 + g * 128 + n]); }
        LDS_WAIT(); __syncthreads();
        if (tid < 64) {
            for (int tt = 0; tt < 32; ++tt) {
                const size_t r = (size_t)b * SEQ + t0 + tt;
                const float dt = DTV[r * 8 + h], dA = expf(dt * a), xv = bf2f(XB[r * 1024 + h * 64 + p]), xd = xv * dt;
                float y = 0.f;
#pragma unroll
                for (int n = 0; n < 128; ++n) { st[n] = st[n] * dA + xd * sB[tt * 128 + n]; y += st[n] * sC[tt * 128 + n]; }
                y += D * xv;
                const float z = bf2f(P[r * NPROJ + OZ + h * 64 + p]);
                YR[r * 512 + h * 64 + p] = y * (z / (1.f + expf(-z)));
            }
        }
    }
}
__device__ __forceinline__ void mixnorm_phase_simple(const float* ATT, const float* YR, const float* ga, const float* gs, bf16* AOo, int gw, int NGW, int lane) {
    for (int m = gw; m < MT; m += NGW) {
        float a[8], y[8]; float sa = 0.f, sy = 0.f;
#pragma unroll
        for (int i = 0; i < 8; ++i) { a[i] = ATT[(size_t)m * 512 + lane * 8 + i]; y[i] = YR[(size_t)m * 512 + lane * 8 + i]; sa += a[i] * a[i]; sy += y[i] * y[i]; }
        sa = wave_sum(sa);
#pragma unroll
        for (int o = 1; o < 32; o <<= 1) sy += __shfl_xor(sy, o);
        const float ra = 1.f / sqrtf(sa * (1.f / 512.f) + EPS), ry = 1.f / sqrtf(sy * (1.f / 256.f) + EPS);
#pragma unroll
        for (int i = 0; i < 8; ++i) { AOo[(size_t)m * 1024 + lane * 8 + i] = (bf16)f2bf(a[i] * ra * ga[lane * 8 + i]); AOo[(size_t)m * 1024 + 512 + lane * 8 + i] = (bf16)f2bf(y[i] * ry * gs[lane * 8 + i]); }
    }
}
#define KARGP ((const __attribute__((address_space(4))) char*)__builtin_amdgcn_kernarg_segment_ptr())
enum { PH_PRO = 0, PH_L0 = 1, PH_L1 = 10, PH_GATHER = 17, PH_MOEUP = 18, PH_MOEWD = 19, PH_MOEDN = 20, PH_FINAL = 21, PH_N = 22 };
#define ws (*(unsigned char* const __attribute__((address_space(4)))*)(KARGP + 168))
#define ctl ((gu32*)(ws + WS_CTL))
#define IN(k) (lo <= (k) && (k) < hi)
#define SEAM(k) do { if (IN(k) && IN((k) + 1)) xcd_barrier(bar); } while (0)
#define KARG_F(i) (*(const float* const __attribute__((address_space(4)))*)(KARGP + 8 * (i)))
#define x_in KARG_F(0)
#define mix_g KARG_F(1)
#define w_in KARG_F(2)
#define attn_g KARG_F(8)
#define ssd_g KARG_F(9)
#define w_out KARG_F(10)
#define ffn_g KARG_F(11)
#define dwg KARG_F(12)
#define dwu KARG_F(13)
#define dwd KARG_F(14)
#define router_w KARG_F(15)
#define mwg KARG_F(16)
#define mwu KARG_F(17)
#define mwd KARG_F(18)
#define final_g KARG_F(19)
#define conv_w KARG_F(3)
#define conv_b KARG_F(4)
#define dt_bias KARG_F(5)
#define a_log KARG_F(6)
#define d_skip KARG_F(7)
#define X (*(float* const __attribute__((address_space(4)))*)(KARGP + 160))
#define WIN_T ((bf16*)(ws + WS_WIN))
#define WOUT_T ((bf16*)(ws + WS_WOUT))
#define WDGU_T ((bf16*)(ws + WS_WDGU))
#define WDD_T ((bf16*)(ws + WS_WDD))
#define WMGU_T ((bf16*)(ws + WS_R1))
#define WMD_T ((bf16*)(ws + WS_R1))
#define XN ((bf16*)(ws + WS_XN))
#define PROJ ((bf16*)(ws + WS_PROJ))
#define AO ((bf16*)(ws + WS_AO))
#define HB ((bf16*)(ws + WS_HB))
#define HPERM ((bf16*)(ws + WS_R2))
#define YB ((bf16*)(ws + WS_R2))
#define HID ((bf16*)(ws + WS_R3))
#define DTRAW ((float*)(ws + WS_DTRAW))
#define DTV ((float*)(ws + WS_DTV))
#define XBCC ((bf16*)(ws + WS_XBCC))
#define ATTRAW ((float*)(ws + WS_ATTRAW))
#define YRAW ((float*)(ws + WS_YRAW))
#define TOKE ((int*)(ws + WS_TOKE))
#define TOKR ((int*)(ws + WS_TOKR))
#define TOKG ((float*)(ws + WS_TOKG))
#define TOKP ((int*)(ws + WS_TOKP))
#define ROWG ((float*)(ws + WS_ROWG))
#define PTAB ((int*)(ws + WS_PTAB))
#define ECNT (ctl + CW_ECNT)

template <int layer>
__device__ __forceinline__ void layer_phases(LAS unsigned char* L, const XcdBarrier& bar, const int lo, const int hi, const int tid, const int lane, const int wave, const int G, const int bx, const int gw, const int NGW) {
        const int pb = layer ? PH_L1 : PH_L0;
        const float* Xin = layer ? (const float*)X : x_in;
        if (IN(pb + 0)) {
            LAS float* tab = (LAS float*)(L + RING_OFF);
            load_tab8(w_in + (size_t)layer * DM * DINP + NPROJ, DINP, tab, tid);
            norm_rows<false>(Xin, mix_g + layer * DM, XN, tab, DTRAW, nullptr, nullptr, nullptr, nullptr, gw, NGW, lane);
        }
        SEAM(pb + 0);
        if (IN(pb + 1)) {
            pg8::Gemm g{XN, WIN_T + (size_t)layer * NPROJ * DM, MT, NPROJ, DM}; pg8::StaticOrder S; S.init(MT, NPROJ, G, bx);
            pg8::EpiBf16 E{PROJ, NPROJ, 512, 0.125f};
            pg8::gemm_phase<pg8::EpiBf16, pg8::StaticOrder, true, true>(L + RING_OFF, g, S, E);
        }
        SEAM(pb + 1);
        if (IN(pb + 2)) conv_phase_simple(PROJ, conv_w + layer * 4096, conv_b + layer * 1024, DTRAW, dt_bias + layer * 8, XBCC, DTV, bx * (NWAVES * 64) + tid, G * NWAVES * 64);
        SEAM(pb + 2);
        if (IN(pb + 3)) {
            if (G > 64) {
                if (bx < 64) ssd_unit_simple(bx, XBCC, PROJ, DTV, a_log + layer * 8, d_skip + layer * 8, YRAW, (LAS float*)(L + RING_OFF), (LAS float*)(L + RING_OFF + 16384), tid);
                else attn_phase_simple(PROJ, ATTRAW, (bx - 64) * (NWAVES * 64) + tid, (G - 64) * NWAVES * 64);
            } else { for (int u = bx; u < 64; u += G) ssd_unit_simple(u, XBCC, PROJ, DTV, a_log + layer * 8, d_skip + layer * 8, YRAW, (LAS float*)(L + RING_OFF), (LAS float*)(L + RING_OFF + 16384), tid);
                attn_phase_simple(PROJ, ATTRAW, bx * (NWAVES * 64) + tid, G * NWAVES * 64); }
        }
        SEAM(pb + 3);
        if (IN(pb + 4)) mixnorm_phase_simple(ATTRAW, YRAW, attn_g + layer * 512, ssd_g + layer * 512, AO, gw, NGW, lane);
        SEAM(pb + 4);
        if (IN(pb + 5)) {
            pg8::Gemm g{AO, WOUT_T + (size_t)layer * DM * DM, MT, DM, DM}; pg8::StaticOrder S; S.init(MT, DM, G, bx);
            pg8::EpiResAdd E{Xin, X, DM};
            pg8::gemm_phase<pg8::EpiResAdd, pg8::StaticOrder, true, true>(L + RING_OFF, g, S, E);
        }
        SEAM(pb + 5);
        if (IN(pb + 6)) {
            LAS float* tab = (LAS float*)(L + RING_OFF);
            if (layer == 0) { for (int i = tid; i < 8192; i += NWAVES * 64) tab[i] = 0.f; LDS_WAIT(); __syncthreads();
                norm_rows<false>(X, ffn_g, XN, tab, DTRAW, nullptr, nullptr, nullptr, nullptr, gw, NGW, lane); }
            else { load_tab8(router_w, 8, tab, tid);
                norm_rows<true>(X, ffn_g + DM, XN, tab, nullptr, TOKE, TOKR, TOKG, ECNT, gw, NGW, lane); }
        }
        SEAM(pb + 6);
    }
__global__ void __launch_bounds__(NWAVES * 64, 2) mk_fwd(Args args) {
    extern __shared__ __attribute__((aligned(16))) unsigned char lds[];
    LAS unsigned char* L = (LAS unsigned char*)lds;
    const int tid = threadIdx.x, lane = tid & 63, wave = __builtin_amdgcn_readfirstlane(tid >> 6);
    const int G = gridDim.x; const int bx = blockIdx.x; const int vcu = (G % 8 == 0) ? (bx % 8) * (G / 8) + bx / 8 : bx;
    const int gw = vcu * NWAVES + wave, NGW = G * NWAVES;
    for (int u = tid; u < (LDS_BYTES - LDSCTL_OFF) / 4; u += NWAVES * 64) ((LAS unsigned*)(L + LDSCTL_OFF))[u] = 0u;
    __syncthreads();
    const int lo = *(const __attribute__((address_space(4))) int*)(KARGP + 176), hi = *(const __attribute__((address_space(4))) int*)(KARGP + 180);
    XcdBarrier bar; bar.bar = (unsigned*)(ctl + CW_BAR); bar.x = 0; bar.st = nullptr;
    if (hi - lo > 1) bar = xcd_barrier_post((unsigned*)(ctl + CW_BAR), (volatile LAS unsigned*)(L + MISC_OFF) + 8);
    if (IN(PH_PRO)) {
        LAS float* scr = (LAS float*)(L + RING_OFF + wave * 16384);
        constexpr int I_IN = (DM / 64) * (NPROJ / 32), I_OUT = (DM / 64) * (DM / 32), I_DGU = 2 * (DM / 64) * (DFF / 32), I_DD = (DFF / 64) * (DM / 32), I_MGU = 2 * (DM / 64) * (DFFE / 32);
        constexpr int NITEMS = 2 * I_IN + 2 * I_OUT + I_DGU + I_DD + NE * I_MGU;
        for (int it = gw; it < NITEMS; it += NGW) {
            int r = it;
            if (r < 2 * I_IN) { const int l = r / I_IN; conv_plain(w_in + (size_t)l * DM * DINP, DINP, DM, NPROJ, WIN_T + (size_t)l * NPROJ * DM, r % I_IN, scr, lane); continue; } r -= 2 * I_IN;
            if (r < 2 * I_OUT) { const int l = r / I_OUT; conv_plain(w_out + (size_t)l * DM * DM, DM, DM, DM, WOUT_T + (size_t)l * DM * DM, r % I_OUT, scr, lane); continue; } r -= 2 * I_OUT;
            if (r < I_DGU) { conv_gu(dwg, dwu, DM, DFF, WDGU_T, r, scr, lane); continue; } r -= I_DGU;
            if (r < I_DD) { conv_plain(dwd, DM, DFF, DM, WDD_T, r, scr, lane); continue; } r -= I_DD;
            { const int e = r / I_MGU; conv_gu(mwg + (size_t)e * DM * DFFE, mwu + (size_t)e * DM * DFFE, DM, DFFE, WMGU_T + (size_t)e * 2 * DFFE * DM, r % I_MGU, scr, lane); }
        }
    }
    SEAM(PH_PRO);
    layer_phases<0>(L, bar, lo, hi, tid, lane, wave, G, bx, gw, NGW);
    if (IN(PH_L0 + 7)) {
        pg8::Gemm g{XN, WDGU_T, MT, 2 * DFF, DM}; pg8::StaticOrder S; S.init(MT, 2 * DFF, G, bx);
        pg8::EpiSwiGLU E{HB, DFF};
        pg8::gemm_phase<pg8::EpiSwiGLU, pg8::StaticOrder, true, true>(L + RING_OFF, g, S, E);
    }
    SEAM(PH_L0 + 7);
    if (IN(PH_L0 + 8)) {
        pg8::Gemm g{HB, WDD_T, MT, DM, DFF}; pg8::StaticOrder S; S.init(MT, DM, G, bx);
        pg8::EpiResAdd E{X, X, DM};
        pg8::gemm_phase<pg8::EpiResAdd, pg8::StaticOrder, true, true>(L + RING_OFF, g, S, E);
    }
    SEAM(PH_L0 + 8);
    layer_phases<1>(L, bar, lo, hi, tid, lane, wave, G, bx, gw, NGW);
    if (IN(PH_GATHER)) {
        int off[NE + 1]; off[0] = 0;
#pragma unroll
        for (int e = 0; e < NE; ++e) { const int c = (int)__hip_atomic_load(ECNT + 64 * e, RLX_AGENT); off[e + 1] = off[e] + ((c + 255) & ~255); }
        const int P = off[NE] >> 8;
        if (bx == 0) { if (tid < 256) { int e = 0;
#pragma unroll
                for (int q = 1; q < NE; ++q) e += (tid * 256 >= off[q]) ? 1 : 0;
                PTAB[tid] = (tid < P) ? e : 0; }
            if (tid == 0) PTAB[256] = P; }
        for (int i = gw; i < 2 * MT; i += NGW) {
            const int m = i >> 1, e = TOKE[i], r = TOKR[i];
            int o = 0;
#pragma unroll
            for (int q = 0; q < NE; ++q) o = (e == q) ? off[q] : o;
            const int pos = o + r;
            if (lane == 0) { TOKP[i] = pos; ROWG[pos] = TOKG[i]; }
            const GAS v4u* src = (const GAS v4u*)(XN + (size_t)m * DM); GAS v4u* dst = (GAS v4u*)(HPERM + (size_t)pos * DM);
            dst[lane] = src[lane]; dst[lane + 64] = src[lane + 64];
        }
        for (int i = gw; i < NE * 256; i += NGW) {
            const int e = i >> 8, j = i & 255; int c0 = 0, c1 = 0;
#pragma unroll
            for (int q = 0; q < NE; ++q) { if (e == q) { c0 = off[q]; c1 = off[q + 1]; } }
            const int pos = c0 + (int)__hip_atomic_load(ECNT + 64 * e, RLX_AGENT) + j;
            if (pos < c1) { if (lane == 0) ROWG[pos] = 0.f; GAS v4u* dst = (GAS v4u*)(HPERM + (size_t)pos * DM); const v4u z = {0u, 0u, 0u, 0u}; dst[lane] = z; dst[lane + 64] = z; }
        }
    }
    SEAM(PH_GATHER);
    if (IN(PH_MOEUP)) {
        const int P = PTAB[256];
        pg8::Gemm g{HPERM, WMGU_T, P * 256, 2 * DFFE, DM}; pg8::GroupedOrder S; S.init(P, 2 * DFFE / 256, G, bx, PTAB, (long)2 * DFFE * DM * 2);
        pg8::EpiSwiGLU E{HID, DFFE};
        pg8::gemm_phase<pg8::EpiSwiGLU, pg8::GroupedOrder, true, true>(L + RING_OFF, g, S, E);
    }
    SEAM(PH_MOEUP);
    if (IN(PH_MOEWD)) {
        LAS float* scr = (LAS float*)(L + RING_OFF + wave * 16384);
        constexpr int I_MD = (DFFE / 64) * (DM / 32);
        for (int it = gw; it < NE * I_MD; it += NGW) { const int e = it / I_MD; conv_plain(mwd + (size_t)e * DFFE * DM, DM, DFFE, DM, WMD_T + (size_t)e * DM * DFFE, it % I_MD, scr, lane); }
    }
    SEAM(PH_MOEWD);
    if (IN(PH_MOEDN)) {
        const int P = PTAB[256];
        pg8::Gemm g{HID, WMD_T, P * 256, DM, DFFE}; pg8::GroupedOrder S; S.init(P, DM / 256, G, bx, PTAB, (long)DM * DFFE * 2);
        pg8::EpiRowScaleBf16 E{YB, DM, ROWG};
        pg8::gemm_phase<pg8::EpiRowScaleBf16, pg8::GroupedOrder, true, true>(L + RING_OFF, g, S, E);
    }
    SEAM(PH_MOEDN);
    if (IN(PH_FINAL)) {
        f32x4 gv[4];
#pragma unroll
        for (int j = 0; j < 4; ++j) gv[j] = *((const GAS f32x4*)final_g + lane + 64 * j);
        for (int m = gw; m < MT; m += NGW) {
            GAS f32x4* xr = (GAS f32x4*)(X + (size_t)m * DM) + lane;
            const int pa = TOKP[2 * m], pc = TOKP[2 * m + 1];
            const GAS unsigned long long* ya = (const GAS unsigned long long*)(YB + (size_t)pa * DM) + lane; const GAS unsigned long long* yc = (const GAS unsigned long long*)(YB + (size_t)pc * DM) + lane;
            f32x4 v[4]; float s = 0.f;
#pragma unroll
            for (int j = 0; j < 4; ++j) { v[j] = xr[64 * j]; const unsigned long long a = ya[64 * j], c = yc[64 * j];
                v[j].x += bfbits2f((unsigned)a & 0xffffu) + bfbits2f((unsigned)c & 0xffffu); v[j].y += bfbits2f(((unsigned)a >> 16)) + bfbits2f(((unsigned)c >> 16));
                v[j].z += bfbits2f((unsigned)(a >> 32) & 0xffffu) + bfbits2f((unsigned)(c >> 32) & 0xffffu); v[j].w += bfbits2f((unsigned)(a >> 48)) + bfbits2f((unsigned)(c >> 48));
                s += (v[j].x * v[j].x + v[j].y * v[j].y) + (v[j].z * v[j].z + v[j].w * v[j].w); }
            const float rstd = 1.f / sqrtf(wave_sum(s) * (1.f / DM) + EPS);
#pragma unroll
            for (int j = 0; j < 4; ++j) xr[64 * j] = v[j] * rstd * gv[j];
        }
    }
#undef IN
}

#undef ws
#undef ctl
#undef X
extern "C" void kernel_launch(void* const* d_in, const int* in_sizes, int n_in, void* d_out, int out_size, void* d_ws, size_t ws_size, hipStream_t stream) {
    static int grid = 0;
    if (grid == 0) {
        if (n_in != 20 || in_sizes[0] != MT * DM || out_size != MT * DM || ws_size < WS_END) { fprintf(stderr, "kernel_launch: unexpected shapes / workspace (n_in %d, ws %zu < %zu); nothing launched\n", n_in, ws_size, (size_t)WS_END); grid = -1; return; }
        int dev = 0, cus = 0;
        if (hipGetDevice(&dev) != hipSuccess || hipDeviceGetAttribute(&cus, hipDeviceAttributeMultiprocessorCount, dev) != hipSuccess) { grid = -1; return; }
        if (hipFuncSetAttribute((const void*)mk_fwd, hipFuncAttributeMaxDynamicSharedMemorySize, LDS_BYTES) != hipSuccess) { fprintf(stderr, "kernel_launch: hipFuncSetAttribute failed\n"); grid = -1; return; }
        int per_cu = 0;
        if (hipOccupancyMaxActiveBlocksPerMultiprocessor(&per_cu, (const void*)mk_fwd, NWAVES * 64, LDS_BYTES) != hipSuccess || per_cu < 1) { fprintf(stderr, "kernel_launch: occupancy query reports %d workgroups per CU for %d B of LDS; the grid would not be resident; nothing launched\n", per_cu, LDS_BYTES); grid = -1; return; }
        (void)hipGetLastError();
        grid = cus;
    }
    if (grid < 0) return;
    (void)hipMemsetAsync((char*)d_ws + WS_CTL, 0, CTL_ZERO_BYTES, stream);
    Args a{};
    for (int i = 0; i < 20; ++i) a.in[i] = (const float*)d_in[i];
    a.out = (float*)d_out; a.ws = (unsigned char*)d_ws;
    auto run = [&](int lo, int hi) { a.ph_lo = lo; a.ph_hi = hi; hipLaunchKernelGGL(mk_fwd, dim3(grid), dim3(NWAVES * 64), LDS_BYTES, stream, a); };
    run(PH_PRO, PH_N);
}
```

```cpp
#include <hip/hip_runtime.h>
#include <cstdio>
#include <cstdint>
namespace pg8 {
#define PG8_LAS __attribute__((address_space(3)))
typedef unsigned short bf16_t;
typedef short bf16x8 __attribute__((ext_vector_type(8)));
typedef short bf16x16 __attribute__((ext_vector_type(16)));
typedef int i32x8 __attribute__((ext_vector_type(8)));
typedef float f32x4 __attribute__((ext_vector_type(4)));
typedef unsigned u32x4 __attribute__((ext_vector_type(4)));
constexpr int BM = 256, BK = 64, HALF = 128, HTB = HALF * BK * 2  , STAGE_BYTES = 8 * HTB, NXCD = 8;

__host__ __device__ __forceinline__ int lds_byte(int r, int c) { const int st = (r >> 4) * 2 + (c >> 5), rr = r & 15, cc = c & 31, ob = rr * 64 + cc * 2; return st * 1024 + (ob ^ (((ob >> 9) & 1) << 5)); }
__host__ __device__ __forceinline__ void stage_rc(int b, int& R, int& C) { const int st = b / 1024, sb = b % 1024, swz = sb ^ (((sb >> 9) & 1) << 5); R = (st >> 1) * 16 + swz / 64; C = (st & 1) * 32 + (swz % 64) / 2; }
__host__ __device__ __forceinline__ int perm32(int rho) { const int n = rho >> 4, i = rho & 15; return 8 * (i >> 2) + 4 * n + (i & 3); }

struct Unit { int pm, pn; long boff; int ord; int arow0, avalid; long aoff, ooff; };
struct Gemm { const bf16_t* A; const bf16_t* Bt; int M, N, K, ld; };

struct StaticOrder {
    int nM, nN, nwg, G, c, WGM;
    __host__ __device__ void init(int M, int N, int G_, int c_, int wgm = 4) { nM = M / BM; nN = N / BM; nwg = nM * nN; G = G_; c = c_; WGM = wgm; }
    __host__ __device__ bool next(int i, Unit& u) const {
        const long L = (long)i * G + c; if (L >= nwg) return false;
        int wgid = (int)L; { const int q = nwg / NXCD, r = nwg % NXCD, xcd = wgid % NXCD, off = wgid / NXCD; wgid = (xcd < r ? xcd * (q + 1) : r * (q + 1) + (xcd - r) * q) + off; }
        const int nig = WGM * nN, gid = wgid / nig, fm = gid * WGM, gsz = (nM - fm) < WGM ? (nM - fm) : WGM;
        u.pm = fm + ((wgid % nig) % gsz); u.pn = (wgid % nig) / gsz; u.boff = 0; u.ord = i; u.arow0 = 0; u.avalid = BM; u.aoff = 0; u.ooff = 0; return true;
    }
    static constexpr bool GATHER = false;
    __device__ __forceinline__ int arow(const Unit&, int r) const { return r; }
    __device__ __forceinline__ void a_ready(const Unit&) const {}
    __device__ __forceinline__ void done(const Unit&) const {}
};

__device__ __forceinline__ unsigned cvt_pk_bf16(float lo, float hi) { unsigned r; asm volatile("v_cvt_pk_bf16_f32 %0, %1, %2" : "=v"(r) : "v"(lo), "v"(hi)); return r; }
typedef float f32x2 __attribute__((ext_vector_type(2)));

__device__ __forceinline__ float rstd_of(const float* rss, int row) {
    const f32x4 a = *(const f32x4*)(rss + (size_t)row * 16), b = *(const f32x4*)(rss + (size_t)row * 16 + 4), c = *(const f32x4*)(rss + (size_t)row * 16 + 8), d = *(const f32x4*)(rss + (size_t)row * 16 + 12);
    const float s = (((a[0] + a[1]) + (a[2] + a[3])) + ((b[0] + b[1]) + (b[2] + b[3]))) + (((c[0] + c[1]) + (c[2] + c[3])) + ((d[0] + d[1]) + (d[2] + d[3])));
    return __builtin_amdgcn_rsqf(s * (1.f / 1024.f) + 1e-5f);
}
__device__ __forceinline__ void epi_st16(void* p, u32x4 w, bool nt) { if (nt) __builtin_nontemporal_store(w, (__attribute__((address_space(1))) u32x4*)p); else *(u32x4*)p = w; }
__device__ __forceinline__ void epi_st8(void* p, unsigned long long w, bool nt) { if (nt) __builtin_nontemporal_store(w, (__attribute__((address_space(1))) unsigned long long*)p); else *(unsigned long long*)p = w; }
struct EpiBf16 {
    static constexpr bool PERM = true, AFTER_DRAIN = false;
    bf16_t* O; int ldc; int scale_cols; float scale0; const PG8_LAS float* rs;
    __device__ __forceinline__ void operator()(const f32x4 (&acc)[2][2][4][2], const Unit& u, int wr, int wc, int fr, int fq, const bool nt) const {
        const int row0 = u.pm * BM + wr * 64 + fr; const int colt = u.pn * BM;
        const float sc = (colt < scale_cols) ? scale0 : 1.f;
        const int col0 = colt + wc * 32 + 8 * fq;
        const PG8_LAS float* rsu = rs + u.ord * 256 + wr * 64 + fr;
#pragma unroll
        for (int ai = 0; ai < 2; ++ai)
#pragma unroll
            for (int m = 0; m < 4; ++m) { bf16_t* rowp = O + (size_t)(row0 + ai * HALF + m * 16) * ldc + col0;
                const float rsv = sc * rsu[ai * HALF + m * 16];
#pragma unroll
                for (int bj = 0; bj < 2; ++bj) { f32x4 v0 = acc[ai][bj][m][0] * rsv, v1 = acc[ai][bj][m][1] * rsv;
                    u32x4 w; w.x = cvt_pk_bf16(v0[0], v0[1]); w.y = cvt_pk_bf16(v0[2], v0[3]); w.z = cvt_pk_bf16(v1[0], v1[1]); w.w = cvt_pk_bf16(v1[2], v1[3]);
                    epi_st16(rowp + bj * HALF, w, nt); } }
    }
};
__device__ __forceinline__ float silu_mul(float g, float u) { return g * u * __builtin_amdgcn_rcpf(1.f + __builtin_amdgcn_exp2f(-1.4426950408889634f * g)); }
__device__ __forceinline__ f32x2 silu_mul2(f32x2 g, f32x2 u) {
    const f32x2 t = g * (-1.4426950408889634f); f32x2 e; e.x = __builtin_amdgcn_exp2f(t.x); e.y = __builtin_amdgcn_exp2f(t.y);
    const f32x2 d = e + 1.0f; f32x2 r; r.x = __builtin_amdgcn_rcpf(d.x); r.y = __builtin_amdgcn_rcpf(d.y);
    return (g * u) * r;
}
__device__ __forceinline__ f32x2 silu_mul2s(f32x2 g, f32x2 u, const float cs, const float is2) {
    const f32x2 t = g * cs; f32x2 e; e.x = __builtin_amdgcn_exp2f(t.x); e.y = __builtin_amdgcn_exp2f(t.y);
    const f32x2 d = e * is2 + is2; f32x2 r; r.x = __builtin_amdgcn_rcpf(d.x); r.y = __builtin_amdgcn_rcpf(d.y);
    return (g * u) * r;
}
__device__ __forceinline__ float inv_sq_scale(float s) { return s > 0.f ? __builtin_amdgcn_rcpf(s * s) : 1e30f; }
struct EpiSwiGLU {
    static constexpr bool PERM = true, AFTER_DRAIN = false;
    bf16_t* O; int ldc; const PG8_LAS float* rs;
    __device__ __forceinline__ void operator()(const f32x4 (&acc)[2][2][4][2], const Unit& u, int wr, int wc, int fr, int fq, const bool nt) const {
        const int row0 = u.pm * BM + wr * 64 + fr; const int col0 = u.pn * HALF + wc * 32 + 8 * fq;
        const PG8_LAS float* rsu = rs + u.ord * 256 + wr * 64 + fr;
#pragma unroll
        for (int ai = 0; ai < 2; ++ai)
#pragma unroll
            for (int m = 0; m < 4; ++m) { bf16_t* rowp = O + (size_t)(row0 + ai * HALF + m * 16) * ldc + col0;
                const float rsv = rsu[ai * HALF + m * 16], cs = rsv * -1.4426950408889634f, is2 = inv_sq_scale(rsv);
                const f32x4 g0 = acc[ai][0][m][0], g1 = acc[ai][0][m][1], u0 = acc[ai][1][m][0], u1 = acc[ai][1][m][1];
                const f32x2 s0 = silu_mul2s((f32x2){g0[0], g0[1]}, (f32x2){u0[0], u0[1]}, cs, is2), s1 = silu_mul2s((f32x2){g0[2], g0[3]}, (f32x2){u0[2], u0[3]}, cs, is2), s2 = silu_mul2s((f32x2){g1[0], g1[1]}, (f32x2){u1[0], u1[1]}, cs, is2), s3 = silu_mul2s((f32x2){g1[2], g1[3]}, (f32x2){u1[2], u1[3]}, cs, is2);
                u32x4 w; w.x = cvt_pk_bf16(s0.x, s0.y); w.y = cvt_pk_bf16(s1.x, s1.y); w.z = cvt_pk_bf16(s2.x, s2.y); w.w = cvt_pk_bf16(s3.x, s3.y);
                epi_st16(rowp, w, nt); }
    }
};
struct EpiSwiGLU8 {
    static constexpr bool PERM = true, AFTER_DRAIN = false;
    unsigned char* O; int ldc; const PG8_LAS float* rs;
    __device__ __forceinline__ void operator()(const f32x4 (&acc)[2][2][4][2], const Unit& u, int wr, int wc, int fr, int fq, const bool nt) const {
        const int row0 = u.pm * BM + wr * 64 + fr; const int col0 = u.pn * HALF + wc * 32 + 8 * fq;
        const PG8_LAS float* rsu = rs + u.ord * 256 + wr * 64 + fr;
#pragma unroll
        for (int ai = 0; ai < 2; ++ai)
#pragma unroll
            for (int m = 0; m < 4; ++m) { unsigned char* rowp = O + (size_t)(row0 + ai * HALF + m * 16) * ldc + col0;
                const float rsv = rsu[ai * HALF + m * 16], cs = rsv * -1.4426950408889634f, is2 = inv_sq_scale(rsv);
                const f32x4 g0 = acc[ai][0][m][0], g1 = acc[ai][0][m][1], u0 = acc[ai][1][m][0], u1 = acc[ai][1][m][1];
                const f32x2 s0 = silu_mul2s((f32x2){g0[0], g0[1]}, (f32x2){u0[0], u0[1]}, cs, is2), s1 = silu_mul2s((f32x2){g0[2], g0[3]}, (f32x2){u0[2], u0[3]}, cs, is2), s2 = silu_mul2s((f32x2){g1[0], g1[1]}, (f32x2){u1[0], u1[1]}, cs, is2), s3 = silu_mul2s((f32x2){g1[2], g1[3]}, (f32x2){u1[2], u1[3]}, cs, is2);
                int w0 = __builtin_bit_cast(int, s0.x), w1 = __builtin_bit_cast(int, s2.x);
                w0 = __builtin_amdgcn_cvt_pk_fp8_f32(s0.x, s0.y, w0, false); w0 = __builtin_amdgcn_cvt_pk_fp8_f32(s1.x, s1.y, w0, true);
                w1 = __builtin_amdgcn_cvt_pk_fp8_f32(s2.x, s2.y, w1, false); w1 = __builtin_amdgcn_cvt_pk_fp8_f32(s3.x, s3.y, w1, true);
                epi_st8(rowp, (unsigned long long)(unsigned)w0 | ((unsigned long long)(unsigned)w1 << 32), nt); }
    }
};
struct EpiResAddNorm {
    static constexpr bool PERM = true, AFTER_DRAIN = false;
    bf16_t* xr; int ldc; float* rss; unsigned char* X8; float asc;
    __device__ __forceinline__ void operator()(const f32x4 (&acc)[2][2][4][2], const Unit& u, int wr, int wc, int fr, int fq, const bool nt) const {
        const int col0 = u.pn * BM + wc * 32 + 8 * fq;
#pragma unroll
        for (int ai = 0; ai < 2; ++ai)
#pragma unroll
            for (int m = 0; m < 4; ++m) { const int row = u.pm * BM + ai * HALF + wr * 64 + m * 16 + fr; const size_t off = (size_t)row * ldc + col0; float ss = 0.f;
#pragma unroll
                for (int bj = 0; bj < 2; ++bj) {
                    const u32x4 q = *(const u32x4*)(xr + off + bj * HALF);
                    const f32x4 b0 = (f32x4){__builtin_bit_cast(float, q.x << 16), __builtin_bit_cast(float, q.x & 0xffff0000u), __builtin_bit_cast(float, q.y << 16), __builtin_bit_cast(float, q.y & 0xffff0000u)};
                    const f32x4 b1 = (f32x4){__builtin_bit_cast(float, q.z << 16), __builtin_bit_cast(float, q.z & 0xffff0000u), __builtin_bit_cast(float, q.w << 16), __builtin_bit_cast(float, q.w & 0xffff0000u)};
                    const f32x4 v0 = b0 + acc[ai][bj][m][0] * asc, v1 = b1 + acc[ai][bj][m][1] * asc;
                    { u32x4 w; w.x = cvt_pk_bf16(v0[0], v0[1]); w.y = cvt_pk_bf16(v0[2], v0[3]); w.z = cvt_pk_bf16(v1[0], v1[1]); w.w = cvt_pk_bf16(v1[2], v1[3]); epi_st16(xr + off + bj * HALF, w, nt); }
                    ss += (v0[0] * v0[0] + v0[1] * v0[1]) + (v0[2] * v0[2] + v0[3] * v0[3]) + (v1[0] * v1[0] + v1[1] * v1[1]) + (v1[2] * v1[2] + v1[3] * v1[3]);
                    if (X8) { int q0 = 0, q1 = 0;
                        q0 = __builtin_amdgcn_cvt_pk_fp8_f32(v0[0], v0[1], q0, false); q0 = __builtin_amdgcn_cvt_pk_fp8_f32(v0[2], v0[3], q0, true);
                        q1 = __builtin_amdgcn_cvt_pk_fp8_f32(v1[0], v1[1], q1, false); q1 = __builtin_amdgcn_cvt_pk_fp8_f32(v1[2], v1[3], q1, true);
                        epi_st8(X8 + off + bj * HALF, (unsigned long long)(unsigned)q0 | ((unsigned long long)(unsigned)q1 << 32), nt); } }
                ss += __shfl_xor(ss, 16); ss += __shfl_xor(ss, 32);
                if (fq == 0) rss[(size_t)row * 16 + u.pn * 4 + wc] = ss; }
    }
};
struct EpiRowScaleBf16 {
    static constexpr bool PERM = true, AFTER_DRAIN = false;
    bf16_t* O; int ldc; const PG8_LAS float* rs;
    __device__ __forceinline__ void operator()(const f32x4 (&acc)[2][2][4][2], const Unit& u, int wr, int wc, int fr, int fq, const bool nt) const {
        const int row0 = u.pm * BM + wr * 64 + fr; const int col0 = u.pn * BM + wc * 32 + 8 * fq;
        const PG8_LAS float* rsu = rs + u.ord * 256 + wr * 64 + fr;
#pragma unroll
        for (int ai = 0; ai < 2; ++ai)
#pragma unroll
            for (int m = 0; m < 4; ++m) { const int row = row0 + ai * HALF + m * 16; const float sc = rsu[ai * HALF + m * 16]; bf16_t* rowp = O + u.ooff + (long)row * ldc + col0;
#pragma unroll
                for (int bj = 0; bj < 2; ++bj) { f32x4 v0 = acc[ai][bj][m][0] * sc, v1 = acc[ai][bj][m][1] * sc;
                    u32x4 w; w.x = cvt_pk_bf16(v0[0], v0[1]); w.y = cvt_pk_bf16(v0[2], v0[3]); w.z = cvt_pk_bf16(v1[0], v1[1]); w.w = cvt_pk_bf16(v1[2], v1[3]);
                    epi_st16(rowp + bj * HALF, w, nt); } }
    }
};
template <bool GATHER_> struct GroupedOrder {
    static constexpr bool GATHER = GATHER_;
    int nM, nN, nwg, G, c, WGM; const PG8_LAS int* pan; const PG8_LAS unsigned short* tok; long estride;
    __device__ void init(int nM_, int nN_, int G_, int c_, const PG8_LAS int* pan_, const PG8_LAS unsigned short* tok_, long estride_, int wgm = 4) { nM = nM_; nN = nN_; nwg = nM * nN; G = G_; c = c_; pan = pan_; tok = tok_; estride = estride_; WGM = wgm; }
    __device__ bool next(int i, Unit& u) const {
        const long L = (long)i * G + c; if (L >= nwg) return false;
        int wgid = (int)L; { const int q = nwg / NXCD, r = nwg % NXCD, xcd = wgid % NXCD, off = wgid / NXCD; wgid = (xcd < r ? xcd * (q + 1) : r * (q + 1) + (xcd - r) * q) + off; }
        const int nig = WGM * nN, gid = wgid / nig, fm = gid * WGM, gsz = (nM - fm) < WGM ? (nM - fm) : WGM;
        u.pm = fm + ((wgid % nig) % gsz); u.pn = (wgid % nig) / gsz;
        const int pe = __builtin_amdgcn_readfirstlane(pan[u.pm]); const int e = pe & 255, j = (pe >> 8) & 255;
        u.boff = (long)e * estride; u.ord = i; u.arow0 = e * 16384 + 256 * j; u.avalid = ((pe >> 16) & 255) + 1; u.aoff = 0; u.ooff = 0; return true;
    }
    __device__ __forceinline__ int arow(const Unit& u, int r) const { return (int)tok[u.ord * 256 + r]; }
    __device__ __forceinline__ void a_ready(const Unit&) const {}
    __device__ __forceinline__ void done(const Unit&) const {}
};
struct TailOrder {
    static constexpr bool GATHER = false;
    int ntail, G, c; const PG8_LAS int* pan; long estride; int es;
    __device__ void init(int P, int G_, int c_, const PG8_LAS int* pan_, long estride_, int es_) { ntail = (P - 128) * 4 * 7; G = G_; c = c_; pan = pan_; estride = estride_; es = es_; }
    __device__ bool next(int i, Unit& u) const {
        const int L = i * G + c; if (L >= ntail) return false;
        const int s = L % 7, t = L / 7; u.pn = t & 3; u.pm = 128 + (t >> 2);
        const int pe = __builtin_amdgcn_readfirstlane(pan[u.pm]); const int e = pe & 255, j = (pe >> 8) & 255;
        u.aoff = (long)s * 512 * es; u.boff = (long)e * estride + (long)s * 512 * es; u.ord = i; u.arow0 = e * 16384 + 256 * j; u.avalid = ((pe >> 16) & 255) + 1;
        u.ooff = ((long)s * 2048 - 32768) * 1024; return true;
    }
    __device__ __forceinline__ int arow(const Unit&, int r) const { return r; }
    __device__ __forceinline__ void a_ready(const Unit&) const {}
    __device__ __forceinline__ void done(const Unit&) const {}
};
template <int MODE, class Sched> __device__ __forceinline__ void fill_rs(PG8_LAS float* tab, const Sched& S, const float* src, int tid, const float mul = 1.f) {
    for (int idx = tid;; idx += 512) { Unit u; if (!S.next(idx >> 8, u)) break;
        const int row = u.pm * BM + (idx & 255);
        tab[idx] = ((MODE == 1) ? rstd_of(src, row) : src[row]) * mul; }
    asm volatile("s_waitcnt lgkmcnt(0)" ::: "memory"); __syncthreads();
}
template <class Sched> __device__ __forceinline__ void fill_grouped(PG8_LAS float* tab, PG8_LAS unsigned short* tok, const Sched& S, const float* srcv, const int* tokv, int tid, const float mul = 1.f) {
    for (int idx = tid;; idx += 512) { Unit u; if (!S.next(idx >> 8, u)) break;
        const int r = idx & 255; const bool v = r < u.avalid;
        tab[idx] = v ? srcv[u.arow0 + r] * mul : 0.f;
        if (tok) tok[idx] = (unsigned short)(v ? tokv[u.arow0 + r] : 0); }
    asm volatile("s_waitcnt lgkmcnt(0)" ::: "memory"); __syncthreads();
}

template <class Epi, class Sched, bool ALIGN_EPI = false, bool SP2 = false, int ES = 2>
__device__ __forceinline__ void gemm_phase(PG8_LAS unsigned char* lds, const Gemm g, const Sched& S, const Epi& E) {
    const int tid = threadIdx.x, wid = __builtin_amdgcn_readfirstlane(tid >> 6), lane = tid & 63, wr = wid >> 2, wc = wid & 3, fr = lane & 15, fq = lane >> 4;
    const int PBy = g.ld * ES, nt = g.K * ES / 128;
    unsigned voffA0[2], voffA1[2], voffB[2];
    const size_t kstep = (size_t)(BK * 2);
    const size_t hstep = (size_t)HALF * PBy;
#pragma unroll
    for (int i = 0; i < 2; ++i) { int R, C; stage_rc(tid * 16 + i * 8192, R, C); const int Rb = Epi::PERM ? ((R & ~31) + perm32(R & 31)) : R;
        voffA0[i] = (unsigned)(R * PBy + C * 2); voffA1[i] = voffA0[i] + (unsigned)hstep; voffB[i] = (unsigned)(Rb * PBy + C * 2); }
#define PG8_SETA(u_) do { if constexpr (Sched::GATHER) { _Pragma("unroll") for (int i_ = 0; i_ < 2; ++i_) { int R_, C_; stage_rc(tid * 16 + i_ * 8192, R_, C_); \
        voffA0[i_] = (unsigned)(S.arow(u_, R_) * PBy + C_ * 2); voffA1[i_] = (unsigned)(S.arow(u_, R_ + HALF) * PBy + C_ * 2); } } } while (0)
    const size_t tstep = 2 * hstep;
    const unsigned ldsw = (unsigned)wid * 1024u;
    const int aoff = lds_byte(wr * 64 + fr, fq * 8), boff = lds_byte(wc * 32 + fr, fq * 8);
#define PG8_SA(b, h) (((b) * 2 + (h)) * HTB)
#define PG8_SB(b, h) ((4 + (b) * 2 + (h)) * HTB)
#define PG8_STAGE(bufoff, gbase, voff) do { _Pragma("unroll") for (int _i = 0; _i < 2; ++_i) \
        __builtin_amdgcn_global_load_lds((const unsigned*)((const char*)(gbase) + (voff)[_i]), (PG8_LAS unsigned*)(lds + (bufoff) + ldsw + _i * 8192), 16, 0, 0); } while (0)
#define PG8_LD8(p_) ({ const u32x4 lo_ = *(const PG8_LAS u32x4*)(p_), hi_ = *(const PG8_LAS u32x4*)((p_) + 1024); (i32x8){(int)lo_.x, (int)lo_.y, (int)lo_.z, (int)lo_.w, (int)hi_.x, (int)hi_.y, (int)hi_.z, (int)hi_.w}; })
#define PG8_LDA(dst, b, h) do { if constexpr (ES == 2) { _Pragma("unroll") for (int m = 0; m < 4; ++m) _Pragma("unroll") for (int k = 0; k < 2; ++k) dst[m][k] = *(const PG8_LAS bf16x8*)(lds + PG8_SA(b, h) + aoff + m * 2048 + k * 1024); } \
        else { _Pragma("unroll") for (int m = 0; m < 4; ++m) dst##8[m] = PG8_LD8(lds + PG8_SA(b, h) + aoff + m * 2048); } } while (0)
#define PG8_LDB(dst, b, h) do { if constexpr (ES == 2) { _Pragma("unroll") for (int n = 0; n < 2; ++n) _Pragma("unroll") for (int k = 0; k < 2; ++k) dst[n][k] = *(const PG8_LAS bf16x8*)(lds + PG8_SB(b, h) + boff + n * 2048 + k * 1024); } \
        else { _Pragma("unroll") for (int n = 0; n < 2; ++n) dst##8[n] = PG8_LD8(lds + PG8_SB(b, h) + boff + n * 2048); } } while (0)
#define PG8_MMA(ai, bj, At, Bt) do { __builtin_amdgcn_s_setprio(1); _Pragma("unroll") for (int m = 0; m < 4; ++m) _Pragma("unroll") for (int n = 0; n < 2; ++n) { \
        if constexpr (ES == 2) { _Pragma("unroll") for (int k = 0; k < 2; ++k) acc[ai][bj][m][n] = __builtin_amdgcn_mfma_f32_16x16x32_bf16(Bt[n][k], At[m][k], acc[ai][bj][m][n], 0, 0, 0); } \
        else asm volatile("v_mfma_scale_f32_16x16x128_f8f6f4 %0, %1, %2, %0, %3, %3 op_sel_hi:[0,0,0]" : "+v"(acc[ai][bj][m][n]) : "v"(Bt##8[n]), "v"(At##8[m]), "v"(0x7F7F7F7F)); } \
        __builtin_amdgcn_s_setprio(0); } while (0)
#define PG8_WAIT_V(n) asm volatile("s_waitcnt vmcnt(" #n ")" ::: "memory")
#define PG8_WAIT_L(n) asm volatile("s_waitcnt lgkmcnt(" #n ")" ::: "memory")
#define PG8_BAR __builtin_amdgcn_s_barrier()
#define PG8_SCHED __builtin_amdgcn_sched_barrier(0)
    Unit cur, nxt; int ui = 0;
    if (!S.next(0, cur)) return;
    f32x4 acc[2][2][4][2];
#pragma unroll
    for (int a = 0; a < 2; ++a)
#pragma unroll
        for (int b = 0; b < 2; ++b)
#pragma unroll
            for (int m = 0; m < 4; ++m)
#pragma unroll
                for (int n = 0; n < 2; ++n) acc[a][b][m][n] = (f32x4){0.f, 0.f, 0.f, 0.f};
    bf16x8 At[4][2], B0[2][2], B1[2][2]; i32x8 At8[4], B08[2], B18[2];
    const char* cA = (const char*)g.A + (Sched::GATHER ? (size_t)0 : (size_t)cur.pm * tstep) + cur.aoff; const char* cB = (const char*)g.Bt + (size_t)cur.pn * tstep + cur.boff;
    S.a_ready(cur);
    static_assert(SP2, "only the two-super-phase loop is kept in this file");
    PG8_SETA(cur);
    {
        PG8_STAGE(PG8_SB(0, 0), cB, voffB); PG8_STAGE(PG8_SB(0, 1), cB + hstep, voffB); PG8_STAGE(PG8_SA(0, 0), cA, voffA0); PG8_STAGE(PG8_SA(0, 1), cA, voffA1);
        if (wr == 1) PG8_BAR;
        PG8_WAIT_V(2); PG8_BAR;
        PG8_STAGE(PG8_SB(1, 0), cB + kstep, voffB); PG8_STAGE(PG8_SA(1, 0), cA + kstep, voffA0); PG8_STAGE(PG8_SB(1, 1), cB + hstep + kstep, voffB);
        PG8_WAIT_V(6); PG8_BAR;
    }
    for (;;) {
        const bool has_next = S.next(ui + 1, nxt);
        const char* nA = has_next ? (const char*)g.A + (Sched::GATHER ? (size_t)0 : (size_t)nxt.pm * tstep) + nxt.aoff : cA; const char* nB = has_next ? (const char*)g.Bt + (size_t)nxt.pn * tstep + nxt.boff : cB;
        for (int t = 0; t < nt; t += 2) {
            const bool last = (t == nt - 2);
            const char* a1 = cA + (size_t)(t + 1) * kstep;
            const char* a2 = last ? nA : cA + (size_t)(t + 2) * kstep; const char* b2 = last ? nB : cB + (size_t)(t + 2) * kstep;
            const char* a3 = a2 + kstep; const char* b3 = b2 + kstep;
            if (last && has_next) S.a_ready(nxt);
            {
            PG8_LDB(B0, 0, 0); PG8_LDB(B1, 0, 1); PG8_SCHED; PG8_LDA(At, 0, 0); PG8_STAGE(PG8_SA(1, 1), a1, voffA1);
            if (last && has_next) PG8_SETA(nxt);
            PG8_WAIT_V(8); PG8_WAIT_L(0); PG8_BAR; PG8_MMA(0, 0, At, B0); PG8_MMA(0, 1, At, B1); PG8_BAR; PG8_SCHED;
            PG8_LDA(At, 0, 1); PG8_STAGE(PG8_SB(0, 0), b2, voffB); PG8_STAGE(PG8_SB(0, 1), b2 + hstep, voffB); PG8_STAGE(PG8_SA(0, 0), a2, voffA0);
            PG8_WAIT_V(8); PG8_WAIT_L(0); PG8_BAR; PG8_MMA(1, 0, At, B0); PG8_MMA(1, 1, At, B1); PG8_BAR; PG8_SCHED;
            PG8_LDB(B0, 1, 0); PG8_LDB(B1, 1, 1); PG8_SCHED; PG8_LDA(At, 1, 0); PG8_STAGE(PG8_SA(0, 1), a2, voffA1);
            PG8_WAIT_V(8); PG8_WAIT_L(0); PG8_BAR; PG8_MMA(0, 0, At, B0); PG8_MMA(0, 1, At, B1); PG8_BAR; PG8_SCHED;
            PG8_LDA(At, 1, 1); PG8_STAGE(PG8_SB(1, 0), b3, voffB); PG8_STAGE(PG8_SB(1, 1), b3 + hstep, voffB); PG8_STAGE(PG8_SA(1, 0), a3, voffA0);
            PG8_WAIT_V(8); PG8_WAIT_L(0); PG8_BAR; PG8_MMA(1, 0, At, B0); PG8_MMA(1, 1, At, B1); PG8_BAR; PG8_SCHED;
            }
        }
        if constexpr (ALIGN_EPI) { if (wr == 0) PG8_BAR; }
        if constexpr (ES == 1) asm volatile("s_nop 15\n\ts_nop 15\n\ts_nop 15" ::: "memory");
        if constexpr (!Epi::AFTER_DRAIN) { E(acc, cur, wr, wc, fr, fq, !has_next); S.done(cur); }
        if (!has_next) break;
#pragma unroll
        for (int a = 0; a < 2; ++a)
#pragma unroll
            for (int b = 0; b < 2; ++b)
#pragma unroll
                for (int m = 0; m < 4; ++m)
#pragma unroll
                    for (int n = 0; n < 2; ++n) acc[a][b][m][n] = (f32x4){0.f, 0.f, 0.f, 0.f};
        cur = nxt; cA = nA; cB = nB; ++ui;
        if constexpr (ALIGN_EPI) { if (wr == 1) PG8_BAR; }
    }
    PG8_WAIT_V(0);
    if constexpr (!ALIGN_EPI) { if (wr == 0) PG8_BAR; }
    PG8_BAR;
    if constexpr (Epi::AFTER_DRAIN) { E.fused(acc, cur, wr, wc, fr, fq, lds, wid, lane); S.done(cur); }
#undef PG8_SA
#undef PG8_SB
#undef PG8_STAGE
#undef PG8_SETA
#undef PG8_LDA
#undef PG8_LDB
#undef PG8_MMA
#undef PG8_LD8
#undef PG8_WAIT_V
#undef PG8_WAIT_L
#undef PG8_BAR
#undef PG8_SCHED
}
}

#define GAS __attribute__((address_space(1)))
#define LAS __attribute__((address_space(3)))
typedef unsigned short bf16;
typedef unsigned v4u __attribute__((ext_vector_type(4)));
typedef float f32x4 __attribute__((ext_vector_type(4)));
typedef short bf16x8 __attribute__((ext_vector_type(8)));
typedef GAS unsigned gu32;
typedef GAS unsigned long long gu64;
#define RLX_AGENT __ATOMIC_RELAXED, __HIP_MEMORY_SCOPE_AGENT
#define LDS_WAIT() asm volatile("s_waitcnt lgkmcnt(0)" ::: "memory")
#define VM_WAIT() asm volatile("s_waitcnt vmcnt(0)" ::: "memory")
__device__ __forceinline__ unsigned long long rt() { return __builtin_amdgcn_s_memrealtime(); }
__device__ __forceinline__ unsigned f2bf(float f) { unsigned u = __builtin_bit_cast(unsigned, f); return (u + 0x7fffu + ((u >> 16) & 1u)) >> 16; }
__device__ __forceinline__ unsigned pk2(float lo, float hi) { return f2bf(lo) | (f2bf(hi) << 16); }

#define XB_TMO      128
#define XB_XCNT(j)  (256  + 64 * (j))
#define XB_XSUB(j)  (1280 + 64 * (j))
#define XB_XGEN(j)  (2304 + 64 * (j))
#define XB_TOP      3328
#define XB_TOPGEN   3392
#define XCD_BAR_WORDS 3456
#define XB_SPIN_CAP (1u << 18)

__device__ __forceinline__ unsigned xb_ld(unsigned* p)              { return __hip_atomic_load(p, __ATOMIC_RELAXED, __HIP_MEMORY_SCOPE_AGENT); }
__device__ __forceinline__ unsigned xb_add(unsigned* p, unsigned v) { return __hip_atomic_fetch_add(p, v, __ATOMIC_RELAXED, __HIP_MEMORY_SCOPE_AGENT); }
__device__ __forceinline__ unsigned xb_xcc_id() { return (unsigned)__builtin_amdgcn_s_getreg((3 << 11) | 20) & 0xFu; }
#define XB_SPIN(cond, bar) do { unsigned _sp = 0; while (cond) { __builtin_amdgcn_s_sleep(1); \
    if ((++_sp & 255u) == 0u) { if (xb_ld(&(bar)[XB_TMO])) break; if (_sp > XB_SPIN_CAP) { atomicAdd(&(bar)[XB_TMO], 1u); break; } } } } while (0)

struct XcdBarrier {
    unsigned* bar; unsigned x;
    volatile LAS unsigned* st;
};

__device__ __forceinline__ XcdBarrier xcd_barrier_post(unsigned* bar, volatile LAS unsigned* st) {
    XcdBarrier b; b.bar = bar; b.x = xb_xcc_id(); b.st = st;
    if (threadIdx.x == 0) (void)xb_add(&bar[XB_XCNT(b.x)], 1u);
    return b;
}
__device__ __forceinline__ void xcd_barrier_complete(unsigned* bar, unsigned x, unsigned& nloc, unsigned& nx) {
    const unsigned G = gridDim.x * gridDim.y * gridDim.z;
    unsigned sum, cnt, mine, sp = 0u;
    for (;;) {
        sum = 0u; cnt = 0u; mine = 0u;
#pragma unroll
        for (unsigned j = 0; j < 16; ++j) { const unsigned c = xb_ld(&bar[XB_XCNT(j)]); sum += c; cnt += (c > 0u) ? 1u : 0u; mine = (j == x) ? c : mine; }
        if (sum == G) break;
        __builtin_amdgcn_s_sleep(1);
        if ((++sp & 255u) == 0u) { if (xb_ld(&bar[XB_TMO])) break; if (sp > XB_SPIN_CAP) { atomicAdd(&bar[XB_TMO], 1u); break; } }
    }
    nloc = mine > 0u ? mine : 1u; nx = cnt > 0u ? cnt : 1u;
}

__device__ __forceinline__ void xcd_barrier(const XcdBarrier& b) {
    asm volatile("s_waitcnt vmcnt(0)" ::: "memory");
    __syncthreads();
    if (threadIdx.x == 0) {
        unsigned* bar = b.bar;
        __builtin_amdgcn_s_waitcnt(0);
        unsigned nloc = b.st[0], nx = b.st[1];
        if (nloc == 0u) { xcd_barrier_complete(bar, b.x, nloc, nx); b.st[0] = nloc; b.st[1] = nx; }
        const unsigned old = xb_add(&bar[XB_XSUB(b.x)], 1u);
        const unsigned gen = old / nloc;
        if (old + 1u == (gen + 1u) * nloc) {
            __builtin_amdgcn_fence(__ATOMIC_RELEASE, "agent");
            asm volatile("s_waitcnt vmcnt(0)" ::: "memory");
            const unsigned og = xb_add(&bar[XB_TOP], 1u);
            const unsigned tg = og / nx;
            if (og + 1u == (tg + 1u) * nx) xb_add(&bar[XB_TOPGEN], 1u);
            else XB_SPIN(xb_ld(&bar[XB_TOPGEN]) == tg, bar);
            __builtin_amdgcn_fence(__ATOMIC_ACQUIRE, "agent");
            xb_add(&bar[XB_XGEN(b.x)], 1u);
            asm volatile("s_waitcnt vmcnt(0)" ::: "memory");
        } else {
            XB_SPIN(xb_ld(&bar[XB_XGEN(b.x)]) == gen, bar);
            __builtin_amdgcn_fence(__ATOMIC_ACQUIRE, "agent");
            asm volatile("s_waitcnt vmcnt(0)" ::: "memory");
        }
    }
    __syncthreads();
}

__device__ __forceinline__ void xcd_arrive(const XcdBarrier& b, unsigned* bar2) {
    asm volatile("s_waitcnt vmcnt(0)" ::: "memory");
    __syncthreads();
    if (threadIdx.x == 0) {
        __builtin_amdgcn_s_waitcnt(0);
        const unsigned nloc = b.st[0], nx = b.st[1];
        const unsigned old = xb_add(&bar2[XB_XSUB(b.x)], 1u);
        const unsigned gen = old / nloc;
        if (old + 1u == (gen + 1u) * nloc) {
            __builtin_amdgcn_fence(__ATOMIC_RELEASE, "agent");
            asm volatile("s_waitcnt vmcnt(0)" ::: "memory");
            const unsigned og = xb_add(&bar2[XB_TOP], 1u);
            const unsigned tg = og / nx;
            if (og + 1u == (tg + 1u) * nx) xb_add(&bar2[XB_TOPGEN], 1u);
        }
    }
}
__device__ __forceinline__ void xcd_wait(const XcdBarrier& b, unsigned* bar2, const unsigned g) {
    if (threadIdx.x == 0) {
        XB_SPIN(xb_ld(&bar2[XB_TOPGEN]) < g, b.bar);
        __builtin_amdgcn_fence(__ATOMIC_ACQUIRE, "agent");
        asm volatile("s_waitcnt vmcnt(0)" ::: "memory");
    }
    __syncthreads();
}

__device__ __forceinline__ float bf2f(bf16 v) { return __builtin_bit_cast(float, (unsigned)v << 16); }
__device__ __forceinline__ float bfbits2f(unsigned bits) { return __builtin_bit_cast(float, bits << 16); }

constexpr int NWAVES = 8;
constexpr int BATCH = 8, SEQ = 2048, DM = 1024, MT = BATCH * SEQ;
constexpr int DINP = 3080, NPROJ = 3072;
constexpr int OQ = 0, OK_ = 512, OV = 1024, OZ = 1536, OXBC = 2048;
constexpr int NH = 8, HD = 64, SSTATE = 128;
constexpr int DFF = 2816, DFFE = 3584, NE = 8;
constexpr int MOE_ROWS = 2 * MT + NE * 256;
constexpr float EPS = 1e-5f;
constexpr int NE_PRO = 5;
constexpr float WU_SCALE = 32.f;
constexpr float WD_SCALE = 64.f;

constexpr size_t MiB = 1u << 20;
constexpr size_t WS_CTL = 0, CTL_ZERO_BYTES = 1 * MiB;
constexpr size_t WS_DTRAW = 1 * MiB, WS_DTV = WS_DTRAW + 512 * 1024;
constexpr size_t WS_TOKE = 2 * MiB, WS_TOKR = WS_TOKE + 128 * 1024, WS_TOKG = WS_TOKR + 128 * 1024, WS_TOKP = WS_TOKG + 128 * 1024;
constexpr size_t WS_ROWG = 2 * MiB + 512 * 1024, WS_ROWS = WS_ROWG + 160 * 1024, WS_PTAB = 3 * MiB, WS_WDT = 3 * MiB + 64 * 1024;
constexpr size_t WS_RTOKV = 1 * MiB, WS_RGV = 1 * MiB + 512 * 1024, WS_RSV = 3 * MiB + 256 * 1024;
constexpr size_t WS_RSS = 424 * MiB;
constexpr size_t WS_R1 = 4 * MiB;
constexpr size_t WS_WIN = 116 * MiB, WS_WOUT = 128 * MiB, WS_WDGU = 132 * MiB, WS_WDD = 143 * MiB;
constexpr size_t WS_AO = 149 * MiB;
constexpr size_t WS_R2 = 116 * MiB;
constexpr size_t WS_R3 = 184 * MiB;
constexpr size_t WS_PROJ = WS_R3, WS_HB = WS_R3, WS_XN = 428 * MiB;
constexpr size_t WS_XBCC = 312 * MiB, WS_ATTRAW = 328 * MiB, WS_XR = 344 * MiB, WS_YRAW = 376 * MiB;
constexpr size_t WS_ST2 = 408 * MiB;
constexpr size_t WS_END = 460 * MiB;
static_assert(WS_R3 + (size_t)MOE_ROWS * DFFE * 2 <= WS_END && WS_R2 + (size_t)MOE_ROWS * DM * 2 <= WS_R3 && WS_WDD + (size_t)DM * DFF * 2 <= WS_AO, "ws map");
constexpr int CW_TMO = 0, CW_CODE = 1, CW_BAR = 4096, CW_BAR2 = 8192, CW_ECNT = 16384;

constexpr int RING_OFF = 0, RING_BYTES = 159744;
constexpr int LDSCTL_OFF = RING_BYTES, MISC_OFF = LDSCTL_OFF + 320;
constexpr int TOK_TAB_OFF = 131072 + 15360, PAN_TAB_OFF = TOK_TAB_OFF + 7680;
constexpr int RS_TAB_OFF = 131072;
constexpr int LDS_BYTES = 163840;

typedef const float* cfp;
struct Args { const float* in[20]; float* out; unsigned char* ws; int ph_lo, ph_hi; };
static_assert(sizeof(Args) == 184, "Args layout");

template <int CTRL, int RMASK> __device__ __forceinline__ float dpp_addf(float v) {
    return v + __builtin_bit_cast(float, __builtin_amdgcn_update_dpp(0, __builtin_bit_cast(int, v), CTRL, RMASK, 0xf, true)); }
__device__ __forceinline__ float half_sums(float x) { x = dpp_addf<0xB1, 0xf>(x); x = dpp_addf<0x4E, 0xf>(x); x = dpp_addf<0x141, 0xf>(x); x = dpp_addf<0x140, 0xf>(x); return dpp_addf<0x142, 0xa>(x); }
__device__ __forceinline__ float wave_sum(float v) {
    const float x = half_sums(v);
    return __builtin_bit_cast(float, __builtin_amdgcn_readlane(__builtin_bit_cast(int, x), 31)) + __builtin_bit_cast(float, __builtin_amdgcn_readlane(__builtin_bit_cast(int, x), 63));
}
__device__ __forceinline__ void transpose_item(const float* W, int ldw, bf16* WT, int K, int k0, int n0, int drow0, LAS unsigned char* scr, int lane, const float* gk = nullptr) {
    const int kq = lane >> 4, n4 = lane & 15;
    const float* src = W + (size_t)(k0 + 16 * kq) * ldw + n0 + 4 * n4;
    f32x4 v[16];
#pragma unroll
    for (int i = 0; i < 16; ++i) v[i] = __builtin_nontemporal_load((const GAS f32x4*)(src + (size_t)i * ldw));
    if (gk) {
#pragma unroll
        for (int i = 0; i < 16; ++i) v[i] = v[i] * gk[k0 + 16 * kq + i]; }
#pragma unroll
    for (int j = 0; j < 4; ++j) {
        v4u a, b;
        a.x = pk2(v[0][j], v[1][j]); a.y = pk2(v[2][j], v[3][j]); a.z = pk2(v[4][j], v[5][j]); a.w = pk2(v[6][j], v[7][j]);
        b.x = pk2(v[8][j], v[9][j]); b.y = pk2(v[10][j], v[11][j]); b.z = pk2(v[12][j], v[13][j]); b.w = pk2(v[14][j], v[15][j]);
        LAS unsigned char* p = scr + (4 * n4 + j) * 144 + kq * 32;
        *(LAS v4u*)p = a; *(LAS v4u*)(p + 16) = b; }
    LDS_WAIT(); asm volatile("" ::: "memory");
#pragma unroll
    for (int i = 0; i < 8; ++i) { const int n = 8 * i + (lane >> 3), c = lane & 7;
        __builtin_nontemporal_store(*(const LAS v4u*)(scr + n * 144 + c * 16), (GAS v4u*)(WT + (size_t)(drow0 + n) * K + k0 + 8 * c)); }
    LDS_WAIT(); asm volatile("" ::: "memory");
}
__device__ __forceinline__ void transpose_item8(const float* W, int ldw, unsigned char* WT, int K, int k0, int n0, int drow0, float scale, LAS unsigned char* scr, int lane, const float* gk = nullptr) {
    const int kq = lane >> 4, n4 = lane & 15;
    const float* src = W + (size_t)(k0 + 16 * kq) * ldw + n0 + 4 * n4;
    f32x4 v[16];
#pragma unroll
    for (int i = 0; i < 16; ++i) v[i] = __builtin_nontemporal_load((const GAS f32x4*)(src + (size_t)i * ldw)) * (gk ? scale * gk[k0 + 16 * kq + i] : scale);
#pragma unroll
    for (int j = 0; j < 4; ++j) { int w[4];
#pragma unroll
        for (int q = 0; q < 4; ++q) { w[q] = __builtin_amdgcn_cvt_pk_fp8_f32(v[4 * q][j], v[4 * q + 1][j], 0, false); w[q] = __builtin_amdgcn_cvt_pk_fp8_f32(v[4 * q + 2][j], v[4 * q + 3][j], w[q], true); }
        *(LAS v4u*)(scr + (4 * n4 + j) * 80 + kq * 16) = (v4u){(unsigned)w[0], (unsigned)w[1], (unsigned)w[2], (unsigned)w[3]}; }
    LDS_WAIT(); asm volatile("" ::: "memory");
#pragma unroll
    for (int i = 0; i < 4; ++i) { const int idx = lane + 64 * i, n = idx >> 2, c = idx & 3;
        __builtin_nontemporal_store(*(const LAS v4u*)(scr + n * 80 + c * 16), (GAS v4u*)(WT + (size_t)(drow0 + n) * K + k0 + 16 * c)); }
    LDS_WAIT(); asm volatile("" ::: "memory");
}
__device__ __forceinline__ void conv_plain(const float* W, int ldw, int K, int N, bf16* WT, int it, LAS unsigned char* scr, int lane, const float* gk = nullptr) {
    const int nblk = N / 64, kb = it / nblk, nb = it % nblk;
    transpose_item(W, ldw, WT, K, 64 * kb, 64 * nb, 64 * nb, scr, lane, gk);
}
__device__ __forceinline__ void conv_gu(const float* Wg, const float* Wu, int K, int F, bf16* WT, int it, LAS unsigned char* scr, int lane, const float* gk = nullptr) {
    const int nblk = F / 64, per = (K / 64) * nblk, half = it / per, r = it % per, kb = r / nblk, nb = r % nblk, f0 = 64 * nb;
    transpose_item(half ? Wu : Wg, F, WT, K, 64 * kb, f0, (f0 / 128) * 256 + half * 128 + (f0 % 128), scr, lane, gk);
}

__device__ __forceinline__ void xb_rows(const float* Xf, const float* g, bf16* XBo, float* rss, int gw, int NGW, int lane) {
    f32x4 gv[4];
#pragma unroll
    for (int j = 0; j < 4; ++j) gv[j] = *((const GAS f32x4*)g + lane + 64 * j);
    for (int m = gw; m < MT; m += NGW) {
        const GAS f32x4* xr = (const GAS f32x4*)(Xf + (size_t)m * DM) + lane;
        f32x4 v[4]; float s = 0.f;
#pragma unroll
        for (int j = 0; j < 4; ++j) { v[j] = xr[64 * j]; s += (v[j].x * v[j].x + v[j].y * v[j].y) + (v[j].z * v[j].z + v[j].w * v[j].w); }
        s = wave_sum(s);
        GAS unsigned long long* o8 = (GAS unsigned long long*)(XBo + (size_t)m * DM) + lane;
#pragma unroll
        for (int j = 0; j < 4; ++j) o8[64 * j] = (unsigned long long)pk2(v[j].x, v[j].y) | ((unsigned long long)pk2(v[j].z, v[j].w) << 32);
        if (lane < 16) rss[(size_t)m * 16 + lane] = lane ? 0.f : s;
    }
}
__device__ __forceinline__ void route_rows(const bf16* XBi, const float* gain, const float* rss, const LAS float* tab, LAS int* lcnt, int* toke, int* tokr, int* rtokv, float* rgv, float* rsv, gu32* ecnt, int gw, int NGW, int lane, int tid) {
    const f32x4 ga0 = *(const GAS f32x4*)(gain + 8 * lane), ga1 = *(const GAS f32x4*)(gain + 8 * lane + 4), gb0 = *(const GAS f32x4*)(gain + 512 + 8 * lane), gb1 = *(const GAS f32x4*)(gain + 512 + 8 * lane + 4);
    for (int m0 = 0; m0 < MT; m0 += 8 * NGW) {
        if (tid < 16) lcnt[tid] = 0;
        LDS_WAIT(); __syncthreads();
        int ee[8], ll[8]; float gg[8], rr[8];
#pragma unroll
        for (int r = 0; r < 8; ++r) { const int m = m0 + r * NGW + gw; ee[r] = -1; ll[r] = 0; gg[r] = 0.f; rr[r] = 0.f;
            if (m < MT) {
        const v4u u0 = *(const GAS v4u*)(XBi + (size_t)m * DM + 8 * lane), u1 = *(const GAS v4u*)(XBi + (size_t)m * DM + 512 + 8 * lane);
        const float h0[8] = {bfbits2f(u0.x & 0xffffu) * ga0.x, bfbits2f(u0.x >> 16) * ga0.y, bfbits2f(u0.y & 0xffffu) * ga0.z, bfbits2f(u0.y >> 16) * ga0.w, bfbits2f(u0.z & 0xffffu) * ga1.x, bfbits2f(u0.z >> 16) * ga1.y, bfbits2f(u0.w & 0xffffu) * ga1.z, bfbits2f(u0.w >> 16) * ga1.w};
        const float h1[8] = {bfbits2f(u1.x & 0xffffu) * gb0.x, bfbits2f(u1.x >> 16) * gb0.y, bfbits2f(u1.y & 0xffffu) * gb0.z, bfbits2f(u1.y >> 16) * gb0.w, bfbits2f(u1.z & 0xffffu) * gb1.x, bfbits2f(u1.z >> 16) * gb1.y, bfbits2f(u1.w & 0xffffu) * gb1.z, bfbits2f(u1.w >> 16) * gb1.w};
        float d[8];
#pragma unroll
        for (int q = 0; q < 8; ++q) { const LAS float* t = tab + q * 1024 + 8 * lane;
            const f32x4 a0 = *(const LAS f32x4*)t, a1 = *(const LAS f32x4*)(t + 4), b0 = *(const LAS f32x4*)(t + 512), b1 = *(const LAS f32x4*)(t + 516);
            d[q] = ((h0[0] * a0.x + h0[1] * a0.y) + (h0[2] * a0.z + h0[3] * a0.w)) + ((h0[4] * a1.x + h0[5] * a1.y) + (h0[6] * a1.z + h0[7] * a1.w))
                 + ((h1[0] * b0.x + h1[1] * b0.y) + (h1[2] * b0.z + h1[3] * b0.w)) + ((h1[4] * b1.x + h1[5] * b1.y) + (h1[6] * b1.z + h1[7] * b1.w)); }
#pragma unroll
        for (int q = 0; q < 8; ++q) d[q] = wave_sum(d[q]);
        if (lane == 0) {
            const float rstd = pg8::rstd_of(rss, m);
            int e1 = 0; float v1 = d[0];
#pragma unroll
            for (int q = 1; q < 8; ++q) if (d[q] > v1) { v1 = d[q]; e1 = q; }
            int e2 = -1; float v2 = -3.0e38f;
#pragma unroll
            for (int q = 0; q < 8; ++q) if (q != e1 && d[q] > v2) { v2 = d[q]; e2 = q; }
            const int l1 = __hip_atomic_fetch_add(lcnt + e1, 1, __ATOMIC_RELAXED, __HIP_MEMORY_SCOPE_WORKGROUP), l2 = __hip_atomic_fetch_add(lcnt + e2, 1, __ATOMIC_RELAXED, __HIP_MEMORY_SCOPE_WORKGROUP);
            ee[r] = e1 | (e2 << 4); ll[r] = l1 | (l2 << 16); gg[r] = 1.f / (1.f + expf((v2 - v1) * rstd)); rr[r] = rstd;
        } } }
        LDS_WAIT(); __syncthreads();
        if (tid < 8) lcnt[8 + tid] = (int)__hip_atomic_fetch_add(ecnt + 64 * tid, (unsigned)lcnt[tid], RLX_AGENT);
        LDS_WAIT(); __syncthreads();
        if (lane == 0) {
#pragma unroll
            for (int r = 0; r < 8; ++r) if (ee[r] >= 0) { const int m = m0 + r * NGW + gw, e1 = ee[r] & 15, e2 = ee[r] >> 4, r1 = lcnt[8 + e1] + (ll[r] & 0xffff), r2 = lcnt[8 + e2] + (ll[r] >> 16);
                const float g1 = gg[r], g2 = 1.f - g1, rstd = rr[r];
                toke[2 * m] = e1; toke[2 * m + 1] = e2; tokr[2 * m] = r1; tokr[2 * m + 1] = r2;
                rtokv[e1 * 16384 + r1] = m; rtokv[e2 * 16384 + r2] = m; rgv[e1 * 16384 + r1] = g1; rgv[e2 * 16384 + r2] = g2; rsv[e1 * 16384 + r1] = rstd; rsv[e2 * 16384 + r2] = rstd; } }
        LDS_WAIT(); __syncthreads();
    }
}
__device__ __forceinline__ void load_tab8(const float* W, int ldw, LAS float* tab, int tid) {
    for (int i = tid; i < 8192; i += NWAVES * 64) { const int k = i >> 3, j = i & 7; tab[j * 1024 + k] = W[(size_t)k * ldw + j]; }
    LDS_WAIT(); __syncthreads();
}

namespace sba {
typedef float f32x16 __attribute__((ext_vector_type(16)));
typedef short v4i16_t __attribute__((ext_vector_type(4)));
__device__ __forceinline__ v4i16_t vtr(const LAS char* p) { return __builtin_amdgcn_ds_read_tr16_b64_v4i16((LAS v4i16_t*)p); }
typedef float f32x2_t __attribute__((ext_vector_type(2))); typedef __bf16 bf16x2_t __attribute__((ext_vector_type(2)));
__device__ __forceinline__ unsigned cvtpk(float lo, float hi) { f32x2_t v = {lo, hi}; bf16x2_t b = __builtin_convertvector(v, bf16x2_t); return __builtin_bit_cast(unsigned, b); }
__device__ __forceinline__ float hsum32(float v) { auto rr = __builtin_amdgcn_permlane32_swap(__float_as_uint(v), __float_as_uint(v), false, false); return __uint_as_float(rr[0]) + __uint_as_float(rr[1]); }
constexpr int ATT_LDS = 131072 + 4096;
constexpr float RSTOP = 104.f * 1.4426950408889634f;
__device__ __forceinline__ void glds16(const void* gsrc, unsigned lds_dst) { unsigned keep;
    asm volatile("s_mov_b32 %0, m0\n\ts_mov_b32 m0, %2\n\ts_nop 0\n\tglobal_load_lds_dwordx4 %1, off\n\ts_mov_b32 m0, %0" : "=&s"(keep) : "v"(gsrc), "s"(lds_dst) : "memory"); }

__device__ __forceinline__ void attn_unit(const int b, const int qt2, const bf16* __restrict__ P, const float* __restrict__ gattn, bf16* __restrict__ AOo, LAS unsigned char* lds, const int wave, const int lane, const int parity) {
    const int h = wave, r32 = lane & 31, hi = lane >> 5;
    LAS char* vl = (LAS char*)lds + wave * 16384;
    LAS float* red = (LAS float*)(lds + 131072) + parity * 512;
    const size_t row0 = (size_t)b * SEQ;
    bf16x8 qa[4], qb[4];
#pragma unroll
    for (int ks = 0; ks < 4; ++ks) { qa[ks] = *(const bf16x8*)(P + (row0 + 64 * qt2 + r32) * NPROJ + OQ + h * 64 + 16 * ks + 8 * hi); qb[ks] = *(const bf16x8*)(P + (row0 + 64 * qt2 + 32 + r32) * NPROJ + OQ + h * 64 + 16 * ks + 8 * hi); }
    f32x16 oa0, oa1, ob0, ob1;
#pragma unroll
    for (int r = 0; r < 16; ++r) { oa0[r] = 0.f; oa1[r] = 0.f; ob0[r] = 0.f; ob1[r] = 0.f; }
    float Ra = 1.f, Rb = 1.f;
    const int grp = lane >> 4, i16 = lane & 15;
    const LAS char* vrd = vl + 4096 + (4 * (grp >> 1) + (i16 >> 2)) * 128 + (16 * (grp & 1) + 4 * (i16 & 3)) * 2;
    const LAS char* krd = vl + r32 * 128;
    const unsigned vdma = (unsigned)__builtin_amdgcn_readfirstlane((int)(unsigned)(uintptr_t)vl);
    const bf16* ksrc = P + (row0 + (lane >> 3)) * NPROJ + OK_ + h * 64 + (((lane & 7) ^ ((lane >> 3) & 7)) * 8);
    const bf16* vsrc = P + (row0 + (lane >> 3)) * NPROJ + OV + h * 64 + (lane & 7) * 8;
#define SBA_ISSUE(SLOT, kt_) do { const size_t ko_ = (size_t)(kt_) * 32 * NPROJ; \
        _Pragma("unroll") for (int i = 0; i < 4; ++i) glds16(ksrc + ko_ + (size_t)(8 * i) * NPROJ, vdma + (SLOT) * 8192 + i * 1024); \
        _Pragma("unroll") for (int i = 0; i < 4; ++i) glds16(vsrc + ko_ + (size_t)(8 * i) * NPROJ, vdma + (SLOT) * 8192 + 4096 + i * 1024); } while (0)
#define SBA_BLOCK(QR, O0, O1, R, DIAG) do { \
        f32x16 p; \
        _Pragma("unroll") for (int r = 0; r < 16; ++r) p[r] = 0.f; \
        _Pragma("unroll") for (int ks = 0; ks < 4; ++ks) p = __builtin_amdgcn_mfma_f32_32x32x16_bf16(kf[ks], QR[ks], p, 0, 0, 0); \
        if (DIAG) { _Pragma("unroll") for (int r = 0; r < 16; ++r) { const int kl = (r & 3) + 8 * (r >> 2) + 4 * hi; if (kl >= r32) p[r] = -1.0e30f; } } \
        float sg[16], qn[16], G[4], PG[4];                       \
        _Pragma("unroll") for (int r = 0; r < 16; ++r) { const float e = __builtin_amdgcn_exp2f(fminf(p[r], 126.f)); const float qq = __builtin_amdgcn_rcpf(1.f + e); qn[r] = qq; sg[r] = e * qq; } \
        _Pragma("unroll") for (int g = 0; g < 4; ++g) { G[g] = (qn[4 * g] * qn[4 * g + 1]) * (qn[4 * g + 2] * qn[4 * g + 3]); \
            auto rr_ = __builtin_amdgcn_permlane32_swap(__float_as_uint(G[g]), __float_as_uint(G[g]), false, false); PG[g] = __uint_as_float(hi ? rr_[0] : rr_[1]); }     \
        float base[4]; \
        { float acc = R; \
          _Pragma("unroll") for (int g = 3; g >= 0; --g) { base[g] = hi == 0 ? acc * PG[g] : acc; acc *= G[g] * PG[g]; } \
          R = acc; } \
        float w[16]; \
        _Pragma("unroll") for (int g = 0; g < 4; ++g) { float lat = base[g]; \
            _Pragma("unroll") for (int i = 3; i >= 0; --i) { const int r = 4 * g + i; w[r] = sg[r] * lat; lat *= qn[r]; } } \
        v4u pb0, pb1; \
        pb0.x = cvtpk(w[0], w[1]); pb0.y = cvtpk(w[2], w[3]); pb0.z = cvtpk(w[4], w[5]); pb0.w = cvtpk(w[6], w[7]); \
        pb1.x = cvtpk(w[8], w[9]); pb1.y = cvtpk(w[10], w[11]); pb1.z = cvtpk(w[12], w[13]); pb1.w = cvtpk(w[14], w[15]); \
        const bf16x8 b0 = __builtin_bit_cast(bf16x8, pb0), b1 = __builtin_bit_cast(bf16x8, pb1); \
        O0 = __builtin_amdgcn_mfma_f32_32x32x16_bf16(vf00, b0, O0, 0, 0, 0); O0 = __builtin_amdgcn_mfma_f32_32x32x16_bf16(vf01, b1, O0, 0, 0, 0); \
        O1 = __builtin_amdgcn_mfma_f32_32x32x16_bf16(vf10, b0, O1, 0, 0, 0); O1 = __builtin_amdgcn_mfma_f32_32x32x16_bf16(vf11, b1, O1, 0, 0, 0); \
    } while (0)
#define SBA_TILE(SLOT, kt_) do { \
        if ((kt_) >= 1) asm volatile("s_waitcnt vmcnt(8)" ::: "memory"); else asm volatile("s_waitcnt vmcnt(0)" ::: "memory");     \
        bf16x8 kf[4]; \
        _Pragma("unroll") for (int ks = 0; ks < 4; ++ks) kf[ks] = *(const LAS bf16x8*)(krd + (SLOT) * 8192 + (((2 * ks + hi) ^ (r32 & 7)) * 16)); \
        const LAS char* vr_ = vrd + (SLOT) * 8192; \
        const v4i16_t a00 = vtr(vr_), a01 = vtr(vr_ + 8 * 128), a02 = vtr(vr_ + 16 * 128), a03 = vtr(vr_ + 24 * 128); \
        const v4i16_t a10 = vtr(vr_ + 64), a11 = vtr(vr_ + 8 * 128 + 64), a12 = vtr(vr_ + 16 * 128 + 64), a13 = vtr(vr_ + 24 * 128 + 64); \
        asm volatile("s_waitcnt lgkmcnt(0)" ::: "memory");      \
        if ((kt_) >= 2) SBA_ISSUE(SLOT, (kt_) - 2); \
        const bf16x8 vf00 = {a00[0], a00[1], a00[2], a00[3], a01[0], a01[1], a01[2], a01[3]}, vf01 = {a02[0], a02[1], a02[2], a02[3], a03[0], a03[1], a03[2], a03[3]}; \
        const bf16x8 vf10 = {a10[0], a10[1], a10[2], a10[3], a11[0], a11[1], a11[2], a11[3]}, vf11 = {a12[0], a12[1], a12[2], a12[3], a13[0], a13[1], a13[2], a13[3]}; \
        if (!doneB) { SBA_BLOCK(qb, ob0, ob1, Rb, (kt_) == 2 * qt2 + 1); doneB = __all(Rb == 0.f); } \
        if ((kt_) <= 2 * qt2 && !doneA) { SBA_BLOCK(qa, oa0, oa1, Ra, (kt_) == 2 * qt2); doneA = __all(Ra == 0.f); } \
    } while (0)
    SBA_ISSUE(0, 2 * qt2 + 1); SBA_ISSUE(1, 2 * qt2);
    asm volatile("" : "+v"(qa[0]), "+v"(qa[1]), "+v"(qa[2]), "+v"(qa[3]), "+v"(qb[0]), "+v"(qb[1]), "+v"(qb[2]), "+v"(qb[3]));
    bool doneA = false, doneB = false;
    for (int kt = 2 * qt2 + 1;;) {
        SBA_TILE(0, kt); if (kt == 0 || (doneA && doneB)) break; --kt;
        SBA_TILE(1, kt); if (kt == 0 || (doneA && doneB)) break; --kt;
    }
    asm volatile("s_waitcnt vmcnt(0)" ::: "memory");
#undef SBA_TILE
#undef SBA_BLOCK
#undef SBA_ISSUE
    float ssa = 0.f, ssb = 0.f;
#pragma unroll
    for (int r = 0; r < 16; ++r) { ssa += oa0[r] * oa0[r] + oa1[r] * oa1[r]; ssb += ob0[r] * ob0[r] + ob1[r] * ob1[r]; }
    ssa = hsum32(ssa); ssb = hsum32(ssb);
    if (hi == 0) { red[h * 64 + r32] = ssa; red[h * 64 + 32 + r32] = ssb; }
    LDS_WAIT(); __syncthreads();
    float ta = 0.f, tb = 0.f;
#pragma unroll
    for (int j = 0; j < 8; ++j) { ta += red[j * 64 + r32]; tb += red[j * 64 + 32 + r32]; }
    const float rsa = 1.f / sqrtf(ta * (1.f / 512.f) + EPS), rsb = 1.f / sqrtf(tb * (1.f / 512.f) + EPS);
#pragma unroll
    for (int db = 0; db < 2; ++db)
#pragma unroll
        for (int g = 0; g < 4; ++g) { const int d = 32 * db + 8 * g + 4 * hi; const f32x4 gv = *(const f32x4*)(gattn + h * 64 + d);
            const f32x16& xa = db ? oa1 : oa0; const f32x16& xb = db ? ob1 : ob0;
            const unsigned la = cvtpk(xa[4 * g] * rsa * gv.x, xa[4 * g + 1] * rsa * gv.y), ha = cvtpk(xa[4 * g + 2] * rsa * gv.z, xa[4 * g + 3] * rsa * gv.w);
            const unsigned lb = cvtpk(xb[4 * g] * rsb * gv.x, xb[4 * g + 1] * rsb * gv.y), hb = cvtpk(xb[4 * g + 2] * rsb * gv.z, xb[4 * g + 3] * rsb * gv.w);
            *(LAS unsigned long long*)(vl + r32 * 128 + d * 2) = (unsigned long long)la | ((unsigned long long)ha << 32);
            *(LAS unsigned long long*)(vl + (32 + r32) * 128 + d * 2) = (unsigned long long)lb | ((unsigned long long)hb << 32); }
    LDS_WAIT();
#pragma unroll
    for (int i = 0; i < 8; ++i) { const int row = (lane >> 3) + 8 * i; const v4u v = *(const LAS v4u*)(vl + row * 128 + (lane & 7) * 16);
        *(v4u*)(AOo + (row0 + 64 * qt2 + row) * 1024 + h * 64 + (lane & 7) * 8) = v; }
    LDS_WAIT();
}
}
namespace ssd {
typedef float f32x16 __attribute__((ext_vector_type(16)));
typedef short v4i16_t __attribute__((ext_vector_type(4)));
constexpr int RS = 272, XRS = 528;
constexpr int OFF_B = 0, OFF_C = 128 * RS, OFF_X = 2 * 128 * RS, OFF_TAB = OFF_X + 128 * XRS, OFF_T = OFF_C;
constexpr int TAB_HEAD = 2048, TAB_ACUM = 0, TAB_DT = 512, TAB_CF = 1024, TAB_DECS = 1536;
constexpr int OFF_DTP = OFF_TAB + 4 * TAB_HEAD;
constexpr int LDS_NEED = OFF_DTP + 8192;
constexpr float LOG2E = 1.4426950408889634f;
__device__ __forceinline__ v4i16_t vtr(const LAS char* p) { return __builtin_amdgcn_ds_read_tr16_b64_v4i16((LAS v4i16_t*)p); }
typedef float f32x2_t __attribute__((ext_vector_type(2))); typedef __bf16 bf16x2_t __attribute__((ext_vector_type(2)));
__device__ __forceinline__ unsigned cvtpk(float lo, float hi) { f32x2_t v = {lo, hi}; bf16x2_t b = __builtin_convertvector(v, bf16x2_t); return __builtin_bit_cast(unsigned, b); }
__device__ __forceinline__ float bflo(unsigned u) { return __builtin_bit_cast(float, u << 16); }
__device__ __forceinline__ float bfhi(unsigned u) { return __builtin_bit_cast(float, u & 0xffff0000u); }
__device__ __forceinline__ float ex(float x) { return __builtin_amdgcn_exp2f(LOG2E * x); }
__device__ __forceinline__ int crow(int r, int hi) { return (r & 3) + 8 * (r >> 2) + 4 * hi; }

struct ATensors { const bf16* PROJ; const float* cw; const float* cb; const float* dtraw; const float* dtbias; const float* alog; const float* dskip;
                  bf16* YD; bf16* ST; bf16* CC; float* ACUM; };

__device__ __forceinline__ void phaseA_unit(const int b, const int c, const int g, const ATensors& T, LAS unsigned char* lds, const int wave, const int lane) {
    const int r32 = lane & 31, hi = lane >> 5, grp = lane >> 4, i16 = lane & 15;
    const int tok0 = b * SEQ + c * 128;
    LAS char* L = (LAS char*)lds;
    if (wave < 4) {
        const int h = g * 4 + wave; const float a = -expf(T.alog[h]), bias = T.dtbias[h];
        LAS float* tab = (LAS float*)(L + OFF_TAB + wave * TAB_HEAD);
        const int l0 = 2 * lane;
        float z0 = T.dtraw[(size_t)(tok0 + l0) * 8 + h] + bias, z1 = T.dtraw[(size_t)(tok0 + l0 + 1) * 8 + h] + bias;
        const float d0 = (z0 > 20.f) ? z0 : log1pf(expf(z0)), d1 = (z1 > 20.f) ? z1 : log1pf(expf(z1));
        const float a0 = d0 * a, a1 = d1 * a, ps = a0 + a1;
        float inc = ps;
#pragma unroll
        for (int o = 1; o < 64; o <<= 1) { const float t = __shfl_up(inc, o); if (lane >= o) inc += t; }
        const float exc = inc - ps, c0 = exc + a0, c1 = exc + ps;
        const float alast = __shfl(inc, 63);
        tab[TAB_ACUM / 4 + l0] = c0; tab[TAB_ACUM / 4 + l0 + 1] = c1; tab[TAB_DT / 4 + l0] = d0; tab[TAB_DT / 4 + l0 + 1] = d1;
        LDS_WAIT();
        const float eb = tab[TAB_ACUM / 4 + (l0 | 31)];
        tab[TAB_CF / 4 + l0] = ex(eb - c0) * d0; tab[TAB_CF / 4 + l0 + 1] = ex(eb - c1) * d1;
        tab[TAB_DECS / 4 + l0] = ex(alast - c0) * d0; tab[TAB_DECS / 4 + l0 + 1] = ex(alast - c1) * d1;
        T.ACUM[(size_t)(tok0 + l0) * 8 + h] = c0; T.ACUM[(size_t)(tok0 + l0 + 1) * 8 + h] = c1;
    }
    {
        const int scol = (lane < 32) ? (g * 256 + lane * 8) : (lane < 48) ? (512 + g * 128 + (lane - 32) * 8) : (768 + g * 128 + (lane - 48) * 8);
        float wt[4][8], bs[8];
#pragma unroll
        for (int k = 0; k < 4; ++k) { const f32x4 w0 = *(const f32x4*)(T.cw + k * 1024 + scol), w1 = *(const f32x4*)(T.cw + k * 1024 + scol + 4);
            wt[k][0] = w0.x; wt[k][1] = w0.y; wt[k][2] = w0.z; wt[k][3] = w0.w; wt[k][4] = w1.x; wt[k][5] = w1.y; wt[k][6] = w1.z; wt[k][7] = w1.w; }
        { const f32x4 b0 = *(const f32x4*)(T.cb + scol), b1 = *(const f32x4*)(T.cb + scol + 4); bs[0] = b0.x; bs[1] = b0.y; bs[2] = b0.z; bs[3] = b0.w; bs[4] = b1.x; bs[5] = b1.y; bs[6] = b1.z; bs[7] = b1.w; }
        const bf16* src = T.PROJ + (size_t)(tok0 + 16 * wave) * NPROJ + OXBC + scol;
        const bool first = (c == 0) && (wave == 0);
        v4u raw[19];
#pragma unroll
        for (int j = 0; j < 19; ++j) { const v4u zz = {0u, 0u, 0u, 0u}; raw[j] = (first && j < 3) ? zz : *(const v4u*)(src + (long)(j - 3) * NPROJ); }
        LAS char* dst = (lane < 32) ? (L + OFF_X + lane * 16) : (lane < 48) ? (L + OFF_B + (lane - 32) * 16) : (L + OFF_C + (lane - 48) * 16);
        const int drs = (lane < 32) ? XRS : RS;
#pragma unroll
        for (int j = 0; j < 16; ++j) {
            float o[8];
#pragma unroll
            for (int i = 0; i < 8; ++i) o[i] = bs[i];
#pragma unroll
            for (int k = 0; k < 4; ++k) { const v4u rv = raw[j + k];
                o[0] += wt[k][0] * bflo(rv.x); o[1] += wt[k][1] * bfhi(rv.x); o[2] += wt[k][2] * bflo(rv.y); o[3] += wt[k][3] * bfhi(rv.y);
                o[4] += wt[k][4] * bflo(rv.z); o[5] += wt[k][5] * bfhi(rv.z); o[6] += wt[k][6] * bflo(rv.w); o[7] += wt[k][7] * bfhi(rv.w); }
#pragma unroll
            for (int i = 0; i < 8; ++i) o[i] = o[i] * __builtin_amdgcn_rcpf(1.f + __builtin_amdgcn_exp2f(-LOG2E * o[i]));
            v4u pk; pk.x = cvtpk(o[0], o[1]); pk.y = cvtpk(o[2], o[3]); pk.z = cvtpk(o[4], o[5]); pk.w = cvtpk(o[6], o[7]);
            const int l = 16 * wave + j;
            *(LAS v4u*)(dst + l * drs) = pk;
            if (lane >= 48) *(v4u*)(T.CC + (size_t)(tok0 + l) * 256 + g * 128 + (lane - 48) * 8) = pk;
        }
    }
    LDS_WAIT(); __syncthreads();
    f32x16 t0, t1;
#pragma unroll
    for (int r = 0; r < 16; ++r) { t0[r] = 0.f; t1[r] = 0.f; }
    {
        const int ti = wave, lb = (ti >= 6) ? 3 : (ti >= 3) ? 2 : (ti >= 1) ? 1 : 0, sb = ti - lb * (lb + 1) / 2;
        const LAS char* ap = L + OFF_B + (32 * sb + r32) * RS + 16 * hi; const LAS char* bp = L + OFF_C + (32 * lb + r32) * RS + 16 * hi;
#pragma unroll
        for (int ks = 0; ks < 8; ++ks) t0 = __builtin_amdgcn_mfma_f32_32x32x16_bf16(*(const LAS bf16x8*)(ap + 32 * ks), *(const LAS bf16x8*)(bp + 32 * ks), t0, 0, 0, 0);
        if (wave < 2) { const int sb2 = 2 + wave;
            const LAS char* ap2 = L + OFF_B + (32 * sb2 + r32) * RS + 16 * hi; const LAS char* bp2 = L + OFF_C + (96 + r32) * RS + 16 * hi;
#pragma unroll
            for (int ks = 0; ks < 8; ++ks) t1 = __builtin_amdgcn_mfma_f32_32x32x16_bf16(*(const LAS bf16x8*)(ap2 + 32 * ks), *(const LAS bf16x8*)(bp2 + 32 * ks), t1, 0, 0, 0); }
    }
    LDS_WAIT(); __syncthreads();
    {
        LAS char* tp = L + OFF_T + wave * 2048 + lane * 32;
        v4u w0, w1; w0.x = cvtpk(t0[0], t0[1]); w0.y = cvtpk(t0[2], t0[3]); w0.z = cvtpk(t0[4], t0[5]); w0.w = cvtpk(t0[6], t0[7]);
        w1.x = cvtpk(t0[8], t0[9]); w1.y = cvtpk(t0[10], t0[11]); w1.z = cvtpk(t0[12], t0[13]); w1.w = cvtpk(t0[14], t0[15]);
        *(LAS v4u*)tp = w0; *(LAS v4u*)(tp + 16) = w1;
        if (wave < 2) { LAS char* tp2 = L + OFF_T + (8 + wave) * 2048 + lane * 32;
            w0.x = cvtpk(t1[0], t1[1]); w0.y = cvtpk(t1[2], t1[3]); w0.z = cvtpk(t1[4], t1[5]); w0.w = cvtpk(t1[6], t1[7]);
            w1.x = cvtpk(t1[8], t1[9]); w1.y = cvtpk(t1[10], t1[11]); w1.z = cvtpk(t1[12], t1[13]); w1.w = cvtpk(t1[14], t1[15]);
            *(LAS v4u*)tp2 = w0; *(LAS v4u*)(tp2 + 16) = w1; }
    }
    LDS_WAIT(); __syncthreads();
    const int hl = wave >> 1, ph = wave & 1, h = g * 4 + hl;
    const LAS float* tab = (const LAS float*)(L + OFF_TAB + hl * TAB_HEAD);
    const float Dh = T.dskip[h];
    bf16x8 xf[8];
    {
        const LAS char* xp = L + OFF_X + (4 * (grp >> 1) + (i16 >> 2)) * XRS + (hl * 64 + 32 * ph + 16 * (grp & 1) + 4 * (i16 & 3)) * 2;
#pragma unroll
        for (int ks = 0; ks < 8; ++ks) { const v4i16_t a0 = vtr(xp + (16 * ks) * XRS), a1 = vtr(xp + (16 * ks + 8) * XRS);
            xf[ks] = (bf16x8){a0[0], a0[1], a0[2], a0[3], a1[0], a1[1], a1[2], a1[3]}; }
    }
#pragma unroll
    for (int lb = 0; lb < 4; ++lb) {
        f32x16 y;
#pragma unroll
        for (int r = 0; r < 16; ++r) y[r] = 0.f;
        const float acl = tab[TAB_ACUM / 4 + 32 * lb + r32];
#pragma unroll
        for (int sb = 0; sb <= lb; ++sb) {
            const LAS char* tp = L + OFF_T + (lb * (lb + 1) / 2 + sb) * 2048 + lane * 32;
            const v4u q0 = *(const LAS v4u*)tp, q1 = *(const LAS v4u*)(tp + 16);
            float tv[16] = {bflo(q0.x), bfhi(q0.x), bflo(q0.y), bfhi(q0.y), bflo(q0.z), bfhi(q0.z), bflo(q0.w), bfhi(q0.w),
                            bflo(q1.x), bfhi(q1.x), bflo(q1.y), bfhi(q1.y), bflo(q1.z), bfhi(q1.z), bflo(q1.w), bfhi(q1.w)};
            float m[16];
            if (sb < lb) {
                const float rowf = ex(acl - tab[TAB_ACUM / 4 + 32 * sb + 31]);
#pragma unroll
                for (int q = 0; q < 4; ++q) { const f32x4 cf = *(const LAS f32x4*)(tab + TAB_CF / 4 + 32 * sb + 8 * q + 4 * hi);
                    m[4 * q] = tv[4 * q] * (rowf * cf.x); m[4 * q + 1] = tv[4 * q + 1] * (rowf * cf.y); m[4 * q + 2] = tv[4 * q + 2] * (rowf * cf.z); m[4 * q + 3] = tv[4 * q + 3] * (rowf * cf.w); }
            } else {
#pragma unroll
                for (int q = 0; q < 4; ++q) { const f32x4 as = *(const LAS f32x4*)(tab + TAB_ACUM / 4 + 32 * sb + 8 * q + 4 * hi), ds = *(const LAS f32x4*)(tab + TAB_DT / 4 + 32 * sb + 8 * q + 4 * hi);
                    const float asv[4] = {as.x, as.y, as.z, as.w}, dsv[4] = {ds.x, ds.y, ds.z, ds.w};
#pragma unroll
                    for (int i = 0; i < 4; ++i) { const int sl = 8 * q + 4 * hi + i;
                        const float f = (sl <= r32) ? ex(acl - asv[i]) * dsv[i] : 0.f;
                        m[4 * q + i] = tv[4 * q + i] * f + ((sl == r32) ? Dh : 0.f); } }
            }
            v4u p0, p1; p0.x = cvtpk(m[0], m[1]); p0.y = cvtpk(m[2], m[3]); p0.z = cvtpk(m[4], m[5]); p0.w = cvtpk(m[6], m[7]);
            p1.x = cvtpk(m[8], m[9]); p1.y = cvtpk(m[10], m[11]); p1.z = cvtpk(m[12], m[13]); p1.w = cvtpk(m[14], m[15]);
            y = __builtin_amdgcn_mfma_f32_32x32x16_bf16(__builtin_bit_cast(bf16x8, p0), xf[2 * sb], y, 0, 0, 0);
            y = __builtin_amdgcn_mfma_f32_32x32x16_bf16(__builtin_bit_cast(bf16x8, p1), xf[2 * sb + 1], y, 0, 0, 0);
        }
        v4u* yp = (v4u*)T.YD + ((size_t)((((b * 16 + c) * 2 + g) * 8 + wave) * 4 + lb) * 2) * 64 + lane;
#pragma unroll
        for (int rh = 0; rh < 2; ++rh) yp[rh * 64] = (v4u){cvtpk(y[8 * rh], y[8 * rh + 1]), cvtpk(y[8 * rh + 2], y[8 * rh + 3]), cvtpk(y[8 * rh + 4], y[8 * rh + 5]), cvtpk(y[8 * rh + 6], y[8 * rh + 7])};
    }
    {
        f32x16 xs[4];
#pragma unroll
        for (int nb = 0; nb < 4; ++nb)
#pragma unroll
            for (int r = 0; r < 16; ++r) xs[nb][r] = 0.f;
        const LAS char* bp = L + OFF_B + (4 * (grp >> 1) + (i16 >> 2)) * RS + (16 * (grp & 1) + 4 * (i16 & 3)) * 2;
#pragma unroll
        for (int ks = 0; ks < 8; ++ks) {
            const f32x4 e0 = *(const LAS f32x4*)(tab + TAB_DECS / 4 + 16 * ks + 4 * hi), e1 = *(const LAS f32x4*)(tab + TAB_DECS / 4 + 16 * ks + 8 + 4 * hi);
            const v4u xu = __builtin_bit_cast(v4u, xf[ks]);
            v4u su; su.x = cvtpk(bflo(xu.x) * e0.x, bfhi(xu.x) * e0.y); su.y = cvtpk(bflo(xu.y) * e0.z, bfhi(xu.y) * e0.w);
            su.z = cvtpk(bflo(xu.z) * e1.x, bfhi(xu.z) * e1.y); su.w = cvtpk(bflo(xu.w) * e1.z, bfhi(xu.w) * e1.w);
            const bf16x8 sx = __builtin_bit_cast(bf16x8, su);
#pragma unroll
            for (int nb = 0; nb < 4; ++nb) { const v4i16_t a0 = vtr(bp + (16 * ks) * RS + nb * 64), a1 = vtr(bp + (16 * ks + 8) * RS + nb * 64);
                xs[nb] = __builtin_amdgcn_mfma_f32_32x32x16_bf16((bf16x8){a0[0], a0[1], a0[2], a0[3], a1[0], a1[1], a1[2], a1[3]}, sx, xs[nb], 0, 0, 0); }
        }
        v4u* sp = (v4u*)T.ST + (size_t)((b * 16 + c) * 8 + h) * 1024 + (size_t)(ph * 8) * 64 + lane;
#pragma unroll
        for (int nb = 0; nb < 4; ++nb)
#pragma unroll
            for (int rh = 0; rh < 2; ++rh) sp[(nb * 2 + rh) * 64] = (v4u){cvtpk(xs[nb][8 * rh], xs[nb][8 * rh + 1]), cvtpk(xs[nb][8 * rh + 2], xs[nb][8 * rh + 3]), cvtpk(xs[nb][8 * rh + 4], xs[nb][8 * rh + 5]), cvtpk(xs[nb][8 * rh + 6], xs[nb][8 * rh + 7])};
    }
    LDS_WAIT(); __syncthreads();
}

__device__ __forceinline__ void scan_states(const bf16* ST, bf16* SF, const float* ACUM, const int gtid, const int nthr) {
    for (int e = gtid; e < BATCH * 8 * 1024; e += nthr) {
        const int bh = e >> 10, b = bh >> 3, h = bh & 7, q = e & 1023;
        float S[8];
#pragma unroll
        for (int j = 0; j < 8; ++j) S[j] = 0.f;
        v4u v[16]; float dc[16];
#pragma unroll
        for (int c = 0; c < 16; ++c) { v[c] = *((const v4u*)ST + (size_t)((b * 16 + c) * 8 + h) * 1024 + q); dc[c] = ACUM[(size_t)(b * SEQ + c * 128 + 127) * 8 + h]; }
#pragma unroll
        for (int c = 0; c < 16; ++c) {
            *((v4u*)SF + (size_t)((b * 16 + c) * 8 + h) * 1024 + q) = (v4u){cvtpk(S[0], S[1]), cvtpk(S[2], S[3]), cvtpk(S[4], S[5]), cvtpk(S[6], S[7])};
            const float d = ex(dc[c]);
            S[0] = S[0] * d + bflo(v[c].x); S[1] = S[1] * d + bfhi(v[c].x); S[2] = S[2] * d + bflo(v[c].y); S[3] = S[3] * d + bfhi(v[c].y);
            S[4] = S[4] * d + bflo(v[c].z); S[5] = S[5] * d + bfhi(v[c].z); S[6] = S[6] * d + bflo(v[c].w); S[7] = S[7] * d + bfhi(v[c].w); }
    }
}

struct BTensors { const bf16* PROJ; const bf16* YD; const bf16* SF; const bf16* CC; const float* ACUM; const float* gssd; bf16* AO; };

__device__ __forceinline__ void phaseB_unit(const int b, const int c, const int g, const BTensors& T, LAS unsigned char* lds, const int wave, const int lane, const int tid) {
    const int r32 = lane & 31, hi = lane >> 5;
    const int tok0 = b * SEQ + c * 128;
    LAS char* L = (LAS char*)lds;
#pragma unroll
    for (int i = 0; i < 4; ++i) { const int ch = tid + 512 * i, row = ch >> 4, cc = ch & 15;
        *(LAS v4u*)(L + OFF_C + row * RS + cc * 16) = *(const v4u*)(T.CC + (size_t)(tok0 + row) * 256 + g * 128 + cc * 8); }
    { const int hl = tid >> 7, l = tid & 127; ((LAS float*)(L + OFF_TAB))[hl * 128 + l] = ex(T.ACUM[(size_t)(tok0 + l) * 8 + g * 4 + hl]); }
    const int hl = wave >> 1, ph = wave & 1, h = g * 4 + hl;
    bf16x8 sf[8];
    {
        const bf16x8* sp = (const bf16x8*)T.SF + (size_t)((((b * 16 + c) * 8 + h) * 2 + ph) * 8) * 64 + lane;
#pragma unroll
        for (int ks = 0; ks < 8; ++ks) sf[ks] = sp[ks * 64];
    }
    LDS_WAIT(); __syncthreads();
    const LAS float* ea = (const LAS float*)(L + OFF_TAB) + hl * 128;
#pragma unroll
    for (int lb = 0; lb < 4; ++lb) {
        f32x16 y;
#pragma unroll
        for (int r = 0; r < 16; ++r) y[r] = 0.f;
        const LAS char* cp = L + OFF_C + (32 * lb + r32) * RS + 8 * hi;
#pragma unroll
        for (int ks = 0; ks < 8; ++ks) { const unsigned long long c0 = *(const LAS unsigned long long*)(cp + 32 * ks), c1 = *(const LAS unsigned long long*)(cp + 32 * ks + 16);
            v4u cu; cu.x = (unsigned)c0; cu.y = (unsigned)(c0 >> 32); cu.z = (unsigned)c1; cu.w = (unsigned)(c1 >> 32);
            y = __builtin_amdgcn_mfma_f32_32x32x16_bf16(__builtin_bit_cast(bf16x8, cu), sf[ks], y, 0, 0, 0); }
        const v4u* ydp = (const v4u*)T.YD + ((size_t)((((b * 16 + c) * 2 + g) * 8 + wave) * 4 + lb) * 2) * 64 + lane;
        LAS bf16* yl = (LAS bf16*)(L + OFF_X + (32 * lb + 4 * hi) * XRS) + hl * 64 + 32 * ph + r32;
#pragma unroll
        for (int rh = 0; rh < 2; ++rh) { const v4u yd = ydp[rh * 64];
            const f32x4 e0 = *(const LAS f32x4*)(ea + 32 * lb + 16 * rh + 4 * hi), e1 = *(const LAS f32x4*)(ea + 32 * lb + 16 * rh + 8 + 4 * hi);
            yl[(16 * rh + 0) * (XRS / 2)] = (bf16)f2bf(y[8 * rh] * e0.x + bflo(yd.x)); yl[(16 * rh + 1) * (XRS / 2)] = (bf16)f2bf(y[8 * rh + 1] * e0.y + bfhi(yd.x));
            yl[(16 * rh + 2) * (XRS / 2)] = (bf16)f2bf(y[8 * rh + 2] * e0.z + bflo(yd.y)); yl[(16 * rh + 3) * (XRS / 2)] = (bf16)f2bf(y[8 * rh + 3] * e0.w + bfhi(yd.y));
            yl[(16 * rh + 8) * (XRS / 2)] = (bf16)f2bf(y[8 * rh + 4] * e1.x + bflo(yd.z)); yl[(16 * rh + 9) * (XRS / 2)] = (bf16)f2bf(y[8 * rh + 5] * e1.y + bfhi(yd.z));
            yl[(16 * rh + 10) * (XRS / 2)] = (bf16)f2bf(y[8 * rh + 6] * e1.z + bflo(yd.w)); yl[(16 * rh + 11) * (XRS / 2)] = (bf16)f2bf(y[8 * rh + 7] * e1.w + bfhi(yd.w)); }
    }
    v4u zq[4][2];
    { const int cl = lane & 15;
#pragma unroll
      for (int ps = 0; ps < 4; ++ps) { const bf16* zp = T.PROJ + (size_t)(tok0 + 16 * wave + 4 * ps + (lane >> 4)) * NPROJ + OZ + g * 256 + cl * 8; zq[ps][0] = *(const v4u*)zp; zq[ps][1] = *(const v4u*)(zp + 128); } }
    LDS_WAIT(); __syncthreads();
    {
        const int cl = lane & 15;
        const f32x4 g0 = *(const f32x4*)(T.gssd + g * 256 + cl * 8), g1 = *(const f32x4*)(T.gssd + g * 256 + cl * 8 + 4), g2 = *(const f32x4*)(T.gssd + g * 256 + 128 + cl * 8), g3 = *(const f32x4*)(T.gssd + g * 256 + 128 + cl * 8 + 4);
#pragma unroll
        for (int ps = 0; ps < 4; ++ps) { const int row = 16 * wave + 4 * ps + (lane >> 4);
            const v4u u0 = *(const LAS v4u*)(L + OFF_X + row * XRS + cl * 16), u1 = *(const LAS v4u*)(L + OFF_X + row * XRS + 256 + cl * 16);
            float a[16] = {bflo(u0.x), bfhi(u0.x), bflo(u0.y), bfhi(u0.y), bflo(u0.z), bfhi(u0.z), bflo(u0.w), bfhi(u0.w), bflo(u1.x), bfhi(u1.x), bflo(u1.y), bfhi(u1.y), bflo(u1.z), bfhi(u1.z), bflo(u1.w), bfhi(u1.w)};
            const v4u z0 = zq[ps][0], z1 = zq[ps][1];
            const float zz[16] = {bflo(z0.x), bfhi(z0.x), bflo(z0.y), bfhi(z0.y), bflo(z0.z), bfhi(z0.z), bflo(z0.w), bfhi(z0.w), bflo(z1.x), bfhi(z1.x), bflo(z1.y), bfhi(z1.y), bflo(z1.z), bfhi(z1.z), bflo(z1.w), bfhi(z1.w)};
            float ss = 0.f;
#pragma unroll
            for (int i = 0; i < 16; ++i) { a[i] *= zz[i] * __builtin_amdgcn_rcpf(1.f + __builtin_amdgcn_exp2f(-LOG2E * zz[i])); ss += a[i] * a[i]; }
            ss = dpp_addf<0xB1, 0xf>(ss); ss = dpp_addf<0x4E, 0xf>(ss); ss = dpp_addf<0x141, 0xf>(ss); ss = dpp_addf<0x140, 0xf>(ss);
            const float rs = 1.f / sqrtf(ss * (1.f / 256.f) + EPS);
            v4u o0, o1; o0.x = cvtpk(a[0] * rs * g0.x, a[1] * rs * g0.y); o0.y = cvtpk(a[2] * rs * g0.z, a[3] * rs * g0.w); o0.z = cvtpk(a[4] * rs * g1.x, a[5] * rs * g1.y); o0.w = cvtpk(a[6] * rs * g1.z, a[7] * rs * g1.w);
            o1.x = cvtpk(a[8] * rs * g2.x, a[9] * rs * g2.y); o1.y = cvtpk(a[10] * rs * g2.z, a[11] * rs * g2.w); o1.z = cvtpk(a[12] * rs * g3.x, a[13] * rs * g3.y); o1.w = cvtpk(a[14] * rs * g3.z, a[15] * rs * g3.w);
            bf16* op = T.AO + (size_t)(tok0 + row) * 1024 + 512 + g * 256 + cl * 8;
            *(v4u*)op = o0; *(v4u*)(op + 128) = o1; }
    }
    LDS_WAIT(); __syncthreads();
}
}

__device__ __forceinline__ void dt_tail(const bf16* XBi, const bf16* WDTl, const float* rss, float* DTR, LAS unsigned char* lds, const int vcu, const int G, const int wave, const int lane, const int tid) {
    typedef float f32x16 __attribute__((ext_vector_type(16)));
    const int r32 = lane & 31, hi = lane >> 5;
    for (int p = vcu; p < MT / 64; p += G) {
        const int mb = wave & 1, kq = wave >> 1;
        f32x16 d;
#pragma unroll
        for (int r = 0; r < 16; ++r) d[r] = 0.f;
        const bf16* ap = XBi + (size_t)(64 * p + 32 * mb + r32) * DM + 256 * kq + 8 * hi;
        const bf16* bp = WDTl + (size_t)(r32 & 7) * DM + 256 * kq + 8 * hi;
        const bf16x8 zero8 = {0, 0, 0, 0, 0, 0, 0, 0};
        bf16x8 af[16], bq[16];
#pragma unroll
        for (int ks = 0; ks < 16; ++ks) { af[ks] = *(const bf16x8*)(ap + 16 * ks); bq[ks] = *(const bf16x8*)(bp + 16 * ks); }
#pragma unroll
        for (int ks = 0; ks < 16; ++ks) d = __builtin_amdgcn_mfma_f32_32x32x16_bf16(af[ks], (r32 < 8) ? bq[ks] : zero8, d, 0, 0, 0);
        LAS float* dp = (LAS float*)lds + ((kq * 64 + 32 * mb + 4 * hi) * 8 + r32);
        if (r32 < 8) {
#pragma unroll
            for (int r = 0; r < 16; ++r) dp[((r & 3) + 8 * (r >> 2)) * 8] = d[r]; }
        LDS_WAIT(); __syncthreads();
        { const int row = tid >> 3, j = tid & 7; const LAS float* q = (const LAS float*)lds + row * 8 + j;
          DTR[(size_t)(64 * p + row) * 8 + j] = ((q[0] + q[512]) + (q[1024] + q[1536])) * pg8::rstd_of(rss, 64 * p + row); }
        LDS_WAIT(); __syncthreads();
    }
}

__device__ __forceinline__ int moe_tables(LAS int* pan, gu32* ecnt, int tid) {
    int cnt[NE], ps[NE + 1]; ps[0] = 0;
#pragma unroll
    for (int e = 0; e < NE; ++e) { cnt[e] = (int)__hip_atomic_load(ecnt + 64 * e, RLX_AGENT); ps[e + 1] = ps[e] + ((cnt[e] + 255) >> 8); }
    if (tid < 256) { int e = 0, c = cnt[0], p0 = 0;
#pragma unroll
        for (int q = 1; q < NE; ++q) if (tid >= ps[q]) { e = q; c = cnt[q]; p0 = ps[q]; }
        const int j = tid - p0, real = min(256, c - 256 * j);
        if (tid < ps[NE]) pan[tid] = e | (j << 8) | ((real - 1) << 16); }
    LDS_WAIT(); __syncthreads();
    return ps[NE];
}
#define KARGP ((const __attribute__((address_space(4))) char*)__builtin_amdgcn_kernarg_segment_ptr())
enum { PH_PRO = 0, PH_L0 = 1, PH_FFNUP = 6, PH_FFNDN = 7, PH_L1 = 8, PH_ROUTE = 13, PH_MOEUP = 14, PH_MOEDN = 15, PH_FINAL = 16, PH_N = 17 };
#define ws (*(unsigned char* const __attribute__((address_space(4)))*)(KARGP + 168))
#define ctl ((gu32*)(ws + WS_CTL))
#define IN(k) (lo <= (k) && (k) < hi)
#ifndef PROBE_MASK
#define PROBE_MASK 0u
#endif
#define PB(k) _Pragma("unroll") for (int rep_ = 0; rep_ < (int)((PROBE_MASK >> (k)) & 1u) + 1; ++rep_) {
#define PE(k) if (rep_ + 1 < (int)((PROBE_MASK >> (k)) & 1u) + 1) xcd_barrier(bar); }
#define SEAM(k) do { if (IN(k) && IN((k) + 1)) xcd_barrier(bar); } while (0)
#define KARG_F(i) (*(const float* const __attribute__((address_space(4)))*)(KARGP + 8 * (i)))
#define x_in KARG_F(0)
#define mix_g KARG_F(1)
#define w_in KARG_F(2)
#define attn_g KARG_F(8)
#define ssd_g KARG_F(9)
#define w_out KARG_F(10)
#define ffn_g KARG_F(11)
#define dwg KARG_F(12)
#define dwu KARG_F(13)
#define dwd KARG_F(14)
#define router_w KARG_F(15)
#define mwg KARG_F(16)
#define mwu KARG_F(17)
#define mwd KARG_F(18)
#define final_g KARG_F(19)
#define conv_w KARG_F(3)
#define conv_b KARG_F(4)
#define dt_bias KARG_F(5)
#define a_log KARG_F(6)
#define d_skip KARG_F(7)
#define OUTF (*(float* const __attribute__((address_space(4)))*)(KARGP + 160))
#define XR ((bf16*)(ws + WS_XR))
#define WIN_T ((bf16*)(ws + WS_WIN))
#define WOUT_T ((bf16*)(ws + WS_WOUT))
#define WDGU_T ((bf16*)(ws + WS_WDGU))
#define WDD_T ((bf16*)(ws + WS_WDD))
#define WDGU8 ((unsigned char*)(ws + WS_WDGU))
#define WDD8 ((unsigned char*)(ws + WS_WDD))
#define HB8 ((unsigned char*)(ws + WS_HB))
#define WMGU_T ((bf16*)(ws + WS_R1))
#define WMGU8 ((unsigned char*)(ws + WS_R1))
#define WMD8 ((unsigned char*)(ws + WS_R1 + 60 * MiB))
#define XB8 ((unsigned char*)(ws + WS_XBCC))
#define HID8 ((unsigned char*)(ws + WS_R3))
#define PROJ ((bf16*)(ws + WS_PROJ))
#define AO ((bf16*)(ws + WS_AO))
#define HB ((bf16*)(ws + WS_HB))
#define HPERM ((bf16*)(ws + WS_R2))
#define YB ((bf16*)(ws + WS_R2))
#define YPB ((bf16*)(ws + WS_XN))
#define HID ((bf16*)(ws + WS_R3))
#define RSS(s) ((float*)(ws + WS_RSS) + (size_t)(s) * MT * 16)
#define DTRAW ((float*)(ws + WS_DTRAW))
#define WDT ((bf16*)(ws + WS_WDT))
#define ROWTOK_V ((int*)(ws + WS_RTOKV))
#define ROWG_V ((float*)(ws + WS_RGV))
#define ROWS_V ((float*)(ws + WS_RSV))
#define ACUM ((float*)(ws + WS_DTV))
#define CCB ((bf16*)(ws + WS_XBCC))
#define YDB ((float*)(ws + WS_ATTRAW))
#define STB ((float*)(ws + WS_YRAW))
#define ST2B ((float*)(ws + WS_ST2))
#define TOKE ((int*)(ws + WS_TOKE))
#define TOKR ((int*)(ws + WS_TOKR))
#define TOKG ((float*)(ws + WS_TOKG))
#define TOKP ((int*)(ws + WS_TOKP))
#define ROWG ((float*)(ws + WS_ROWG))
#define PTAB ((int*)(ws + WS_PTAB))
#define ECNT (ctl + CW_ECNT)

struct ConvDesc { const float* src; unsigned char* dst; int gko, ldw, pitch; float scale; int fp8; };
constexpr int GT_MIX1 = 0, GT_FFN0 = DM, GT_FFN1 = 2 * DM, GT_ONE = 3 * DM, GT_N = 3 * DM + 64;
constexpr int CI_IN = (DM / 64) * (NPROJ / 64), CI_OUT = (DM / 64) * (DM / 64), CI_DGU = 2 * (DM / 64) * (DFF / 64), CI_DD = (DFF / 64) * (DM / 64), CI_MGU = 2 * (DM / 64) * (DFFE / 64), CI_MD = (DFFE / 64) * (DM / 64);
constexpr int CI_DONOR = CI_IN + 2 * CI_OUT + CI_DGU + CI_DD + NE * CI_MGU + NE_PRO * CI_MD;
__device__ __forceinline__ ConvDesc conv_decode(int r) {
    ConvDesc d; d.gko = GT_ONE; d.scale = 1.f; d.fp8 = 0;
    if (r < CI_IN) { const int kb = r / (NPROJ / 64), nb = r % (NPROJ / 64);
        d.src = w_in + (size_t)DM * DINP + (size_t)(64 * kb) * DINP + 64 * nb; d.ldw = DINP; d.gko = GT_MIX1 + 64 * kb; d.dst = (unsigned char*)(WIN_T + (size_t)NPROJ * DM + (size_t)(64 * nb) * DM + 64 * kb); d.pitch = DM * 2; return d; }
    r -= CI_IN;
    if (r < 2 * CI_OUT) { const int l = r / CI_OUT, q = r % CI_OUT, kb = q / (DM / 64), nb = q % (DM / 64);
        d.src = w_out + (size_t)l * DM * DM + (size_t)(64 * kb) * DM + 64 * nb; d.ldw = DM; d.dst = (unsigned char*)(WOUT_T + (size_t)l * DM * DM + (size_t)(64 * nb) * DM + 64 * kb); d.pitch = DM * 2; return d; }
    r -= 2 * CI_OUT;
    if (r < CI_DGU) { const int nblk = DFF / 64, per = (DM / 64) * nblk, half = r / per, q = r % per, kb = q / nblk, nb = q % nblk, f0 = 64 * nb, drow0 = (f0 / 128) * 256 + half * 128 + (f0 % 128);
        d.src = (half ? dwu : dwg) + (size_t)(64 * kb) * DFF + f0; d.ldw = DFF; d.gko = GT_FFN0 + 64 * kb; d.scale = WU_SCALE; d.fp8 = 1; d.dst = WDGU8 + (size_t)drow0 * DM + 64 * kb; d.pitch = DM; return d; }
    r -= CI_DGU;
    if (r < CI_DD) { const int kb = r / (DM / 64), nb = r % (DM / 64);
        d.src = dwd + (size_t)(64 * kb) * DM + 64 * nb; d.ldw = DM; d.dst = (unsigned char*)(WDD_T + (size_t)(64 * nb) * DFF + 64 * kb); d.pitch = DFF * 2; return d; }
    r -= CI_DD;
    if (r < NE * CI_MGU) { const int e = r / CI_MGU, q = r % CI_MGU, nblk = DFFE / 64, per = (DM / 64) * nblk, half = q / per, qq = q % per, kb = qq / nblk, nb = qq % nblk, f0 = 64 * nb, drow0 = (f0 / 128) * 256 + half * 128 + (f0 % 128);
        d.src = (half ? mwu : mwg) + (size_t)e * DM * DFFE + (size_t)(64 * kb) * DFFE + f0; d.ldw = DFFE; d.gko = GT_FFN1 + 64 * kb; d.scale = WU_SCALE; d.fp8 = 1;
        d.dst = WMGU8 + (size_t)e * 2 * DFFE * DM + (size_t)drow0 * DM + 64 * kb; d.pitch = DM; return d; }
    r -= NE * CI_MGU;
    { const int e = (NE - NE_PRO) + r / CI_MD, q = r % CI_MD, kb = q / (DM / 64), nb = q % (DM / 64);
        d.src = mwd + (size_t)e * DFFE * DM + (size_t)(64 * kb) * DM + 64 * nb; d.ldw = DM; d.scale = WD_SCALE; d.fp8 = 1; d.dst = WMD8 + (size_t)e * DM * DFFE + (size_t)(64 * nb) * DFFE + 64 * kb; d.pitch = DFFE; return d; }
}
__device__ __forceinline__ void conv_ld(const ConvDesc& d, f32x4 (&v)[16], int lane) {
    asm volatile("" : "+v"(lane));
    const float* s = d.src + (size_t)(16 * (lane >> 4)) * d.ldw + 4 * (lane & 15);
#pragma unroll
    for (int i = 0; i < 16; ++i) v[i] = __builtin_nontemporal_load((const GAS f32x4*)(s + (size_t)i * d.ldw));
}
__device__ __forceinline__ void conv_st(const ConvDesc& d, f32x4 (&v)[16], LAS unsigned char* scr, const LAS float* gtab, int lane) {
    asm volatile("" : "+v"(lane));
    const int kq = lane >> 4, n4 = lane & 15;
    { const LAS f32x4* gt = (const LAS f32x4*)(gtab + d.gko + 16 * kq);
#pragma unroll
      for (int q = 0; q < 4; ++q) { const f32x4 g4 = gt[q] * d.scale;
#pragma unroll
          for (int i = 0; i < 4; ++i) v[4 * q + i] = v[4 * q + i] * g4[i]; } }
    if (d.fp8) {
#pragma unroll
        for (int j = 0; j < 4; ++j) { int w[4];
#pragma unroll
            for (int q = 0; q < 4; ++q) { w[q] = __builtin_amdgcn_cvt_pk_fp8_f32(v[4 * q][j], v[4 * q + 1][j], 0, false); w[q] = __builtin_amdgcn_cvt_pk_fp8_f32(v[4 * q + 2][j], v[4 * q + 3][j], w[q], true); }
            *(LAS v4u*)(scr + (4 * n4 + j) * 80 + kq * 16) = (v4u){(unsigned)w[0], (unsigned)w[1], (unsigned)w[2], (unsigned)w[3]}; }
        LDS_WAIT(); asm volatile("" ::: "memory");
#pragma unroll
        for (int i = 0; i < 4; ++i) { const int idx = lane + 64 * i, n = idx >> 2, c = idx & 3;
            __builtin_nontemporal_store(*(const LAS v4u*)(scr + n * 80 + c * 16), (GAS v4u*)(d.dst + (size_t)n * d.pitch + 16 * c)); }
        LDS_WAIT(); asm volatile("" ::: "memory");
    } else {
#pragma unroll
        for (int j = 0; j < 4; ++j) { v4u a, b;
            a.x = sba::cvtpk(v[0][j], v[1][j]); a.y = sba::cvtpk(v[2][j], v[3][j]); a.z = sba::cvtpk(v[4][j], v[5][j]); a.w = sba::cvtpk(v[6][j], v[7][j]);
            b.x = sba::cvtpk(v[8][j], v[9][j]); b.y = sba::cvtpk(v[10][j], v[11][j]); b.z = sba::cvtpk(v[12][j], v[13][j]); b.w = sba::cvtpk(v[14][j], v[15][j]);
            LAS unsigned char* p = scr + (4 * n4 + j) * 144 + kq * 32;
            *(LAS v4u*)p = a; *(LAS v4u*)(p + 16) = b; }
        LDS_WAIT(); asm volatile("" ::: "memory");
#pragma unroll
        for (int i = 0; i < 8; ++i) { const int n = 8 * i + (lane >> 3), c = lane & 7;
            __builtin_nontemporal_store(*(const LAS v4u*)(scr + n * 144 + c * 16), (GAS v4u*)(d.dst + (size_t)n * d.pitch + 16 * c)); }
        LDS_WAIT(); asm volatile("" ::: "memory");
    }
}
__device__ __forceinline__ void donor_convert(LAS unsigned char* lds, const int w0, const int nw, const int wave, const int lane, const int tid) {
    LAS float* gtab = (LAS float*)(lds + NWAVES * 16384); LAS unsigned char* scr = lds + wave * 16384;
    for (int i = tid; i < GT_N; i += NWAVES * 64) gtab[i] = (i < DM) ? mix_g[DM + i] : (i < 3 * DM) ? ffn_g[i - DM] : 1.f;
    LDS_WAIT(); __syncthreads();
    f32x4 va[16], vb[16];
    conv_ld(conv_decode(min(w0, CI_DONOR - 1)), va, lane);
    for (int r = w0; r < CI_DONOR; r += 2 * nw) {
        const int r2 = r + nw, r3 = r + 2 * nw;
        conv_ld(conv_decode(min(r2, CI_DONOR - 1)), vb, lane);
        conv_st(conv_decode(r), va, scr, gtab, lane);
        conv_ld(conv_decode(min(r3, CI_DONOR - 1)), va, lane);
        if (r2 < CI_DONOR) conv_st(conv_decode(r2), vb, scr, gtab, lane);
    }
    asm volatile("" :: "v"(va[0]), "v"(va[15]));
}

template <int layer>
__device__ __forceinline__ void layer_phases(LAS unsigned char* L, const XcdBarrier& bar, const int lo, const int hi, const int tid, const int lane, const int wave, const int G, const int bx, const int gw, const int NGW) {
        const int pb = layer ? PH_L1 : PH_L0;
        if (IN(pb + 0)) {
            PB(pb + 0)
            const int GG = (layer == 0 && G >= 8) ? G - 3 * G / 8 : G;
            if (bx < GG) {
            pg8::Gemm g{XR, WIN_T + (size_t)layer * NPROJ * DM, MT, NPROJ, DM, DM}; pg8::StaticOrder S; S.init(MT, NPROJ, GG, bx);
            pg8::fill_rs<1>((LAS float*)(L + RS_TAB_OFF), S, RSS(layer ? 2 : 0), tid);
            pg8::EpiBf16 E{PROJ, NPROJ, 512, 0.125f * 1.4426950408889634f, (const LAS float*)(L + RS_TAB_OFF)};
            pg8::gemm_phase<pg8::EpiBf16, pg8::StaticOrder, true, true>(L + RING_OFF, g, S, E);
            dt_tail(XR, WDT + layer * 8 * DM, RSS(layer ? 2 : 0), DTRAW, L + RING_OFF, (GG % 8 == 0) ? (bx % 8) * (GG / 8) + bx / 8 : bx, GG, wave, lane, tid);
            } else { if constexpr (layer == 0) donor_convert(L + RING_OFF, (bx - GG) * NWAVES + wave, (G - GG) * NWAVES, wave, lane, tid); }
            PE(pb + 0)
        }
        SEAM(pb + 0);
        if (IN(pb + 1)) {
            PB(pb + 1)
            const ssd::ATensors T{PROJ, conv_w + layer * 4096, conv_b + layer * 1024, DTRAW, dt_bias + layer * 8, a_log + layer * 8, d_skip + layer * 8, (bf16*)YDB, (bf16*)STB, CCB, ACUM};
            for (int u = ((G % 8 == 0) ? (bx % 8) * (G / 8) + bx / 8 : bx); u < BATCH * 16 * 2; u += G) ssd::phaseA_unit(u >> 5, (u >> 1) & 15, u & 1, T, L + RING_OFF, wave, lane);
            PE(pb + 1)
        }
        const bool split12 = IN(pb + 1) && IN(pb + 2);
        if (split12) xcd_arrive(bar, (unsigned*)(ctl + CW_BAR2));
        if (IN(pb + 2)) {
            PB(pb + 2)
            int par = 0;
            for (int u = ((G % 8 == 0) ? (bx % 8) * (G / 8) + bx / 8 : bx); u < BATCH * (SEQ / 64); u += G) { sba::attn_unit(u >> 5, (SEQ / 64 - 1) - (u & 31), PROJ, attn_g + layer * 512, AO, L + RING_OFF, wave, lane, par); par ^= 1; }
            if (split12) xcd_wait(bar, (unsigned*)(ctl + CW_BAR2), (unsigned)layer + 1u);
            ssd::scan_states((const bf16*)STB, (bf16*)ST2B, ACUM, bx * (NWAVES * 64) + tid, G * NWAVES * 64);
            PE(pb + 2)
        }
        SEAM(pb + 2);
        if (IN(pb + 3)) {
            PB(pb + 3)
            const ssd::BTensors T{PROJ, (const bf16*)YDB, (const bf16*)ST2B, CCB, ACUM, ssd_g + layer * 512, AO};
            for (int u = ((G % 8 == 0) ? (bx % 8) * (G / 8) + bx / 8 : bx); u < BATCH * 16 * 2; u += G) ssd::phaseB_unit(u >> 5, (u >> 1) & 15, u & 1, T, L + RING_OFF, wave, lane, tid);
            PE(pb + 3)
        }
        SEAM(pb + 3);
        if (IN(pb + 4)) {
            PB(pb + 4)
            pg8::Gemm g{AO, WOUT_T + (size_t)layer * DM * DM, MT, DM, DM, DM}; pg8::StaticOrder S; S.init(MT, DM, G, bx, 8);
            pg8::EpiResAddNorm E{XR, DM, RSS(layer ? 3 : 1), XB8, 1.f};
            pg8::gemm_phase<pg8::EpiResAddNorm, pg8::StaticOrder, true, true>(L + RING_OFF, g, S, E);
            PE(pb + 4)
        }
        SEAM(pb + 4);
    }
__global__ void __launch_bounds__(NWAVES * 64, 2) mk_fwd(Args args) {
    extern __shared__ __attribute__((aligned(16))) unsigned char lds[];
    LAS unsigned char* L = (LAS unsigned char*)lds;
    const int tid = threadIdx.x, lane = tid & 63, wave = __builtin_amdgcn_readfirstlane(tid >> 6);
    const int G = gridDim.x; const int bx = blockIdx.x; const int vcu = (G % 8 == 0) ? (bx % 8) * (G / 8) + bx / 8 : bx;
    const int gw = vcu * NWAVES + wave, NGW = G * NWAVES;
    for (int u = tid; u < (LDS_BYTES - LDSCTL_OFF) / 4; u += NWAVES * 64) ((LAS unsigned*)(L + LDSCTL_OFF))[u] = 0u;
    __syncthreads();
    const int lo = *(const __attribute__((address_space(4))) int*)(KARGP + 176), hi = *(const __attribute__((address_space(4))) int*)(KARGP + 180);
    XcdBarrier bar; bar.bar = (unsigned*)(ctl + CW_BAR); bar.x = 0; bar.st = nullptr;
    if (hi - lo > 1) bar = xcd_barrier_post((unsigned*)(ctl + CW_BAR), (volatile LAS unsigned*)(L + MISC_OFF) + 8);
    if (IN(PH_PRO)) {
        PB(PH_PRO)
        LAS unsigned char* scr = L + RING_OFF + wave * 16384;
        for (int it = gw; it < CI_IN; it += NGW) conv_plain(w_in, DINP, DM, NPROJ, WIN_T, it, scr, lane, mix_g);
        xb_rows(x_in, mix_g, XR, RSS(0), gw, NGW, lane);
        { const int idx = bx * (NWAVES * 64) + tid; if (idx < 2 * 8 * DM) { const int l = idx >> 13, j = (idx >> 10) & 7, k = idx & 1023; WDT[idx] = (bf16)f2bf(w_in[(size_t)l * DM * DINP + (size_t)k * DINP + NPROJ + j] * mix_g[l * DM + k]); } }
        PE(PH_PRO)
    }
    SEAM(PH_PRO);
    layer_phases<0>(L, bar, lo, hi, tid, lane, wave, G, bx, gw, NGW);
    if (IN(PH_FFNUP)) {
        PB(PH_FFNUP)
        pg8::Gemm g{(const pg8::bf16_t*)XB8, (const pg8::bf16_t*)WDGU8, MT, 2 * DFF, DM, DM}; pg8::StaticOrder S; S.init(MT, 2 * DFF, G, bx);
        pg8::fill_rs<1>((LAS float*)(L + RS_TAB_OFF), S, RSS(1), tid, 1.f / WU_SCALE);
        pg8::EpiSwiGLU E{HB, DFF, (const LAS float*)(L + RS_TAB_OFF)};
        pg8::gemm_phase<pg8::EpiSwiGLU, pg8::StaticOrder, true, true, 1>(L + RING_OFF, g, S, E);
        {
            const int nfull = S.nwg % G;
            if (nfull > 0 && bx >= nfull) { LAS unsigned char* scr = L + RING_OFF + wave * 16384; constexpr int I_MD = (DFFE / 64) * (DM / 64); const int nid = (G - nfull) * NWAVES;
                for (int it = (bx - nfull) * NWAVES + wave; it < (NE - NE_PRO) * I_MD; it += nid) { const int e = it / I_MD, q = it % I_MD, kb = q / (DM / 64), nb = q % (DM / 64);
                    transpose_item8(mwd + (size_t)e * DFFE * DM, DM, WMD8 + (size_t)e * DM * DFFE, DFFE, 64 * kb, 64 * nb, 64 * nb, WD_SCALE, scr, lane); } }
            else if (nfull == 0) { LAS unsigned char* scr = L + RING_OFF + wave * 16384; constexpr int I_MD = (DFFE / 64) * (DM / 64);
                for (int it = gw; it < (NE - NE_PRO) * I_MD; it += NGW) { const int e = it / I_MD, q = it % I_MD, kb = q / (DM / 64), nb = q % (DM / 64);
                    transpose_item8(mwd + (size_t)e * DFFE * DM, DM, WMD8 + (size_t)e * DM * DFFE, DFFE, 64 * kb, 64 * nb, 64 * nb, WD_SCALE, scr, lane); } }
        }
        PE(PH_FFNUP)
    }
    SEAM(PH_FFNUP);
    if (IN(PH_FFNDN)) {
        PB(PH_FFNDN)
        pg8::Gemm g{HB, WDD_T, MT, DM, DFF, DFF}; pg8::StaticOrder S; S.init(MT, DM, G, bx, 8);
        pg8::EpiResAddNorm E{XR, DM, RSS(2), nullptr, 1.f};
        pg8::gemm_phase<pg8::EpiResAddNorm, pg8::StaticOrder, true, true>(L + RING_OFF, g, S, E);
        PE(PH_FFNDN)
    }
    SEAM(PH_FFNDN);
    layer_phases<1>(L, bar, lo, hi, tid, lane, wave, G, bx, gw, NGW);
    if (IN(PH_ROUTE)) {
        PB(PH_ROUTE)
        LAS float* tab = (LAS float*)(L + RING_OFF);
        load_tab8(router_w, 8, tab, tid);
        route_rows(XR, ffn_g + DM, RSS(3), tab, (LAS int*)(L + RING_OFF + 32768), TOKE, TOKR, ROWTOK_V, ROWG_V, ROWS_V, ECNT, gw, NGW, lane, tid);
        PE(PH_ROUTE)
    }
    SEAM(PH_ROUTE);
    if (IN(PH_MOEUP)) {
        PB(PH_MOEUP)
        const int P = moe_tables((LAS int*)(L + PAN_TAB_OFF), ECNT, tid);
        pg8::Gemm g{(const pg8::bf16_t*)XB8, (const pg8::bf16_t*)WMGU8, P * 256, 2 * DFFE, DM, DM}; pg8::GroupedOrder<true> S; S.init(P, 2 * DFFE / 256, G, bx, (const LAS int*)(L + PAN_TAB_OFF), (const LAS unsigned short*)(L + TOK_TAB_OFF), (long)2 * DFFE * DM);
        pg8::fill_grouped((LAS float*)(L + RS_TAB_OFF), (LAS unsigned short*)(L + TOK_TAB_OFF), S, ROWS_V, ROWTOK_V, tid, 1.f / WU_SCALE);
        pg8::EpiSwiGLU8 E{HID8, DFFE, (const LAS float*)(L + RS_TAB_OFF)};
        pg8::gemm_phase<pg8::EpiSwiGLU8, pg8::GroupedOrder<true>, true, true, 1>(L + RING_OFF, g, S, E);
        PE(PH_MOEUP)
    }
    SEAM(PH_MOEUP);
    if (IN(PH_MOEDN)) {
        PB(PH_MOEDN)
        const int P = moe_tables((LAS int*)(L + PAN_TAB_OFF), ECNT, tid);
        {
            pg8::Gemm g{(const pg8::bf16_t*)HID8, (const pg8::bf16_t*)WMD8, 128 * 256, DM, DFFE, DFFE}; pg8::GroupedOrder<false> S; S.init(128, DM / 256, G, bx, (const LAS int*)(L + PAN_TAB_OFF), nullptr, (long)DM * DFFE, 8);
            pg8::fill_grouped((LAS float*)(L + RS_TAB_OFF), (LAS unsigned short*)nullptr, S, ROWG_V, nullptr, tid, 1.f / WD_SCALE);
            pg8::EpiRowScaleBf16 E{YB, DM, (const LAS float*)(L + RS_TAB_OFF)};
            pg8::gemm_phase<pg8::EpiRowScaleBf16, pg8::GroupedOrder<false>, true, true, 1>(L + RING_OFF, g, S, E);
        }
        if (P > 128) {
            pg8::Gemm g{(const pg8::bf16_t*)HID8, (const pg8::bf16_t*)WMD8, P * 256, DM, 512, DFFE}; pg8::TailOrder S; S.init(P, G, bx, (const LAS int*)(L + PAN_TAB_OFF), (long)DM * DFFE, 1);
            pg8::fill_grouped((LAS float*)(L + RS_TAB_OFF), (LAS unsigned short*)nullptr, S, ROWG_V, nullptr, tid, 1.f / WD_SCALE);
            pg8::EpiRowScaleBf16 E{YPB, DM, (const LAS float*)(L + RS_TAB_OFF)};
            pg8::gemm_phase<pg8::EpiRowScaleBf16, pg8::TailOrder, true, true, 1>(L + RING_OFF, g, S, E);
        }
        PE(PH_MOEDN)
    }
    SEAM(PH_MOEDN);
    if (IN(PH_FINAL)) {
        PB(PH_FINAL)
        int off[NE + 1]; off[0] = 0;
#pragma unroll
        for (int e = 0; e < NE; ++e) { const int c = (int)__hip_atomic_load(ECNT + 64 * e, RLX_AGENT); off[e + 1] = off[e] + ((c + 255) & ~255); }
        f32x4 gv[4];
#pragma unroll
        for (int j = 0; j < 4; ++j) gv[j] = *((const GAS f32x4*)final_g + lane + 64 * j);
#define ADD4(v_, a_) do { v_.x += bfbits2f((unsigned)(a_) & 0xffffu); v_.y += bfbits2f((unsigned)(a_) >> 16); v_.z += bfbits2f((unsigned)((a_) >> 32) & 0xffffu); v_.w += bfbits2f((unsigned)((a_) >> 48)); } while (0)
        for (int m0 = gw; m0 < MT; m0 += 8 * NGW) {
            int pa[8], pc[8];
#pragma unroll
            for (int k = 0; k < 8; ++k) { const int m = m0 + k * NGW; pa[k] = 0; pc[k] = 0;
                if (m < MT) { const int ea = TOKE[2 * m], ec = TOKE[2 * m + 1]; int oa = 0, oc = 0;
#pragma unroll
                    for (int q = 0; q < NE; ++q) { oa = (ea == q) ? off[q] : oa; oc = (ec == q) ? off[q] : oc; }
                    pa[k] = oa + TOKR[2 * m]; pc[k] = oc + TOKR[2 * m + 1]; } }
#pragma unroll
            for (int k = 0; k < 8; k += 2) {
                unsigned long long xa[2][4], ya[2][4], yc[2][4];
#pragma unroll
                for (int h = 0; h < 2; ++h) { const int m = m0 + (k + h) * NGW;
                    if (m < MT) { const GAS unsigned long long* xb = (const GAS unsigned long long*)(XR + (size_t)m * DM) + lane;
#pragma unroll
                        for (int j = 0; j < 4; ++j) xa[h][j] = xb[64 * j];
                        if (pa[k + h] < 32768) { const GAS unsigned long long* y = (const GAS unsigned long long*)(YB + (size_t)pa[k + h] * DM) + lane;
#pragma unroll
                            for (int j = 0; j < 4; ++j) ya[h][j] = y[64 * j]; }
                        if (pc[k + h] < 32768) { const GAS unsigned long long* y = (const GAS unsigned long long*)(YB + (size_t)pc[k + h] * DM) + lane;
#pragma unroll
                            for (int j = 0; j < 4; ++j) yc[h][j] = y[64 * j]; } } }
#pragma unroll
                for (int h = 0; h < 2; ++h) { const int m = m0 + (k + h) * NGW;
                    if (m < MT) { GAS f32x4* xr = (GAS f32x4*)(OUTF + (size_t)m * DM) + lane;
                        f32x4 v[4]; float s = 0.f;
#pragma unroll
                        for (int j = 0; j < 4; ++j) { const unsigned long long a = xa[h][j]; v[j] = (f32x4){bfbits2f((unsigned)a & 0xffffu), bfbits2f((unsigned)a >> 16), bfbits2f((unsigned)(a >> 32) & 0xffffu), bfbits2f((unsigned)(a >> 48))}; }
#pragma unroll
                        for (int side = 0; side < 2; ++side) { const int pos = side ? pc[k + h] : pa[k + h];
                            if (pos < 32768) {
#pragma unroll
                                for (int j = 0; j < 4; ++j) { const unsigned long long a = side ? yc[h][j] : ya[h][j]; ADD4(v[j], a); } }
                            else { unsigned long long tp[7][4];
#pragma unroll
                                for (int sl = 0; sl < 7; ++sl) { const GAS unsigned long long* y = (const GAS unsigned long long*)(YPB + ((size_t)sl * 2048 + (pos - 32768)) * DM) + lane;
#pragma unroll
                                    for (int j = 0; j < 4; ++j) tp[sl][j] = y[64 * j]; }
#pragma unroll
                                for (int sl = 0; sl < 7; ++sl) {
#pragma unroll
                                    for (int j = 0; j < 4; ++j) ADD4(v[j], tp[sl][j]); } } }
#pragma unroll
                        for (int j = 0; j < 4; ++j) s += (v[j].x * v[j].x + v[j].y * v[j].y) + (v[j].z * v[j].z + v[j].w * v[j].w);
                        const float rstd = 1.f / sqrtf(wave_sum(s) * (1.f / DM) + EPS);
#pragma unroll
                        for (int j = 0; j < 4; ++j) xr[64 * j] = v[j] * rstd * gv[j]; } }
            }
        }
#undef ADD4
        PE(PH_FINAL)
    }
#undef IN
}

#undef ws
#undef ctl
#undef X
extern "C" void kernel_launch(void* const* d_in, const int* in_sizes, int n_in, void* d_out, int out_size, void* d_ws, size_t ws_size, hipStream_t stream) {
    static int grid = 0;
    if (grid == 0) {
        if (n_in != 20 || in_sizes[0] != MT * DM || out_size != MT * DM || ws_size < WS_END) { fprintf(stderr, "kernel_launch: unexpected shapes / workspace (n_in %d, ws %zu < %zu); nothing launched\n", n_in, ws_size, (size_t)WS_END); grid = -1; return; }
        int dev = 0, cus = 0;
        if (hipGetDevice(&dev) != hipSuccess || hipDeviceGetAttribute(&cus, hipDeviceAttributeMultiprocessorCount, dev) != hipSuccess) { grid = -1; return; }
        if (hipFuncSetAttribute((const void*)mk_fwd, hipFuncAttributeMaxDynamicSharedMemorySize, LDS_BYTES) != hipSuccess) { fprintf(stderr, "kernel_launch: hipFuncSetAttribute failed\n"); grid = -1; return; }
        int per_cu = 0;
        if (hipOccupancyMaxActiveBlocksPerMultiprocessor(&per_cu, (const void*)mk_fwd, NWAVES * 64, LDS_BYTES) != hipSuccess || per_cu < 1) { fprintf(stderr, "kernel_launch: occupancy query reports %d workgroups per CU for %d B of LDS; the grid would not be resident; nothing launched\n", per_cu, LDS_BYTES); grid = -1; return; }
        (void)hipGetLastError();
        grid = cus;
    }
    if (grid < 0) return;
    (void)hipMemsetAsync((char*)d_ws + WS_CTL, 0, CTL_ZERO_BYTES, stream);
    Args a{};
    for (int i = 0; i < 20; ++i) a.in[i] = (const float*)d_in[i];
    a.out = (float*)d_out; a.ws = (unsigned char*)d_ws;
    auto run = [&](int lo, int hi) { a.ph_lo = lo; a.ph_hi = hi; hipLaunchKernelGGL(mk_fwd, dim3(grid), dim3(NWAVES * 64), LDS_BYTES, stream, a); };
    run(PH_PRO, PH_N);
}
```

```cpp
#include <hip/hip_runtime.h>
#include <cstdio>
#include <cstdint>
namespace pg8 {
#define PG8_LAS __attribute__((address_space(3)))
typedef unsigned short bf16_t;
typedef short bf16x8 __attribute__((ext_vector_type(8)));
typedef short bf16x16 __attribute__((ext_vector_type(16)));
typedef int i32x8 __attribute__((ext_vector_type(8)));
typedef float f32x4 __attribute__((ext_vector_type(4)));
typedef unsigned u32x4 __attribute__((ext_vector_type(4)));
constexpr int BM = 256, BK = 64, HALF = 128, HTB = HALF * BK * 2  , STAGE_BYTES = 8 * HTB, NXCD = 8;

__host__ __device__ __forceinline__ int lds_byte(int r, int c) { const int st = (r >> 4) * 2 + (c >> 5), rr = r & 15, cc = c & 31, ob = rr * 64 + cc * 2; return st * 1024 + (ob ^ (((ob >> 9) & 1) << 5)); }
__host__ __device__ __forceinline__ void stage_rc(int b, int& R, int& C) { const int st = b / 1024, sb = b % 1024, swz = sb ^ (((sb >> 9) & 1) << 5); R = (st >> 1) * 16 + swz / 64; C = (st & 1) * 32 + (swz % 64) / 2; }
__host__ __device__ __forceinline__ int perm32(int rho) { const int n = rho >> 4, i = rho & 15; return 8 * (i >> 2) + 4 * n + (i & 3); }

struct Unit { int pm, pn; long boff; int ord; int arow0, avalid; long aoff, ooff; };
struct Gemm { const bf16_t* A; const bf16_t* Bt; int M, N, K, ld; };

struct StaticOrder {
    int nM, nN, nwg, G, c, WGM;
    __host__ __device__ void init(int M, int N, int G_, int c_, int wgm = 4) { nM = M / BM; nN = N / BM; nwg = nM * nN; G = G_; c = c_; WGM = wgm; }
    __host__ __device__ bool next(int i, Unit& u) const {
        const long L = (long)i * G + c; if (L >= nwg) return false;
        int wgid = (int)L; { const int q = nwg / NXCD, r = nwg % NXCD, xcd = wgid % NXCD, off = wgid / NXCD; wgid = (xcd < r ? xcd * (q + 1) : r * (q + 1) + (xcd - r) * q) + off; }
        const int nig = WGM * nN, gid = wgid / nig, fm = gid * WGM, gsz = (nM - fm) < WGM ? (nM - fm) : WGM;
        u.pm = fm + ((wgid % nig) % gsz); u.pn = (wgid % nig) / gsz; u.boff = 0; u.ord = i; u.arow0 = 0; u.avalid = BM; u.aoff = 0; u.ooff = 0; return true;
    }
    static constexpr bool GATHER = false;
    __device__ __forceinline__ int arow(const Unit&, int r) const { return r; }
    __device__ __forceinline__ void a_ready(const Unit&) const {}
    __device__ __forceinline__ void done(const Unit&) const {}
};

__device__ __forceinline__ unsigned cvt_pk_bf16(float lo, float hi) { unsigned r; asm volatile("v_cvt_pk_bf16_f32 %0, %1, %2" : "=v"(r) : "v"(lo), "v"(hi)); return r; }
typedef float f32x2 __attribute__((ext_vector_type(2)));

__device__ __forceinline__ float rstd_of(const float* rss, int row) {
    const f32x4 a = *(const f32x4*)(rss + (size_t)row * 16), b = *(const f32x4*)(rss + (size_t)row * 16 + 4), c = *(const f32x4*)(rss + (size_t)row * 16 + 8), d = *(const f32x4*)(rss + (size_t)row * 16 + 12);
    const float s = (((a[0] + a[1]) + (a[2] + a[3])) + ((b[0] + b[1]) + (b[2] + b[3]))) + (((c[0] + c[1]) + (c[2] + c[3])) + ((d[0] + d[1]) + (d[2] + d[3])));
    return __builtin_amdgcn_rsqf(s * (1.f / 1024.f) + 1e-5f);
}
__device__ __forceinline__ void epi_st16(void* p, u32x4 w, bool nt) { if (nt) __builtin_nontemporal_store(w, (__attribute__((address_space(1))) u32x4*)p); else *(u32x4*)p = w; }
__device__ __forceinline__ void epi_st8(void* p, unsigned long long w, bool nt) { if (nt) __builtin_nontemporal_store(w, (__attribute__((address_space(1))) unsigned long long*)p); else *(unsigned long long*)p = w; }
struct EpiBf16 {
    static constexpr bool PERM = true, AFTER_DRAIN = false;
    bf16_t* O; int ldc; int scale_cols; float scale0; const PG8_LAS float* rs;
    __device__ __forceinline__ void operator()(const f32x4 (&acc)[2][2][4][2], const Unit& u, int wr, int wc, int fr, int fq, const bool nt) const {
        const int row0 = u.pm * BM + wr * 64 + fr; const int colt = u.pn * BM;
        const float sc = (colt < scale_cols) ? scale0 : 1.f;
        const int col0 = colt + wc * 32 + 8 * fq;
        const PG8_LAS float* rsu = rs + u.ord * 256 + wr * 64 + fr;
#pragma unroll
        for (int ai = 0; ai < 2; ++ai)
#pragma unroll
            for (int m = 0; m < 4; ++m) { bf16_t* rowp = O + (size_t)(row0 + ai * HALF + m * 16) * ldc + col0;
                const float rsv = sc * rsu[ai * HALF + m * 16];
#pragma unroll
                for (int bj = 0; bj < 2; ++bj) { f32x4 v0 = acc[ai][bj][m][0] * rsv, v1 = acc[ai][bj][m][1] * rsv;
                    u32x4 w; w.x = cvt_pk_bf16(v0[0], v0[1]); w.y = cvt_pk_bf16(v0[2], v0[3]); w.z = cvt_pk_bf16(v1[0], v1[1]); w.w = cvt_pk_bf16(v1[2], v1[3]);
                    epi_st16(rowp + bj * HALF, w, nt); } }
    }
};
__device__ __forceinline__ float silu_mul(float g, float u) { return g * u * __builtin_amdgcn_rcpf(1.f + __builtin_amdgcn_exp2f(-1.4426950408889634f * g)); }
__device__ __forceinline__ f32x2 silu_mul2(f32x2 g, f32x2 u) {
    const f32x2 t = g * (-1.4426950408889634f); f32x2 e; e.x = __builtin_amdgcn_exp2f(t.x); e.y = __builtin_amdgcn_exp2f(t.y);
    const f32x2 d = e + 1.0f; f32x2 r; r.x = __builtin_amdgcn_rcpf(d.x); r.y = __builtin_amdgcn_rcpf(d.y);
    return (g * u) * r;
}
__device__ __forceinline__ f32x2 silu_mul2s(f32x2 g, f32x2 u, const float cs, const float is2) {
    const f32x2 t = g * cs; f32x2 e; e.x = __builtin_amdgcn_exp2f(t.x); e.y = __builtin_amdgcn_exp2f(t.y);
    const f32x2 d = e * is2 + is2; f32x2 r; r.x = __builtin_amdgcn_rcpf(d.x); r.y = __builtin_amdgcn_rcpf(d.y);
    return (g * u) * r;
}
__device__ __forceinline__ float inv_sq_scale(float s) { return s > 0.f ? __builtin_amdgcn_rcpf(s * s) : 1e30f; }
struct EpiSwiGLU {
    static constexpr bool PERM = true, AFTER_DRAIN = false;
    bf16_t* O; int ldc; const PG8_LAS float* rs;
    __device__ __forceinline__ void operator()(const f32x4 (&acc)[2][2][4][2], const Unit& u, int wr, int wc, int fr, int fq, const bool nt) const {
        const int row0 = u.pm * BM + wr * 64 + fr; const int col0 = u.pn * HALF + wc * 32 + 8 * fq;
        const PG8_LAS float* rsu = rs + u.ord * 256 + wr * 64 + fr;
#pragma unroll
        for (int ai = 0; ai < 2; ++ai)
#pragma unroll
            for (int m = 0; m < 4; ++m) { bf16_t* rowp = O + (size_t)(row0 + ai * HALF + m * 16) * ldc + col0;
                const float rsv = rsu[ai * HALF + m * 16], cs = rsv * -1.4426950408889634f, is2 = inv_sq_scale(rsv);
                const f32x4 g0 = acc[ai][0][m][0], g1 = acc[ai][0][m][1], u0 = acc[ai][1][m][0], u1 = acc[ai][1][m][1];
                const f32x2 s0 = silu_mul2s((f32x2){g0[0], g0[1]}, (f32x2){u0[0], u0[1]}, cs, is2), s1 = silu_mul2s((f32x2){g0[2], g0[3]}, (f32x2){u0[2], u0[3]}, cs, is2), s2 = silu_mul2s((f32x2){g1[0], g1[1]}, (f32x2){u1[0], u1[1]}, cs, is2), s3 = silu_mul2s((f32x2){g1[2], g1[3]}, (f32x2){u1[2], u1[3]}, cs, is2);
                u32x4 w; w.x = cvt_pk_bf16(s0.x, s0.y); w.y = cvt_pk_bf16(s1.x, s1.y); w.z = cvt_pk_bf16(s2.x, s2.y); w.w = cvt_pk_bf16(s3.x, s3.y);
                epi_st16(rowp, w, nt); }
    }
};
struct EpiSwiGLU8 {
    static constexpr bool PERM = true, AFTER_DRAIN = false;
    unsigned char* O; int ldc; const PG8_LAS float* rs;
    __device__ __forceinline__ void operator()(const f32x4 (&acc)[2][2][4][2], const Unit& u, int wr, int wc, int fr, int fq, const bool nt) const {
        const int row0 = u.pm * BM + wr * 64 + fr; const int col0 = u.pn * HALF + wc * 32 + 8 * fq;
        const PG8_LAS float* rsu = rs + u.ord * 256 + wr * 64 + fr;
#pragma unroll
        for (int ai = 0; ai < 2; ++ai)
#pragma unroll
            for (int m = 0; m < 4; ++m) { unsigned char* rowp = O + (size_t)(row0 + ai * HALF + m * 16) * ldc + col0;
                const float rsv = rsu[ai * HALF + m * 16], cs = rsv * -1.4426950408889634f, is2 = inv_sq_scale(rsv);
                const f32x4 g0 = acc[ai][0][m][0], g1 = acc[ai][0][m][1], u0 = acc[ai][1][m][0], u1 = acc[ai][1][m][1];
                const f32x2 s0 = silu_mul2s((f32x2){g0[0], g0[1]}, (f32x2){u0[0], u0[1]}, cs, is2), s1 = silu_mul2s((f32x2){g0[2], g0[3]}, (f32x2){u0[2], u0[3]}, cs, is2), s2 = silu_mul2s((f32x2){g1[0], g1[1]}, (f32x2){u1[0], u1[1]}, cs, is2), s3 = silu_mul2s((f32x2){g1[2], g1[3]}, (f32x2){u1[2], u1[3]}, cs, is2);
                int w0 = __builtin_bit_cast(int, s0.x), w1 = __builtin_bit_cast(int, s2.x);
                w0 = __builtin_amdgcn_cvt_pk_fp8_f32(s0.x, s0.y, w0, false); w0 = __builtin_amdgcn_cvt_pk_fp8_f32(s1.x, s1.y, w0, true);
                w1 = __builtin_amdgcn_cvt_pk_fp8_f32(s2.x, s2.y, w1, false); w1 = __builtin_amdgcn_cvt_pk_fp8_f32(s3.x, s3.y, w1, true);
                epi_st8(rowp, (unsigned long long)(unsigned)w0 | ((unsigned long long)(unsigned)w1 << 32), nt); }
    }
};
struct EpiResAddNorm {
    static constexpr bool PERM = true, AFTER_DRAIN = false;
    bf16_t* xr; int ldc; float* rss; unsigned char* X8; float asc;
    __device__ __forceinline__ void operator()(const f32x4 (&acc)[2][2][4][2], const Unit& u, int wr, int wc, int fr, int fq, const bool nt) const {
        const int col0 = u.pn * BM + wc * 32 + 8 * fq;
#pragma unroll
        for (int ai = 0; ai < 2; ++ai)
#pragma unroll
            for (int m = 0; m < 4; ++m) { const int row = u.pm * BM + ai * HALF + wr * 64 + m * 16 + fr; const size_t off = (size_t)row * ldc + col0; float ss = 0.f;
#pragma unroll
                for (int bj = 0; bj < 2; ++bj) {
                    const u32x4 q = *(const u32x4*)(xr + off + bj * HALF);
                    const f32x4 b0 = (f32x4){__builtin_bit_cast(float, q.x << 16), __builtin_bit_cast(float, q.x & 0xffff0000u), __builtin_bit_cast(float, q.y << 16), __builtin_bit_cast(float, q.y & 0xffff0000u)};
                    const f32x4 b1 = (f32x4){__builtin_bit_cast(float, q.z << 16), __builtin_bit_cast(float, q.z & 0xffff0000u), __builtin_bit_cast(float, q.w << 16), __builtin_bit_cast(float, q.w & 0xffff0000u)};
                    const f32x4 v0 = b0 + acc[ai][bj][m][0] * asc, v1 = b1 + acc[ai][bj][m][1] * asc;
                    { u32x4 w; w.x = cvt_pk_bf16(v0[0], v0[1]); w.y = cvt_pk_bf16(v0[2], v0[3]); w.z = cvt_pk_bf16(v1[0], v1[1]); w.w = cvt_pk_bf16(v1[2], v1[3]); epi_st16(xr + off + bj * HALF, w, nt); }
                    ss += (v0[0] * v0[0] + v0[1] * v0[1]) + (v0[2] * v0[2] + v0[3] * v0[3]) + (v1[0] * v1[0] + v1[1] * v1[1]) + (v1[2] * v1[2] + v1[3] * v1[3]);
                    if (X8) { int q0 = 0, q1 = 0;
                        q0 = __builtin_amdgcn_cvt_pk_fp8_f32(v0[0], v0[1], q0, false); q0 = __builtin_amdgcn_cvt_pk_fp8_f32(v0[2], v0[3], q0, true);
                        q1 = __builtin_amdgcn_cvt_pk_fp8_f32(v1[0], v1[1], q1, false); q1 = __builtin_amdgcn_cvt_pk_fp8_f32(v1[2], v1[3], q1, true);
                        epi_st8(X8 + off + bj * HALF, (unsigned long long)(unsigned)q0 | ((unsigned long long)(unsigned)q1 << 32), nt); } }
                ss += __shfl_xor(ss, 16); ss += __shfl_xor(ss, 32);
                if (fq == 0) rss[(size_t)row * 16 + u.pn * 4 + wc] = ss; }
    }
};
struct EpiRowScaleBf16 {
    static constexpr bool PERM = true, AFTER_DRAIN = false;
    bf16_t* O; int ldc; const PG8_LAS float* rs;
    __device__ __forceinline__ void operator()(const f32x4 (&acc)[2][2][4][2], const Unit& u, int wr, int wc, int fr, int fq, const bool nt) const {
        const int row0 = u.pm * BM + wr * 64 + fr; const int col0 = u.pn * BM + wc * 32 + 8 * fq;
        const PG8_LAS float* rsu = rs + u.ord * 256 + wr * 64 + fr;
#pragma unroll
        for (int ai = 0; ai < 2; ++ai)
#pragma unroll
            for (int m = 0; m < 4; ++m) { const int row = row0 + ai * HALF + m * 16; const float sc = rsu[ai * HALF + m * 16]; bf16_t* rowp = O + u.ooff + (long)row * ldc + col0;
#pragma unroll
                for (int bj = 0; bj < 2; ++bj) { f32x4 v0 = acc[ai][bj][m][0] * sc, v1 = acc[ai][bj][m][1] * sc;
                    u32x4 w; w.x = cvt_pk_bf16(v0[0], v0[1]); w.y = cvt_pk_bf16(v0[2], v0[3]); w.z = cvt_pk_bf16(v1[0], v1[1]); w.w = cvt_pk_bf16(v1[2], v1[3]);
                    epi_st16(rowp + bj * HALF, w, nt); } }
    }
};
template <bool GATHER_> struct GroupedOrder {
    static constexpr bool GATHER = GATHER_;
    int nM, nN, nwg, G, c, WGM; const PG8_LAS int* pan; const PG8_LAS unsigned short* tok; long estride;
    __device__ void init(int nM_, int nN_, int G_, int c_, const PG8_LAS int* pan_, const PG8_LAS unsigned short* tok_, long estride_, int wgm = 4) { nM = nM_; nN = nN_; nwg = nM * nN; G = G_; c = c_; pan = pan_; tok = tok_; estride = estride_; WGM = wgm; }
    __device__ bool next(int i, Unit& u) const {
        const long L = (long)i * G + c; if (L >= nwg) return false;
        int wgid = (int)L; { const int q = nwg / NXCD, r = nwg % NXCD, xcd = wgid % NXCD, off = wgid / NXCD; wgid = (xcd < r ? xcd * (q + 1) : r * (q + 1) + (xcd - r) * q) + off; }
        const int nig = WGM * nN, gid = wgid / nig, fm = gid * WGM, gsz = (nM - fm) < WGM ? (nM - fm) : WGM;
        u.pm = fm + ((wgid % nig) % gsz); u.pn = (wgid % nig) / gsz;
        const int pe = __builtin_amdgcn_readfirstlane(pan[u.pm]); const int e = pe & 255, j = (pe >> 8) & 255;
        u.boff = (long)e * estride; u.ord = i; u.arow0 = e * 16384 + 256 * j; u.avalid = ((pe >> 16) & 255) + 1; u.aoff = 0; u.ooff = 0; return true;
    }
    __device__ __forceinline__ int arow(const Unit& u, int r) const { return (int)tok[u.ord * 256 + r]; }
    __device__ __forceinline__ void a_ready(const Unit&) const {}
    __device__ __forceinline__ void done(const Unit&) const {}
};
struct TailOrder {
    static constexpr bool GATHER = false;
    int ntail, G, c; const PG8_LAS int* pan; long estride; int es;
    __device__ void init(int P, int G_, int c_, const PG8_LAS int* pan_, long estride_, int es_) { ntail = (P - 128) * 4 * 7; G = G_; c = c_; pan = pan_; estride = estride_; es = es_; }
    __device__ bool next(int i, Unit& u) const {
        const int L = i * G + c; if (L >= ntail) return false;
        const int s = L % 7, t = L / 7; u.pn = t & 3; u.pm = 128 + (t >> 2);
        const int pe = __builtin_amdgcn_readfirstlane(pan[u.pm]); const int e = pe & 255, j = (pe >> 8) & 255;
        u.aoff = (long)s * 512 * es; u.boff = (long)e * estride + (long)s * 512 * es; u.ord = i; u.arow0 = e * 16384 + 256 * j; u.avalid = ((pe >> 16) & 255) + 1;
        u.ooff = ((long)s * 2048 - 32768) * 1024; return true;
    }
    __device__ __forceinline__ int arow(const Unit&, int r) const { return r; }
    __device__ __forceinline__ void a_ready(const Unit&) const {}
    __device__ __forceinline__ void done(const Unit&) const {}
};
template <int MODE, class Sched> __device__ __forceinline__ void fill_rs(PG8_LAS float* tab, const Sched& S, const float* src, int tid, const float mul = 1.f) {
    for (int idx = tid;; idx += 512) { Unit u; if (!S.next(idx >> 8, u)) break;
        const int row = u.pm * BM + (idx & 255);
        tab[idx] = ((MODE == 1) ? rstd_of(src, row) : src[row]) * mul; }
    asm volatile("s_waitcnt lgkmcnt(0)" ::: "memory"); __syncthreads();
}
template <class Sched> __device__ __forceinline__ void fill_grouped(PG8_LAS float* tab, PG8_LAS unsigned short* tok, const Sched& S, const float* srcv, const int* tokv, int tid, const float mul = 1.f) {
    for (int idx = tid;; idx += 512) { Unit u; if (!S.next(idx >> 8, u)) break;
        const int r = idx & 255; const bool v = r < u.avalid;
        tab[idx] = v ? srcv[u.arow0 + r] * mul : 0.f;
        if (tok) tok[idx] = (unsigned short)(v ? tokv[u.arow0 + r] : 0); }
    asm volatile("s_waitcnt lgkmcnt(0)" ::: "memory"); __syncthreads();
}

template <class Epi, class Sched, bool ALIGN_EPI = false, bool SP2 = false, int ES = 2>
__device__ __forceinline__ void gemm_phase(PG8_LAS unsigned char* lds, const Gemm g, const Sched& S, const Epi& E) {
    const int tid = threadIdx.x, wid = __builtin_amdgcn_readfirstlane(tid >> 6), lane = tid & 63, wr = wid >> 2, wc = wid & 3, fr = lane & 15, fq = lane >> 4;
    const int PBy = g.ld * ES, nt = g.K * ES / 128;
    unsigned voffA0[2], voffA1[2], voffB[2];
    const size_t kstep = (size_t)(BK * 2);
    const size_t hstep = (size_t)HALF * PBy;
#pragma unroll
    for (int i = 0; i < 2; ++i) { int R, C; stage_rc(tid * 16 + i * 8192, R, C); const int Rb = Epi::PERM ? ((R & ~31) + perm32(R & 31)) : R;
        voffA0[i] = (unsigned)(R * PBy + C * 2); voffA1[i] = voffA0[i] + (unsigned)hstep; voffB[i] = (unsigned)(Rb * PBy + C * 2); }
#define PG8_SETA(u_) do { if constexpr (Sched::GATHER) { _Pragma("unroll") for (int i_ = 0; i_ < 2; ++i_) { int R_, C_; stage_rc(tid * 16 + i_ * 8192, R_, C_); \
        voffA0[i_] = (unsigned)(S.arow(u_, R_) * PBy + C_ * 2); voffA1[i_] = (unsigned)(S.arow(u_, R_ + HALF) * PBy + C_ * 2); } } } while (0)
    const size_t tstep = 2 * hstep;
    const unsigned ldsw = (unsigned)wid * 1024u;
    const int aoff = lds_byte(wr * 64 + fr, fq * 8), boff = lds_byte(wc * 32 + fr, fq * 8);
#define PG8_SA(b, h) (((b) * 2 + (h)) * HTB)
#define PG8_SB(b, h) ((4 + (b) * 2 + (h)) * HTB)
#define PG8_STAGE(bufoff, gbase, voff) do { _Pragma("unroll") for (int _i = 0; _i < 2; ++_i) \
        __builtin_amdgcn_global_load_lds((const unsigned*)((const char*)(gbase) + (voff)[_i]), (PG8_LAS unsigned*)(lds + (bufoff) + ldsw + _i * 8192), 16, 0, 0); } while (0)
#define PG8_LD8(p_) ({ const u32x4 lo_ = *(const PG8_LAS u32x4*)(p_), hi_ = *(const PG8_LAS u32x4*)((p_) + 1024); (i32x8){(int)lo_.x, (int)lo_.y, (int)lo_.z, (int)lo_.w, (int)hi_.x, (int)hi_.y, (int)hi_.z, (int)hi_.w}; })
#define PG8_LDA(dst, b, h) do { if constexpr (ES == 2) { _Pragma("unroll") for (int m = 0; m < 4; ++m) _Pragma("unroll") for (int k = 0; k < 2; ++k) dst[m][k] = *(const PG8_LAS bf16x8*)(lds + PG8_SA(b, h) + aoff + m * 2048 + k * 1024); } \
        else { _Pragma("unroll") for (int m = 0; m < 4; ++m) dst##8[m] = PG8_LD8(lds + PG8_SA(b, h) + aoff + m * 2048); } } while (0)
#define PG8_LDB(dst, b, h) do { if constexpr (ES == 2) { _Pragma("unroll") for (int n = 0; n < 2; ++n) _Pragma("unroll") for (int k = 0; k < 2; ++k) dst[n][k] = *(const PG8_LAS bf16x8*)(lds + PG8_SB(b, h) + boff + n * 2048 + k * 1024); } \
        else { _Pragma("unroll") for (int n = 0; n < 2; ++n) dst##8[n] = PG8_LD8(lds + PG8_SB(b, h) + boff + n * 2048); } } while (0)
#define PG8_MMA(ai, bj, At, Bt) do { __builtin_amdgcn_s_setprio(1); _Pragma("unroll") for (int m = 0; m < 4; ++m) _Pragma("unroll") for (int n = 0; n < 2; ++n) { \
        if constexpr (ES == 2) { _Pragma("unroll") for (int k = 0; k < 2; ++k) acc[ai][bj][m][n] = __builtin_amdgcn_mfma_f32_16x16x32_bf16(Bt[n][k], At[m][k], acc[ai][bj][m][n], 0, 0, 0); } \
        else asm volatile("v_mfma_scale_f32_16x16x128_f8f6f4 %0, %1, %2, %0, %3, %3 op_sel_hi:[0,0,0]" : "+v"(acc[ai][bj][m][n]) : "v"(Bt##8[n]), "v"(At##8[m]), "v"(0x7F7F7F7F)); } \
        __builtin_amdgcn_s_setprio(0); } while (0)
#define PG8_WAIT_V(n) asm volatile("s_waitcnt vmcnt(" #n ")" ::: "memory")
#define PG8_WAIT_L(n) asm volatile("s_waitcnt lgkmcnt(" #n ")" ::: "memory")
#define PG8_BAR __builtin_amdgcn_s_barrier()
#define PG8_SCHED __builtin_amdgcn_sched_barrier(0)
    Unit cur, nxt; int ui = 0;
    if (!S.next(0, cur)) return;
    f32x4 acc[2][2][4][2];
#pragma unroll
    for (int a = 0; a < 2; ++a)
#pragma unroll
        for (int b = 0; b < 2; ++b)
#pragma unroll
            for (int m = 0; m < 4; ++m)
#pragma unroll
                for (int n = 0; n < 2; ++n) acc[a][b][m][n] = (f32x4){0.f, 0.f, 0.f, 0.f};
    bf16x8 At[4][2], B0[2][2], B1[2][2]; i32x8 At8[4], B08[2], B18[2];
    const char* cA = (const char*)g.A + (Sched::GATHER ? (size_t)0 : (size_t)cur.pm * tstep) + cur.aoff; const char* cB = (const char*)g.Bt + (size_t)cur.pn * tstep + cur.boff;
    S.a_ready(cur);
    static_assert(SP2, "only the two-super-phase loop is kept in this file");
    PG8_SETA(cur);
    {
        PG8_STAGE(PG8_SB(0, 0), cB, voffB); PG8_STAGE(PG8_SB(0, 1), cB + hstep, voffB); PG8_STAGE(PG8_SA(0, 0), cA, voffA0); PG8_STAGE(PG8_SA(0, 1), cA, voffA1);
        if (wr == 1) PG8_BAR;
        PG8_WAIT_V(2); PG8_BAR;
        PG8_STAGE(PG8_SB(1, 0), cB + kstep, voffB); PG8_STAGE(PG8_SA(1, 0), cA + kstep, voffA0); PG8_STAGE(PG8_SB(1, 1), cB + hstep + kstep, voffB);
        PG8_WAIT_V(6); PG8_BAR;
    }
    for (;;) {
        const bool has_next = S.next(ui + 1, nxt);
        const char* nA = has_next ? (const char*)g.A + (Sched::GATHER ? (size_t)0 : (size_t)nxt.pm * tstep) + nxt.aoff : cA; const char* nB = has_next ? (const char*)g.Bt + (size_t)nxt.pn * tstep + nxt.boff : cB;
        for (int t = 0; t < nt; t += 2) {
            const bool last = (t == nt - 2);
            const char* a1 = cA + (size_t)(t + 1) * kstep;
            const char* a2 = last ? nA : cA + (size_t)(t + 2) * kstep; const char* b2 = last ? nB : cB + (size_t)(t + 2) * kstep;
            const char* a3 = a2 + kstep; const char* b3 = b2 + kstep;
            if (last && has_next) S.a_ready(nxt);
            {
            PG8_LDB(B0, 0, 0); PG8_LDB(B1, 0, 1); PG8_SCHED; PG8_LDA(At, 0, 0); PG8_STAGE(PG8_SA(1, 1), a1, voffA1);
            if (last && has_next) PG8_SETA(nxt);
            PG8_WAIT_V(8); PG8_WAIT_L(0); PG8_BAR; PG8_MMA(0, 0, At, B0); PG8_MMA(0, 1, At, B1); PG8_BAR; PG8_SCHED;
            PG8_LDA(At, 0, 1); PG8_STAGE(PG8_SB(0, 0), b2, voffB); PG8_STAGE(PG8_SB(0, 1), b2 + hstep, voffB); PG8_STAGE(PG8_SA(0, 0), a2, voffA0);
            PG8_WAIT_V(8); PG8_WAIT_L(0); PG8_BAR; PG8_MMA(1, 0, At, B0); PG8_MMA(1, 1, At, B1); PG8_BAR; PG8_SCHED;
            PG8_LDB(B0, 1, 0); PG8_LDB(B1, 1, 1); PG8_SCHED; PG8_LDA(At, 1, 0); PG8_STAGE(PG8_SA(0, 1), a2, voffA1);
            PG8_WAIT_V(8); PG8_WAIT_L(0); PG8_BAR; PG8_MMA(0, 0, At, B0); PG8_MMA(0, 1, At, B1); PG8_BAR; PG8_SCHED;
            PG8_LDA(At, 1, 1); PG8_STAGE(PG8_SB(1, 0), b3, voffB); PG8_STAGE(PG8_SB(1, 1), b3 + hstep, voffB); PG8_STAGE(PG8_SA(1, 0), a3, voffA0);
            PG8_WAIT_V(8); PG8_WAIT_L(0); PG8_BAR; PG8_MMA(1, 0, At, B0); PG8_MMA(1, 1, At, B1); PG8_BAR; PG8_SCHED;
            }
        }
        if constexpr (ALIGN_EPI) { if (wr == 0) PG8_BAR; }
        if constexpr (ES == 1) asm volatile("s_nop 15\n\ts_nop 15\n\ts_nop 15" ::: "memory");
        if constexpr (!Epi::AFTER_DRAIN) { E(acc, cur, wr, wc, fr, fq, !has_next); S.done(cur); }
        if (!has_next) break;
#pragma unroll
        for (int a = 0; a < 2; ++a)
#pragma unroll
            for (int b = 0; b < 2; ++b)
#pragma unroll
                for (int m = 0; m < 4; ++m)
#pragma unroll
                    for (int n = 0; n < 2; ++n) acc[a][b][m][n] = (f32x4){0.f, 0.f, 0.f, 0.f};
        cur = nxt; cA = nA; cB = nB; ++ui;
        if constexpr (ALIGN_EPI) { if (wr == 1) PG8_BAR; }
    }
    PG8_WAIT_V(0);
    if constexpr (!ALIGN_EPI) { if (wr == 0) PG8_BAR; }
    PG8_BAR;
    if constexpr (Epi::AFTER_DRAIN) { E.fused(acc, cur, wr, wc, fr, fq, lds, wid, lane); S.done(cur); }
#undef PG8_SA
#undef PG8_SB
#undef PG8_STAGE
#undef PG8_SETA
#undef PG8_LDA
#undef PG8_LDB
#undef PG8_MMA
#undef PG8_LD8
#undef PG8_WAIT_V
#undef PG8_WAIT_L
#undef PG8_BAR
#undef PG8_SCHED
}
}

#define GAS __attribute__((address_space(1)))
#define LAS __attribute__((address_space(3)))
typedef unsigned short bf16;
typedef unsigned v4u __attribute__((ext_vector_type(4)));
typedef float f32x4 __attribute__((ext_vector_type(4)));
typedef short bf16x8 __attribute__((ext_vector_type(8)));
typedef GAS unsigned gu32;
typedef GAS unsigned long long gu64;
#define RLX_AGENT __ATOMIC_RELAXED, __HIP_MEMORY_SCOPE_AGENT
#define LDS_WAIT() asm volatile("s_waitcnt lgkmcnt(0)" ::: "memory")
#define VM_WAIT() asm volatile("s_waitcnt vmcnt(0)" ::: "memory")
__device__ __forceinline__ unsigned long long rt() { return __builtin_amdgcn_s_memrealtime(); }
__device__ __forceinline__ unsigned f2bf(float f) { unsigned u = __builtin_bit_cast(unsigned, f); return (u + 0x7fffu + ((u >> 16) & 1u)) >> 16; }
__device__ __forceinline__ unsigned pk2(float lo, float hi) { return f2bf(lo) | (f2bf(hi) << 16); }

#define XB_TMO      128
#define XB_XCNT(j)  (256  + 64 * (j))
#define XB_XSUB(j)  (1280 + 64 * (j))
#define XB_XGEN(j)  (2304 + 64 * (j))
#define XB_TOP      3328
#define XB_TOPGEN   3392
#define XCD_BAR_WORDS 3456
#define XB_SPIN_CAP (1u << 18)

__device__ __forceinline__ unsigned xb_ld(unsigned* p)              { return __hip_atomic_load(p, __ATOMIC_RELAXED, __HIP_MEMORY_SCOPE_AGENT); }
__device__ __forceinline__ unsigned xb_add(unsigned* p, unsigned v) { return __hip_atomic_fetch_add(p, v, __ATOMIC_RELAXED, __HIP_MEMORY_SCOPE_AGENT); }
__device__ __forceinline__ unsigned xb_xcc_id() { return (unsigned)__builtin_amdgcn_s_getreg((3 << 11) | 20) & 0xFu; }
#define XB_SPIN(cond, bar) do { unsigned _sp = 0; while (cond) { __builtin_amdgcn_s_sleep(1); \
    if ((++_sp & 255u) == 0u) { if (xb_ld(&(bar)[XB_TMO])) break; if (_sp > XB_SPIN_CAP) { atomicAdd(&(bar)[XB_TMO], 1u); break; } } } } while (0)

struct XcdBarrier {
    unsigned* bar; unsigned x;
    volatile LAS unsigned* st;
};

__device__ __forceinline__ XcdBarrier xcd_barrier_post(unsigned* bar, volatile LAS unsigned* st) {
    XcdBarrier b; b.bar = bar; b.x = xb_xcc_id(); b.st = st;
    if (threadIdx.x == 0) (void)xb_add(&bar[XB_XCNT(b.x)], 1u);
    return b;
}
__device__ __forceinline__ void xcd_barrier_complete(unsigned* bar, unsigned x, unsigned& nloc, unsigned& nx) {
    const unsigned G = gridDim.x * gridDim.y * gridDim.z;
    unsigned sum, cnt, mine, sp = 0u;
    for (;;) {
        sum = 0u; cnt = 0u; mine = 0u;
#pragma unroll
        for (unsigned j = 0; j < 16; ++j) { const unsigned c = xb_ld(&bar[XB_XCNT(j)]); sum += c; cnt += (c > 0u) ? 1u : 0u; mine = (j == x) ? c : mine; }
        if (sum == G) break;
        __builtin_amdgcn_s_sleep(1);
        if ((++sp & 255u) == 0u) { if (xb_ld(&bar[XB_TMO])) break; if (sp > XB_SPIN_CAP) { atomicAdd(&bar[XB_TMO], 1u); break; } }
    }
    nloc = mine > 0u ? mine : 1u; nx = cnt > 0u ? cnt : 1u;
}

__device__ __forceinline__ void xcd_barrier(const XcdBarrier& b) {
    asm volatile("s_waitcnt vmcnt(0)" ::: "memory");
    __syncthreads();
    if (threadIdx.x == 0) {
        unsigned* bar = b.bar;
        __builtin_amdgcn_s_waitcnt(0);
        unsigned nloc = b.st[0], nx = b.st[1];
        if (nloc == 0u) { xcd_barrier_complete(bar, b.x, nloc, nx); b.st[0] = nloc; b.st[1] = nx; }
        const unsigned old = xb_add(&bar[XB_XSUB(b.x)], 1u);
        const unsigned gen = old / nloc;
        if (old + 1u == (gen + 1u) * nloc) {
            __builtin_amdgcn_fence(__ATOMIC_RELEASE, "agent");
            asm volatile("s_waitcnt vmcnt(0)" ::: "memory");
            const unsigned og = xb_add(&bar[XB_TOP], 1u);
            const unsigned tg = og / nx;
            if (og + 1u == (tg + 1u) * nx) xb_add(&bar[XB_TOPGEN], 1u);
            else XB_SPIN(xb_ld(&bar[XB_TOPGEN]) == tg, bar);
            __builtin_amdgcn_fence(__ATOMIC_ACQUIRE, "agent");
            xb_add(&bar[XB_XGEN(b.x)], 1u);
            asm volatile("s_waitcnt vmcnt(0)" ::: "memory");
        } else {
            XB_SPIN(xb_ld(&bar[XB_XGEN(b.x)]) == gen, bar);
            __builtin_amdgcn_fence(__ATOMIC_ACQUIRE, "agent");
            asm volatile("s_waitcnt vmcnt(0)" ::: "memory");
        }
    }
    __syncthreads();
}

__device__ __forceinline__ void xcd_arrive(const XcdBarrier& b, unsigned* bar2) {
    asm volatile("s_waitcnt vmcnt(0)" ::: "memory");
    __syncthreads();
    if (threadIdx.x == 0) {
        __builtin_amdgcn_s_waitcnt(0);
        const unsigned nloc = b.st[0], nx = b.st[1];
        const unsigned old = xb_add(&bar2[XB_XSUB(b.x)], 1u);
        const unsigned gen = old / nloc;
        if (old + 1u == (gen + 1u) * nloc) {
            __builtin_amdgcn_fence(__ATOMIC_RELEASE, "agent");
            asm volatile("s_waitcnt vmcnt(0)" ::: "memory");
            const unsigned og = xb_add(&bar2[XB_TOP], 1u);
            const unsigned tg = og / nx;
            if (og + 1u == (tg + 1u) * nx) xb_add(&bar2[XB_TOPGEN], 1u);
        }
    }
}
__device__ __forceinline__ void xcd_wait(const XcdBarrier& b, unsigned* bar2, const unsigned g) {
    if (threadIdx.x == 0) {
        XB_SPIN(xb_ld(&bar2[XB_TOPGEN]) < g, b.bar);
        __builtin_amdgcn_fence(__ATOMIC_ACQUIRE, "agent");
        asm volatile("s_waitcnt vmcnt(0)" ::: "memory");
    }
    __syncthreads();
}

__device__ __forceinline__ float bf2f(bf16 v) { return __builtin_bit_cast(float, (unsigned)v << 16); }
__device__ __forceinline__ float bfbits2f(unsigned bits) { return __builtin_bit_cast(float, bits << 16); }

constexpr int NWAVES = 8;
constexpr int BATCH = 8, SEQ = 2048, DM = 1024, MT = BATCH * SEQ;
constexpr int DINP = 3080, NPROJ = 3072;
constexpr int OQ = 0, OK_ = 512, OV = 1024, OZ = 1536, OXBC = 2048;
constexpr int NH = 8, HD = 64, SSTATE = 128;
constexpr int DFF = 2816, DFFE = 3584, NE = 8;
constexpr int MOE_ROWS = 2 * MT + NE * 256;
constexpr float EPS = 1e-5f;
constexpr int NE_PRO = 5;
constexpr float WU_SCALE = 32.f;
constexpr float WD_SCALE = 64.f;

constexpr size_t MiB = 1u << 20;
constexpr size_t WS_CTL = 0, CTL_ZERO_BYTES = 1 * MiB;
constexpr size_t WS_DTRAW = 1 * MiB, WS_DTV = WS_DTRAW + 512 * 1024;
constexpr size_t WS_TOKE = 2 * MiB, WS_TOKR = WS_TOKE + 128 * 1024, WS_TOKG = WS_TOKR + 128 * 1024, WS_TOKP = WS_TOKG + 128 * 1024;
constexpr size_t WS_ROWG = 2 * MiB + 512 * 1024, WS_ROWS = WS_ROWG + 160 * 1024, WS_PTAB = 3 * MiB, WS_WDT = 3 * MiB + 64 * 1024;
constexpr size_t WS_RTOKV = 1 * MiB, WS_RGV = 1 * MiB + 512 * 1024, WS_RSV = 3 * MiB + 256 * 1024;
constexpr size_t WS_RSS = 424 * MiB;
constexpr size_t WS_R1 = 4 * MiB;
constexpr size_t WS_WIN = 116 * MiB, WS_WOUT = 128 * MiB, WS_WDGU = 132 * MiB, WS_WDD = 143 * MiB;
constexpr size_t WS_AO = 149 * MiB;
constexpr size_t WS_R2 = 116 * MiB;
constexpr size_t WS_R3 = 184 * MiB;
constexpr size_t WS_PROJ = WS_R3, WS_HB = WS_R3, WS_XN = 428 * MiB;
constexpr size_t WS_XBCC = 312 * MiB, WS_ATTRAW = 328 * MiB, WS_XR = 344 * MiB, WS_YRAW = 376 * MiB;
constexpr size_t WS_ST2 = 408 * MiB;
constexpr size_t WS_END = 460 * MiB;
static_assert(WS_R3 + (size_t)MOE_ROWS * DFFE * 2 <= WS_END && WS_R2 + (size_t)MOE_ROWS * DM * 2 <= WS_R3 && WS_WDD + (size_t)DM * DFF * 2 <= WS_AO, "ws map");
constexpr int CW_TMO = 0, CW_CODE = 1, CW_BAR = 4096, CW_BAR2 = 8192, CW_ECNT = 16384;

constexpr int RING_OFF = 0, RING_BYTES = 159744;
constexpr int LDSCTL_OFF = RING_BYTES, MISC_OFF = LDSCTL_OFF + 320;
constexpr int TOK_TAB_OFF = 131072 + 15360, PAN_TAB_OFF = TOK_TAB_OFF + 7680;
constexpr int RS_TAB_OFF = 131072;
constexpr int LDS_BYTES = 163840;

typedef const float* cfp;
struct Args { const float* in[20]; float* out; unsigned char* ws; int ph_lo, ph_hi; };
static_assert(sizeof(Args) == 184, "Args layout");

template <int CTRL, int RMASK> __device__ __forceinline__ float dpp_addf(float v) {
    return v + __builtin_bit_cast(float, __builtin_amdgcn_update_dpp(0, __builtin_bit_cast(int, v), CTRL, RMASK, 0xf, true)); }
__device__ __forceinline__ float half_sums(float x) { x = dpp_addf<0xB1, 0xf>(x); x = dpp_addf<0x4E, 0xf>(x); x = dpp_addf<0x141, 0xf>(x); x = dpp_addf<0x140, 0xf>(x); return dpp_addf<0x142, 0xa>(x); }
__device__ __forceinline__ float wave_sum(float v) {
    const float x = half_sums(v);
    return __builtin_bit_cast(float, __builtin_amdgcn_readlane(__builtin_bit_cast(int, x), 31)) + __builtin_bit_cast(float, __builtin_amdgcn_readlane(__builtin_bit_cast(int, x), 63));
}
__device__ __forceinline__ void transpose_item(const float* W, int ldw, bf16* WT, int K, int k0, int n0, int drow0, LAS unsigned char* scr, int lane, const float* gk = nullptr) {
    const int kq = lane >> 4, n4 = lane & 15;
    const float* src = W + (size_t)(k0 + 16 * kq) * ldw + n0 + 4 * n4;
    f32x4 v[16];
#pragma unroll
    for (int i = 0; i < 16; ++i) v[i] = __builtin_nontemporal_load((const GAS f32x4*)(src + (size_t)i * ldw));
    if (gk) {
#pragma unroll
        for (int i = 0; i < 16; ++i) v[i] = v[i] * gk[k0 + 16 * kq + i]; }
#pragma unroll
    for (int j = 0; j < 4; ++j) {
        v4u a, b;
        a.x = pk2(v[0][j], v[1][j]); a.y = pk2(v[2][j], v[3][j]); a.z = pk2(v[4][j], v[5][j]); a.w = pk2(v[6][j], v[7][j]);
        b.x = pk2(v[8][j], v[9][j]); b.y = pk2(v[10][j], v[11][j]); b.z = pk2(v[12][j], v[13][j]); b.w = pk2(v[14][j], v[15][j]);
        LAS unsigned char* p = scr + (4 * n4 + j) * 144 + kq * 32;
        *(LAS v4u*)p = a; *(LAS v4u*)(p + 16) = b; }
    LDS_WAIT(); asm volatile("" ::: "memory");
#pragma unroll
    for (int i = 0; i < 8; ++i) { const int n = 8 * i + (lane >> 3), c = lane & 7;
        __builtin_nontemporal_store(*(const LAS v4u*)(scr + n * 144 + c * 16), (GAS v4u*)(WT + (size_t)(drow0 + n) * K + k0 + 8 * c)); }
    LDS_WAIT(); asm volatile("" ::: "memory");
}
__device__ __forceinline__ void transpose_item8(const float* W, int ldw, unsigned char* WT, int K, int k0, int n0, int drow0, float scale, LAS unsigned char* scr, int lane, const float* gk = nullptr) {
    const int kq = lane >> 4, n4 = lane & 15;
    const float* src = W + (size_t)(k0 + 16 * kq) * ldw + n0 + 4 * n4;
    f32x4 v[16];
#pragma unroll
    for (int i = 0; i < 16; ++i) v[i] = __builtin_nontemporal_load((const GAS f32x4*)(src + (size_t)i * ldw)) * (gk ? scale * gk[k0 + 16 * kq + i] : scale);
#pragma unroll
    for (int j = 0; j < 4; ++j) { int w[4];
#pragma unroll
        for (int q = 0; q < 4; ++q) { w[q] = __builtin_amdgcn_cvt_pk_fp8_f32(v[4 * q][j], v[4 * q + 1][j], 0, false); w[q] = __builtin_amdgcn_cvt_pk_fp8_f32(v[4 * q + 2][j], v[4 * q + 3][j], w[q], true); }
        *(LAS v4u*)(scr + (4 * n4 + j) * 80 + kq * 16) = (v4u){(unsigned)w[0], (unsigned)w[1], (unsigned)w[2], (unsigned)w[3]}; }
    LDS_WAIT(); asm volatile("" ::: "memory");
#pragma unroll
    for (int i = 0; i < 4; ++i) { const int idx = lane + 64 * i, n = idx >> 2, c = idx & 3;
        __builtin_nontemporal_store(*(const LAS v4u*)(scr + n * 80 + c * 16), (GAS v4u*)(WT + (size_t)(drow0 + n) * K + k0 + 16 * c)); }
    LDS_WAIT(); asm volatile("" ::: "memory");
}
__device__ __forceinline__ void conv_plain(const float* W, int ldw, int K, int N, bf16* WT, int it, LAS unsigned char* scr, int lane, const float* gk = nullptr) {
    const int nblk = N / 64, kb = it / nblk, nb = it % nblk;
    transpose_item(W, ldw, WT, K, 64 * kb, 64 * nb, 64 * nb, scr, lane, gk);
}
__device__ __forceinline__ void conv_gu(const float* Wg, const float* Wu, int K, int F, bf16* WT, int it, LAS unsigned char* scr, int lane, const float* gk = nullptr) {
    const int nblk = F / 64, per = (K / 64) * nblk, half = it / per, r = it % per, kb = r / nblk, nb = r % nblk, f0 = 64 * nb;
    transpose_item(half ? Wu : Wg, F, WT, K, 64 * kb, f0, (f0 / 128) * 256 + half * 128 + (f0 % 128), scr, lane, gk);
}

__device__ __forceinline__ void xb_rows(const float* Xf, const float* g, bf16* XBo, float* rss, int gw, int NGW, int lane) {
    f32x4 gv[4];
#pragma unroll
    for (int j = 0; j < 4; ++j) gv[j] = *((const GAS f32x4*)g + lane + 64 * j);
    for (int m = gw; m < MT; m += NGW) {
        const GAS f32x4* xr = (const GAS f32x4*)(Xf + (size_t)m * DM) + lane;
        f32x4 v[4]; float s = 0.f;
#pragma unroll
        for (int j = 0; j < 4; ++j) { v[j] = xr[64 * j]; s += (v[j].x * v[j].x + v[j].y * v[j].y) + (v[j].z * v[j].z + v[j].w * v[j].w); }
        s = wave_sum(s);
        GAS unsigned long long* o8 = (GAS unsigned long long*)(XBo + (size_t)m * DM) + lane;
#pragma unroll
        for (int j = 0; j < 4; ++j) o8[64 * j] = (unsigned long long)pk2(v[j].x, v[j].y) | ((unsigned long long)pk2(v[j].z, v[j].w) << 32);
        if (lane < 16) rss[(size_t)m * 16 + lane] = lane ? 0.f : s;
    }
}
__device__ __forceinline__ void route_rows(const bf16* XBi, const float* gain, const float* rss, const LAS float* tab, LAS int* lcnt, int* toke, int* tokr, int* rtokv, float* rgv, float* rsv, gu32* ecnt, int gw, int NGW, int lane, int tid) {
    const f32x4 ga0 = *(const GAS f32x4*)(gain + 8 * lane), ga1 = *(const GAS f32x4*)(gain + 8 * lane + 4), gb0 = *(const GAS f32x4*)(gain + 512 + 8 * lane), gb1 = *(const GAS f32x4*)(gain + 512 + 8 * lane + 4);
    f32x4 rt[8][4];
#pragma unroll
    for (int q = 0; q < 8; ++q) { const LAS float* t = tab + q * 1024 + 8 * lane; rt[q][0] = *(const LAS f32x4*)t; rt[q][1] = *(const LAS f32x4*)(t + 4); rt[q][2] = *(const LAS f32x4*)(t + 512); rt[q][3] = *(const LAS f32x4*)(t + 516); }
    for (int m0 = 0; m0 < MT; m0 += 8 * NGW) {
        if (tid < 16) lcnt[tid] = 0;
        LDS_WAIT(); __syncthreads();
        int ee[8], ll[8]; float gg[8], rr[8];
#pragma unroll
        for (int r = 0; r < 8; ++r) { const int m = m0 + r * NGW + gw; ee[r] = -1; ll[r] = 0; gg[r] = 0.f; rr[r] = 0.f;
            if (m < MT) {
        const v4u u0 = *(const GAS v4u*)(XBi + (size_t)m * DM + 8 * lane), u1 = *(const GAS v4u*)(XBi + (size_t)m * DM + 512 + 8 * lane);
        const float h0[8] = {bfbits2f(u0.x & 0xffffu) * ga0.x, bfbits2f(u0.x >> 16) * ga0.y, bfbits2f(u0.y & 0xffffu) * ga0.z, bfbits2f(u0.y >> 16) * ga0.w, bfbits2f(u0.z & 0xffffu) * ga1.x, bfbits2f(u0.z >> 16) * ga1.y, bfbits2f(u0.w & 0xffffu) * ga1.z, bfbits2f(u0.w >> 16) * ga1.w};
        const float h1[8] = {bfbits2f(u1.x & 0xffffu) * gb0.x, bfbits2f(u1.x >> 16) * gb0.y, bfbits2f(u1.y & 0xffffu) * gb0.z, bfbits2f(u1.y >> 16) * gb0.w, bfbits2f(u1.z & 0xffffu) * gb1.x, bfbits2f(u1.z >> 16) * gb1.y, bfbits2f(u1.w & 0xffffu) * gb1.z, bfbits2f(u1.w >> 16) * gb1.w};
        float d[8];
#pragma unroll
        for (int q = 0; q < 8; ++q) { const f32x4 a0 = rt[q][0], a1 = rt[q][1], b0 = rt[q][2], b1 = rt[q][3];
            d[q] = ((h0[0] * a0.x + h0[1] * a0.y) + (h0[2] * a0.z + h0[3] * a0.w)) + ((h0[4] * a1.x + h0[5] * a1.y) + (h0[6] * a1.z + h0[7] * a1.w))
                 + ((h1[0] * b0.x + h1[1] * b0.y) + (h1[2] * b0.z + h1[3] * b0.w)) + ((h1[4] * b1.x + h1[5] * b1.y) + (h1[6] * b1.z + h1[7] * b1.w)); }
#pragma unroll
        for (int q = 0; q < 8; ++q) d[q] = wave_sum(d[q]);
        if (lane == 0) {
            const float rstd = pg8::rstd_of(rss, m);
            int e1 = 0; float v1 = d[0];
#pragma unroll
            for (int q = 1; q < 8; ++q) if (d[q] > v1) { v1 = d[q]; e1 = q; }
            int e2 = -1; float v2 = -3.0e38f;
#pragma unroll
            for (int q = 0; q < 8; ++q) if (q != e1 && d[q] > v2) { v2 = d[q]; e2 = q; }
            const int l1 = __hip_atomic_fetch_add(lcnt + e1, 1, __ATOMIC_RELAXED, __HIP_MEMORY_SCOPE_WORKGROUP), l2 = __hip_atomic_fetch_add(lcnt + e2, 1, __ATOMIC_RELAXED, __HIP_MEMORY_SCOPE_WORKGROUP);
            ee[r] = e1 | (e2 << 4); ll[r] = l1 | (l2 << 16); gg[r] = 1.f / (1.f + expf((v2 - v1) * rstd)); rr[r] = rstd;
        } } }
        LDS_WAIT(); __syncthreads();
        if (tid < 8) lcnt[8 + tid] = (int)__hip_atomic_fetch_add(ecnt + 64 * tid, (unsigned)lcnt[tid], RLX_AGENT);
        LDS_WAIT(); __syncthreads();
        if (lane == 0) {
#pragma unroll
            for (int r = 0; r < 8; ++r) if (ee[r] >= 0) { const int m = m0 + r * NGW + gw, e1 = ee[r] & 15, e2 = ee[r] >> 4, r1 = lcnt[8 + e1] + (ll[r] & 0xffff), r2 = lcnt[8 + e2] + (ll[r] >> 16);
                const float g1 = gg[r], g2 = 1.f - g1, rstd = rr[r];
                toke[2 * m] = e1; toke[2 * m + 1] = e2; tokr[2 * m] = r1; tokr[2 * m + 1] = r2;
                rtokv[e1 * 16384 + r1] = m; rtokv[e2 * 16384 + r2] = m; rgv[e1 * 16384 + r1] = g1; rgv[e2 * 16384 + r2] = g2; rsv[e1 * 16384 + r1] = rstd; rsv[e2 * 16384 + r2] = rstd; } }
        LDS_WAIT(); __syncthreads();
    }
}
__device__ __forceinline__ void load_tab8(const float* W, int ldw, LAS float* tab, int tid) {
    for (int i = tid; i < 8192; i += NWAVES * 64) { const int k = i >> 3, j = i & 7; tab[j * 1024 + k] = W[(size_t)k * ldw + j]; }
    LDS_WAIT(); __syncthreads();
}

namespace sba {
typedef float f32x16 __attribute__((ext_vector_type(16)));
typedef short v4i16_t __attribute__((ext_vector_type(4)));
__device__ __forceinline__ v4i16_t vtr(const LAS char* p) { return __builtin_amdgcn_ds_read_tr16_b64_v4i16((LAS v4i16_t*)p); }
typedef float f32x2_t __attribute__((ext_vector_type(2))); typedef __bf16 bf16x2_t __attribute__((ext_vector_type(2)));
__device__ __forceinline__ unsigned cvtpk(float lo, float hi) { f32x2_t v = {lo, hi}; bf16x2_t b = __builtin_convertvector(v, bf16x2_t); return __builtin_bit_cast(unsigned, b); }
__device__ __forceinline__ float hsum32(float v) { auto rr = __builtin_amdgcn_permlane32_swap(__float_as_uint(v), __float_as_uint(v), false, false); return __uint_as_float(rr[0]) + __uint_as_float(rr[1]); }
constexpr int ATT_LDS = 131072 + 4096;
constexpr float RSTOP = 104.f * 1.4426950408889634f;
__device__ __forceinline__ void glds16(const void* gsrc, unsigned lds_dst) { unsigned keep;
    asm volatile("s_mov_b32 %0, m0\n\ts_mov_b32 m0, %2\n\ts_nop 0\n\tglobal_load_lds_dwordx4 %1, off\n\ts_mov_b32 m0, %0" : "=&s"(keep) : "v"(gsrc), "s"(lds_dst) : "memory"); }

__device__ __forceinline__ void attn_unit(const int b, const int qt2, const bf16* __restrict__ P, const float* __restrict__ gattn, bf16* __restrict__ AOo, LAS unsigned char* lds, const int wave, const int lane, const int parity) {
    const int h = wave, r32 = lane & 31, hi = lane >> 5;
    LAS char* vl = (LAS char*)lds + wave * 16384;
    LAS float* red = (LAS float*)(lds + 131072) + parity * 512;
    const size_t row0 = (size_t)b * SEQ;
    bf16x8 qa[4], qb[4];
#pragma unroll
    for (int ks = 0; ks < 4; ++ks) { qa[ks] = *(const bf16x8*)(P + (row0 + 64 * qt2 + r32) * NPROJ + OQ + h * 64 + 16 * ks + 8 * hi); qb[ks] = *(const bf16x8*)(P + (row0 + 64 * qt2 + 32 + r32) * NPROJ + OQ + h * 64 + 16 * ks + 8 * hi); }
    f32x16 oa0, oa1, ob0, ob1;
#pragma unroll
    for (int r = 0; r < 16; ++r) { oa0[r] = 0.f; oa1[r] = 0.f; ob0[r] = 0.f; ob1[r] = 0.f; }
    float Ra = 1.f, Rb = 1.f;
    const int grp = lane >> 4, i16 = lane & 15;
    const LAS char* vrd = vl + 4096 + (4 * (grp >> 1) + (i16 >> 2)) * 128 + (16 * (grp & 1) + 4 * (i16 & 3)) * 2;
    const LAS char* krd = vl + r32 * 128;
    const unsigned vdma = (unsigned)__builtin_amdgcn_readfirstlane((int)(unsigned)(uintptr_t)vl);
    const bf16* ksrc = P + (row0 + (lane >> 3)) * NPROJ + OK_ + h * 64 + (((lane & 7) ^ ((lane >> 3) & 7)) * 8);
    const bf16* vsrc = P + (row0 + (lane >> 3)) * NPROJ + OV + h * 64 + (lane & 7) * 8;
#define SBA_ISSUE(SLOT, kt_) do { const size_t ko_ = (size_t)(kt_) * 32 * NPROJ; \
        _Pragma("unroll") for (int i = 0; i < 4; ++i) glds16(ksrc + ko_ + (size_t)(8 * i) * NPROJ, vdma + (SLOT) * 8192 + i * 1024); \
        _Pragma("unroll") for (int i = 0; i < 4; ++i) glds16(vsrc + ko_ + (size_t)(8 * i) * NPROJ, vdma + (SLOT) * 8192 + 4096 + i * 1024); } while (0)
#define SBA_BLOCK(QR, O0, O1, R, DIAG) do { \
        f32x16 p; \
        _Pragma("unroll") for (int r = 0; r < 16; ++r) p[r] = 0.f; \
        _Pragma("unroll") for (int ks = 0; ks < 4; ++ks) p = __builtin_amdgcn_mfma_f32_32x32x16_bf16(kf[ks], QR[ks], p, 0, 0, 0); \
        if (DIAG) { _Pragma("unroll") for (int r = 0; r < 16; ++r) { const int kl = (r & 3) + 8 * (r >> 2) + 4 * hi; if (kl >= r32) p[r] = -1.0e30f; } } \
        float sg[16], qn[16], G[4], PG[4];                       \
        _Pragma("unroll") for (int r = 0; r < 16; ++r) { const float e = __builtin_amdgcn_exp2f(fminf(p[r], 126.f)); const float qq = __builtin_amdgcn_rcpf(1.f + e); qn[r] = qq; sg[r] = e * qq; } \
        _Pragma("unroll") for (int g = 0; g < 4; ++g) { G[g] = (qn[4 * g] * qn[4 * g + 1]) * (qn[4 * g + 2] * qn[4 * g + 3]); \
            auto rr_ = __builtin_amdgcn_permlane32_swap(__float_as_uint(G[g]), __float_as_uint(G[g]), false, false); PG[g] = __uint_as_float(hi ? rr_[0] : rr_[1]); }     \
        float base[4]; \
        { float acc = R; \
          _Pragma("unroll") for (int g = 3; g >= 0; --g) { base[g] = hi == 0 ? acc * PG[g] : acc; acc *= G[g] * PG[g]; } \
          R = acc; } \
        float w[16]; \
        _Pragma("unroll") for (int g = 0; g < 4; ++g) { float lat = base[g]; \
            _Pragma("unroll") for (int i = 3; i >= 0; --i) { const int r = 4 * g + i; w[r] = sg[r] * lat; lat *= qn[r]; } } \
        v4u pb0, pb1; \
        pb0.x = cvtpk(w[0], w[1]); pb0.y = cvtpk(w[2], w[3]); pb0.z = cvtpk(w[4], w[5]); pb0.w = cvtpk(w[6], w[7]); \
        pb1.x = cvtpk(w[8], w[9]); pb1.y = cvtpk(w[10], w[11]); pb1.z = cvtpk(w[12], w[13]); pb1.w = cvtpk(w[14], w[15]); \
        const bf16x8 b0 = __builtin_bit_cast(bf16x8, pb0), b1 = __builtin_bit_cast(bf16x8, pb1); \
        O0 = __builtin_amdgcn_mfma_f32_32x32x16_bf16(vf00, b0, O0, 0, 0, 0); O0 = __builtin_amdgcn_mfma_f32_32x32x16_bf16(vf01, b1, O0, 0, 0, 0); \
        O1 = __builtin_amdgcn_mfma_f32_32x32x16_bf16(vf10, b0, O1, 0, 0, 0); O1 = __builtin_amdgcn_mfma_f32_32x32x16_bf16(vf11, b1, O1, 0, 0, 0); \
    } while (0)
#define SBA_TILE(SLOT, kt_) do { \
        if ((kt_) >= 1) asm volatile("s_waitcnt vmcnt(8)" ::: "memory"); else asm volatile("s_waitcnt vmcnt(0)" ::: "memory");     \
        bf16x8 kf[4]; \
        _Pragma("unroll") for (int ks = 0; ks < 4; ++ks) kf[ks] = *(const LAS bf16x8*)(krd + (SLOT) * 8192 + (((2 * ks + hi) ^ (r32 & 7)) * 16)); \
        const LAS char* vr_ = vrd + (SLOT) * 8192; \
        const v4i16_t a00 = vtr(vr_), a01 = vtr(vr_ + 8 * 128), a02 = vtr(vr_ + 16 * 128), a03 = vtr(vr_ + 24 * 128); \
        const v4i16_t a10 = vtr(vr_ + 64), a11 = vtr(vr_ + 8 * 128 + 64), a12 = vtr(vr_ + 16 * 128 + 64), a13 = vtr(vr_ + 24 * 128 + 64); \
        asm volatile("s_waitcnt lgkmcnt(0)" ::: "memory");      \
        if ((kt_) >= 2) SBA_ISSUE(SLOT, (kt_) - 2); \
        const bf16x8 vf00 = {a00[0], a00[1], a00[2], a00[3], a01[0], a01[1], a01[2], a01[3]}, vf01 = {a02[0], a02[1], a02[2], a02[3], a03[0], a03[1], a03[2], a03[3]}; \
        const bf16x8 vf10 = {a10[0], a10[1], a10[2], a10[3], a11[0], a11[1], a11[2], a11[3]}, vf11 = {a12[0], a12[1], a12[2], a12[3], a13[0], a13[1], a13[2], a13[3]}; \
        if (!doneB) { SBA_BLOCK(qb, ob0, ob1, Rb, (kt_) == 2 * qt2 + 1); doneB = __all(Rb == 0.f); } \
        if ((kt_) <= 2 * qt2 && !doneA) { SBA_BLOCK(qa, oa0, oa1, Ra, (kt_) == 2 * qt2); doneA = __all(Ra == 0.f); } \
    } while (0)
    SBA_ISSUE(0, 2 * qt2 + 1); SBA_ISSUE(1, 2 * qt2);
    asm volatile("" : "+v"(qa[0]), "+v"(qa[1]), "+v"(qa[2]), "+v"(qa[3]), "+v"(qb[0]), "+v"(qb[1]), "+v"(qb[2]), "+v"(qb[3]));
    bool doneA = false, doneB = false;
    for (int kt = 2 * qt2 + 1;;) {
        SBA_TILE(0, kt); if (kt == 0 || (doneA && doneB)) break; --kt;
        SBA_TILE(1, kt); if (kt == 0 || (doneA && doneB)) break; --kt;
    }
    asm volatile("s_waitcnt vmcnt(0)" ::: "memory");
#undef SBA_TILE
#undef SBA_BLOCK
#undef SBA_ISSUE
    float ssa = 0.f, ssb = 0.f;
#pragma unroll
    for (int r = 0; r < 16; ++r) { ssa += oa0[r] * oa0[r] + oa1[r] * oa1[r]; ssb += ob0[r] * ob0[r] + ob1[r] * ob1[r]; }
    ssa = hsum32(ssa); ssb = hsum32(ssb);
    if (hi == 0) { red[h * 64 + r32] = ssa; red[h * 64 + 32 + r32] = ssb; }
    LDS_WAIT(); __syncthreads();
    float ta = 0.f, tb = 0.f;
#pragma unroll
    for (int j = 0; j < 8; ++j) { ta += red[j * 64 + r32]; tb += red[j * 64 + 32 + r32]; }
    const float rsa = 1.f / sqrtf(ta * (1.f / 512.f) + EPS), rsb = 1.f / sqrtf(tb * (1.f / 512.f) + EPS);
#pragma unroll
    for (int db = 0; db < 2; ++db)
#pragma unroll
        for (int g = 0; g < 4; ++g) { const int d = 32 * db + 8 * g + 4 * hi; const f32x4 gv = *(const f32x4*)(gattn + h * 64 + d);
            const f32x16& xa = db ? oa1 : oa0; const f32x16& xb = db ? ob1 : ob0;
            const unsigned la = cvtpk(xa[4 * g] * rsa * gv.x, xa[4 * g + 1] * rsa * gv.y), ha = cvtpk(xa[4 * g + 2] * rsa * gv.z, xa[4 * g + 3] * rsa * gv.w);
            const unsigned lb = cvtpk(xb[4 * g] * rsb * gv.x, xb[4 * g + 1] * rsb * gv.y), hb = cvtpk(xb[4 * g + 2] * rsb * gv.z, xb[4 * g + 3] * rsb * gv.w);
            *(LAS unsigned long long*)(vl + r32 * 128 + d * 2) = (unsigned long long)la | ((unsigned long long)ha << 32);
            *(LAS unsigned long long*)(vl + (32 + r32) * 128 + d * 2) = (unsigned long long)lb | ((unsigned long long)hb << 32); }
    LDS_WAIT();
#pragma unroll
    for (int i = 0; i < 8; ++i) { const int row = (lane >> 3) + 8 * i; const v4u v = *(const LAS v4u*)(vl + row * 128 + (lane & 7) * 16);
        *(v4u*)(AOo + (row0 + 64 * qt2 + row) * 1024 + h * 64 + (lane & 7) * 8) = v; }
    LDS_WAIT();
}
}
namespace ssd {
typedef float f32x16 __attribute__((ext_vector_type(16)));
typedef short v4i16_t __attribute__((ext_vector_type(4)));
constexpr int RS = 272, XRS = 528;
constexpr int OFF_B = 0, OFF_C = 128 * RS, OFF_X = 2 * 128 * RS, OFF_TAB = OFF_X + 128 * XRS, OFF_T = OFF_C;
constexpr int TAB_HEAD = 2048, TAB_ACUM = 0, TAB_DT = 512, TAB_CF = 1024, TAB_DECS = 1536;
constexpr int OFF_DTP = OFF_TAB + 4 * TAB_HEAD;
constexpr int LDS_NEED = OFF_DTP + 8192;
constexpr float LOG2E = 1.4426950408889634f;
__device__ __forceinline__ v4i16_t vtr(const LAS char* p) { return __builtin_amdgcn_ds_read_tr16_b64_v4i16((LAS v4i16_t*)p); }
typedef float f32x2_t __attribute__((ext_vector_type(2))); typedef __bf16 bf16x2_t __attribute__((ext_vector_type(2)));
__device__ __forceinline__ unsigned cvtpk(float lo, float hi) { f32x2_t v = {lo, hi}; bf16x2_t b = __builtin_convertvector(v, bf16x2_t); return __builtin_bit_cast(unsigned, b); }
__device__ __forceinline__ float bflo(unsigned u) { return __builtin_bit_cast(float, u << 16); }
__device__ __forceinline__ float bfhi(unsigned u) { return __builtin_bit_cast(float, u & 0xffff0000u); }
__device__ __forceinline__ float ex(float x) { return __builtin_amdgcn_exp2f(LOG2E * x); }
__device__ __forceinline__ int crow(int r, int hi) { return (r & 3) + 8 * (r >> 2) + 4 * hi; }

struct ATensors { const bf16* PROJ; const float* cw; const float* cb; const float* dtraw; const float* dtbias; const float* alog; const float* dskip;
                  bf16* YD; bf16* ST; bf16* CC; float* ACUM; };

__device__ __forceinline__ void phaseA_unit(const int b, const int c, const int g, const ATensors& T, LAS unsigned char* lds, const int wave, const int lane) {
    const int r32 = lane & 31, hi = lane >> 5, grp = lane >> 4, i16 = lane & 15;
    const int tok0 = b * SEQ + c * 128;
    LAS char* L = (LAS char*)lds;
    if (wave < 4) {
        const int h = g * 4 + wave; const float a = -expf(T.alog[h]), bias = T.dtbias[h];
        LAS float* tab = (LAS float*)(L + OFF_TAB + wave * TAB_HEAD);
        const int l0 = 2 * lane;
        float z0 = T.dtraw[(size_t)(tok0 + l0) * 8 + h] + bias, z1 = T.dtraw[(size_t)(tok0 + l0 + 1) * 8 + h] + bias;
        const float d0 = (z0 > 20.f) ? z0 : log1pf(expf(z0)), d1 = (z1 > 20.f) ? z1 : log1pf(expf(z1));
        const float a0 = d0 * a, a1 = d1 * a, ps = a0 + a1;
        float inc = ps;
#pragma unroll
        for (int o = 1; o < 64; o <<= 1) { const float t = __shfl_up(inc, o); if (lane >= o) inc += t; }
        const float exc = inc - ps, c0 = exc + a0, c1 = exc + ps;
        const float alast = __shfl(inc, 63);
        tab[TAB_ACUM / 4 + l0] = c0; tab[TAB_ACUM / 4 + l0 + 1] = c1; tab[TAB_DT / 4 + l0] = d0; tab[TAB_DT / 4 + l0 + 1] = d1;
        LDS_WAIT();
        const float eb = tab[TAB_ACUM / 4 + (l0 | 31)];
        tab[TAB_CF / 4 + l0] = ex(eb - c0) * d0; tab[TAB_CF / 4 + l0 + 1] = ex(eb - c1) * d1;
        tab[TAB_DECS / 4 + l0] = ex(alast - c0) * d0; tab[TAB_DECS / 4 + l0 + 1] = ex(alast - c1) * d1;
        T.ACUM[(size_t)(tok0 + l0) * 8 + h] = c0; T.ACUM[(size_t)(tok0 + l0 + 1) * 8 + h] = c1;
    }
    {
        const int scol = (lane < 32) ? (g * 256 + lane * 8) : (lane < 48) ? (512 + g * 128 + (lane - 32) * 8) : (768 + g * 128 + (lane - 48) * 8);
        float wt[4][8], bs[8];
#pragma unroll
        for (int k = 0; k < 4; ++k) { const f32x4 w0 = *(const f32x4*)(T.cw + k * 1024 + scol), w1 = *(const f32x4*)(T.cw + k * 1024 + scol + 4);
            wt[k][0] = w0.x; wt[k][1] = w0.y; wt[k][2] = w0.z; wt[k][3] = w0.w; wt[k][4] = w1.x; wt[k][5] = w1.y; wt[k][6] = w1.z; wt[k][7] = w1.w; }
        { const f32x4 b0 = *(const f32x4*)(T.cb + scol), b1 = *(const f32x4*)(T.cb + scol + 4); bs[0] = b0.x; bs[1] = b0.y; bs[2] = b0.z; bs[3] = b0.w; bs[4] = b1.x; bs[5] = b1.y; bs[6] = b1.z; bs[7] = b1.w; }
        const bf16* src = T.PROJ + (size_t)(tok0 + 16 * wave) * NPROJ + OXBC + scol;
        const bool first = (c == 0) && (wave == 0);
        v4u raw[19];
#pragma unroll
        for (int j = 0; j < 19; ++j) { const v4u zz = {0u, 0u, 0u, 0u}; raw[j] = (first && j < 3) ? zz : *(const v4u*)(src + (long)(j - 3) * NPROJ); }
        LAS char* dst = (lane < 32) ? (L + OFF_X + lane * 16) : (lane < 48) ? (L + OFF_B + (lane - 32) * 16) : (L + OFF_C + (lane - 48) * 16);
        const int drs = (lane < 32) ? XRS : RS;
#pragma unroll
        for (int j = 0; j < 16; ++j) {
            float o[8];
#pragma unroll
            for (int i = 0; i < 8; ++i) o[i] = bs[i];
#pragma unroll
            for (int k = 0; k < 4; ++k) { const v4u rv = raw[j + k];
                o[0] += wt[k][0] * bflo(rv.x); o[1] += wt[k][1] * bfhi(rv.x); o[2] += wt[k][2] * bflo(rv.y); o[3] += wt[k][3] * bfhi(rv.y);
                o[4] += wt[k][4] * bflo(rv.z); o[5] += wt[k][5] * bfhi(rv.z); o[6] += wt[k][6] * bflo(rv.w); o[7] += wt[k][7] * bfhi(rv.w); }
#pragma unroll
            for (int i = 0; i < 8; ++i) o[i] = o[i] * __builtin_amdgcn_rcpf(1.f + __builtin_amdgcn_exp2f(-LOG2E * o[i]));
            v4u pk; pk.x = cvtpk(o[0], o[1]); pk.y = cvtpk(o[2], o[3]); pk.z = cvtpk(o[4], o[5]); pk.w = cvtpk(o[6], o[7]);
            const int l = 16 * wave + j;
            *(LAS v4u*)(dst + l * drs) = pk;
            if (lane >= 48) *(v4u*)(T.CC + (size_t)(tok0 + l) * 256 + g * 128 + (lane - 48) * 8) = pk;
        }
    }
    LDS_WAIT(); __syncthreads();
    f32x16 t0, t1;
#pragma unroll
    for (int r = 0; r < 16; ++r) { t0[r] = 0.f; t1[r] = 0.f; }
    {
        const int ti = wave, lb = (ti >= 6) ? 3 : (ti >= 3) ? 2 : (ti >= 1) ? 1 : 0, sb = ti - lb * (lb + 1) / 2;
        const LAS char* ap = L + OFF_B + (32 * sb + r32) * RS + 16 * hi; const LAS char* bp = L + OFF_C + (32 * lb + r32) * RS + 16 * hi;
#pragma unroll
        for (int ks = 0; ks < 8; ++ks) t0 = __builtin_amdgcn_mfma_f32_32x32x16_bf16(*(const LAS bf16x8*)(ap + 32 * ks), *(const LAS bf16x8*)(bp + 32 * ks), t0, 0, 0, 0);
        if (wave < 2) { const int sb2 = 2 + wave;
            const LAS char* ap2 = L + OFF_B + (32 * sb2 + r32) * RS + 16 * hi; const LAS char* bp2 = L + OFF_C + (96 + r32) * RS + 16 * hi;
#pragma unroll
            for (int ks = 0; ks < 8; ++ks) t1 = __builtin_amdgcn_mfma_f32_32x32x16_bf16(*(const LAS bf16x8*)(ap2 + 32 * ks), *(const LAS bf16x8*)(bp2 + 32 * ks), t1, 0, 0, 0); }
    }
    LDS_WAIT(); __syncthreads();
    {
        LAS char* tp = L + OFF_T + wave * 2048 + lane * 32;
        v4u w0, w1; w0.x = cvtpk(t0[0], t0[1]); w0.y = cvtpk(t0[2], t0[3]); w0.z = cvtpk(t0[4], t0[5]); w0.w = cvtpk(t0[6], t0[7]);
        w1.x = cvtpk(t0[8], t0[9]); w1.y = cvtpk(t0[10], t0[11]); w1.z = cvtpk(t0[12], t0[13]); w1.w = cvtpk(t0[14], t0[15]);
        *(LAS v4u*)tp = w0; *(LAS v4u*)(tp + 16) = w1;
        if (wave < 2) { LAS char* tp2 = L + OFF_T + (8 + wave) * 2048 + lane * 32;
            w0.x = cvtpk(t1[0], t1[1]); w0.y = cvtpk(t1[2], t1[3]); w0.z = cvtpk(t1[4], t1[5]); w0.w = cvtpk(t1[6], t1[7]);
            w1.x = cvtpk(t1[8], t1[9]); w1.y = cvtpk(t1[10], t1[11]); w1.z = cvtpk(t1[12], t1[13]); w1.w = cvtpk(t1[14], t1[15]);
            *(LAS v4u*)tp2 = w0; *(LAS v4u*)(tp2 + 16) = w1; }
    }
    LDS_WAIT(); __syncthreads();
    const int hl = wave >> 1, ph = wave & 1, h = g * 4 + hl;
    const LAS float* tab = (const LAS float*)(L + OFF_TAB + hl * TAB_HEAD);
    const float Dh = T.dskip[h];
    bf16x8 xf[8];
    {
        const LAS char* xp = L + OFF_X + (4 * (grp >> 1) + (i16 >> 2)) * XRS + (hl * 64 + 32 * ph + 16 * (grp & 1) + 4 * (i16 & 3)) * 2;
#pragma unroll
        for (int ks = 0; ks < 8; ++ks) { const v4i16_t a0 = vtr(xp + (16 * ks) * XRS), a1 = vtr(xp + (16 * ks + 8) * XRS);
            xf[ks] = (bf16x8){a0[0], a0[1], a0[2], a0[3], a1[0], a1[1], a1[2], a1[3]}; }
    }
#pragma unroll
    for (int lb = 0; lb < 4; ++lb) {
        f32x16 y;
#pragma unroll
        for (int r = 0; r < 16; ++r) y[r] = 0.f;
        const float acl = tab[TAB_ACUM / 4 + 32 * lb + r32];
#pragma unroll
        for (int sb = 0; sb <= lb; ++sb) {
            const LAS char* tp = L + OFF_T + (lb * (lb + 1) / 2 + sb) * 2048 + lane * 32;
            const v4u q0 = *(const LAS v4u*)tp, q1 = *(const LAS v4u*)(tp + 16);
            float tv[16] = {bflo(q0.x), bfhi(q0.x), bflo(q0.y), bfhi(q0.y), bflo(q0.z), bfhi(q0.z), bflo(q0.w), bfhi(q0.w),
                            bflo(q1.x), bfhi(q1.x), bflo(q1.y), bfhi(q1.y), bflo(q1.z), bfhi(q1.z), bflo(q1.w), bfhi(q1.w)};
            float m[16];
            if (sb < lb) {
                const float rowf = ex(acl - tab[TAB_ACUM / 4 + 32 * sb + 31]);
#pragma unroll
                for (int q = 0; q < 4; ++q) { const f32x4 cf = *(const LAS f32x4*)(tab + TAB_CF / 4 + 32 * sb + 8 * q + 4 * hi);
                    m[4 * q] = tv[4 * q] * (rowf * cf.x); m[4 * q + 1] = tv[4 * q + 1] * (rowf * cf.y); m[4 * q + 2] = tv[4 * q + 2] * (rowf * cf.z); m[4 * q + 3] = tv[4 * q + 3] * (rowf * cf.w); }
            } else {
#pragma unroll
                for (int q = 0; q < 4; ++q) { const f32x4 as = *(const LAS f32x4*)(tab + TAB_ACUM / 4 + 32 * sb + 8 * q + 4 * hi), ds = *(const LAS f32x4*)(tab + TAB_DT / 4 + 32 * sb + 8 * q + 4 * hi);
                    const float asv[4] = {as.x, as.y, as.z, as.w}, dsv[4] = {ds.x, ds.y, ds.z, ds.w};
#pragma unroll
                    for (int i = 0; i < 4; ++i) { const int sl = 8 * q + 4 * hi + i;
                        const float f = (sl <= r32) ? ex(acl - asv[i]) * dsv[i] : 0.f;
                        m[4 * q + i] = tv[4 * q + i] * f + ((sl == r32) ? Dh : 0.f); } }
            }
            v4u p0, p1; p0.x = cvtpk(m[0], m[1]); p0.y = cvtpk(m[2], m[3]); p0.z = cvtpk(m[4], m[5]); p0.w = cvtpk(m[6], m[7]);
            p1.x = cvtpk(m[8], m[9]); p1.y = cvtpk(m[10], m[11]); p1.z = cvtpk(m[12], m[13]); p1.w = cvtpk(m[14], m[15]);
            y = __builtin_amdgcn_mfma_f32_32x32x16_bf16(__builtin_bit_cast(bf16x8, p0), xf[2 * sb], y, 0, 0, 0);
            y = __builtin_amdgcn_mfma_f32_32x32x16_bf16(__builtin_bit_cast(bf16x8, p1), xf[2 * sb + 1], y, 0, 0, 0);
        }
        v4u* yp = (v4u*)T.YD + ((size_t)((((b * 16 + c) * 2 + g) * 8 + wave) * 4 + lb) * 2) * 64 + lane;
#pragma unroll
        for (int rh = 0; rh < 2; ++rh) yp[rh * 64] = (v4u){cvtpk(y[8 * rh], y[8 * rh + 1]), cvtpk(y[8 * rh + 2], y[8 * rh + 3]), cvtpk(y[8 * rh + 4], y[8 * rh + 5]), cvtpk(y[8 * rh + 6], y[8 * rh + 7])};
    }
    {
        f32x16 xs[4];
#pragma unroll
        for (int nb = 0; nb < 4; ++nb)
#pragma unroll
            for (int r = 0; r < 16; ++r) xs[nb][r] = 0.f;
        const LAS char* bp = L + OFF_B + (4 * (grp >> 1) + (i16 >> 2)) * RS + (16 * (grp & 1) + 4 * (i16 & 3)) * 2;
#pragma unroll
        for (int ks = 0; ks < 8; ++ks) {
            const f32x4 e0 = *(const LAS f32x4*)(tab + TAB_DECS / 4 + 16 * ks + 4 * hi), e1 = *(const LAS f32x4*)(tab + TAB_DECS / 4 + 16 * ks + 8 + 4 * hi);
            const v4u xu = __builtin_bit_cast(v4u, xf[ks]);
            v4u su; su.x = cvtpk(bflo(xu.x) * e0.x, bfhi(xu.x) * e0.y); su.y = cvtpk(bflo(xu.y) * e0.z, bfhi(xu.y) * e0.w);
            su.z = cvtpk(bflo(xu.z) * e1.x, bfhi(xu.z) * e1.y); su.w = cvtpk(bflo(xu.w) * e1.z, bfhi(xu.w) * e1.w);
            const bf16x8 sx = __builtin_bit_cast(bf16x8, su);
#pragma unroll
            for (int nb = 0; nb < 4; ++nb) { const v4i16_t a0 = vtr(bp + (16 * ks) * RS + nb * 64), a1 = vtr(bp + (16 * ks + 8) * RS + nb * 64);
                xs[nb] = __builtin_amdgcn_mfma_f32_32x32x16_bf16((bf16x8){a0[0], a0[1], a0[2], a0[3], a1[0], a1[1], a1[2], a1[3]}, sx, xs[nb], 0, 0, 0); }
        }
        v4u* sp = (v4u*)T.ST + (size_t)((b * 16 + c) * 8 + h) * 1024 + (size_t)(ph * 8) * 64 + lane;
#pragma unroll
        for (int nb = 0; nb < 4; ++nb)
#pragma unroll
            for (int rh = 0; rh < 2; ++rh) sp[(nb * 2 + rh) * 64] = (v4u){cvtpk(xs[nb][8 * rh], xs[nb][8 * rh + 1]), cvtpk(xs[nb][8 * rh + 2], xs[nb][8 * rh + 3]), cvtpk(xs[nb][8 * rh + 4], xs[nb][8 * rh + 5]), cvtpk(xs[nb][8 * rh + 6], xs[nb][8 * rh + 7])};
    }
    LDS_WAIT(); __syncthreads();
}

__device__ __forceinline__ void scan_states(const bf16* ST, bf16* SF, const float* ACUM, const int gtid, const int nthr) {
    for (int e = gtid; e < BATCH * 8 * 1024; e += nthr) {
        const int bh = e >> 10, b = bh >> 3, h = bh & 7, q = e & 1023;
        float S[8];
#pragma unroll
        for (int j = 0; j < 8; ++j) S[j] = 0.f;
        v4u v[16]; float dc[16];
#pragma unroll
        for (int c = 0; c < 16; ++c) { v[c] = *((const v4u*)ST + (size_t)((b * 16 + c) * 8 + h) * 1024 + q); dc[c] = ACUM[(size_t)(b * SEQ + c * 128 + 127) * 8 + h]; }
#pragma unroll
        for (int c = 0; c < 16; ++c) {
            *((v4u*)SF + (size_t)((b * 16 + c) * 8 + h) * 1024 + q) = (v4u){cvtpk(S[0], S[1]), cvtpk(S[2], S[3]), cvtpk(S[4], S[5]), cvtpk(S[6], S[7])};
            const float d = ex(dc[c]);
            S[0] = S[0] * d + bflo(v[c].x); S[1] = S[1] * d + bfhi(v[c].x); S[2] = S[2] * d + bflo(v[c].y); S[3] = S[3] * d + bfhi(v[c].y);
            S[4] = S[4] * d + bflo(v[c].z); S[5] = S[5] * d + bfhi(v[c].z); S[6] = S[6] * d + bflo(v[c].w); S[7] = S[7] * d + bfhi(v[c].w); }
    }
}

struct BTensors { const bf16* PROJ; const bf16* YD; const bf16* SF; const bf16* CC; const float* ACUM; const float* gssd; bf16* AO; };

__device__ __forceinline__ void phaseB_unit(const int b, const int c, const int g, const BTensors& T, LAS unsigned char* lds, const int wave, const int lane, const int tid) {
    const int r32 = lane & 31, hi = lane >> 5;
    const int tok0 = b * SEQ + c * 128;
    LAS char* L = (LAS char*)lds;
#pragma unroll
    for (int i = 0; i < 4; ++i) { const int ch = tid + 512 * i, row = ch >> 4, cc = ch & 15;
        *(LAS v4u*)(L + OFF_C + row * RS + cc * 16) = *(const v4u*)(T.CC + (size_t)(tok0 + row) * 256 + g * 128 + cc * 8); }
    { const int hl = tid >> 7, l = tid & 127; ((LAS float*)(L + OFF_TAB))[hl * 128 + l] = ex(T.ACUM[(size_t)(tok0 + l) * 8 + g * 4 + hl]); }
    LDS_WAIT(); __syncthreads();
    const int hl = wave >> 1, ph = wave & 1, h = g * 4 + hl;
    bf16x8 sf[8];
    {
        const bf16x8* sp = (const bf16x8*)T.SF + (size_t)((((b * 16 + c) * 8 + h) * 2 + ph) * 8) * 64 + lane;
#pragma unroll
        for (int ks = 0; ks < 8; ++ks) sf[ks] = sp[ks * 64];
    }
    const LAS float* ea = (const LAS float*)(L + OFF_TAB) + hl * 128;
#pragma unroll
    for (int lb = 0; lb < 4; ++lb) {
        f32x16 y;
#pragma unroll
        for (int r = 0; r < 16; ++r) y[r] = 0.f;
        const LAS char* cp = L + OFF_C + (32 * lb + r32) * RS + 8 * hi;
#pragma unroll
        for (int ks = 0; ks < 8; ++ks) { const unsigned long long c0 = *(const LAS unsigned long long*)(cp + 32 * ks), c1 = *(const LAS unsigned long long*)(cp + 32 * ks + 16);
            v4u cu; cu.x = (unsigned)c0; cu.y = (unsigned)(c0 >> 32); cu.z = (unsigned)c1; cu.w = (unsigned)(c1 >> 32);
            y = __builtin_amdgcn_mfma_f32_32x32x16_bf16(__builtin_bit_cast(bf16x8, cu), sf[ks], y, 0, 0, 0); }
        const v4u* ydp = (const v4u*)T.YD + ((size_t)((((b * 16 + c) * 2 + g) * 8 + wave) * 4 + lb) * 2) * 64 + lane;
        LAS bf16* yl = (LAS bf16*)(L + OFF_X + (32 * lb + 4 * hi) * XRS) + hl * 64 + 32 * ph + r32;
#pragma unroll
        for (int rh = 0; rh < 2; ++rh) { const v4u yd = ydp[rh * 64];
            const f32x4 e0 = *(const LAS f32x4*)(ea + 32 * lb + 16 * rh + 4 * hi), e1 = *(const LAS f32x4*)(ea + 32 * lb + 16 * rh + 8 + 4 * hi);
            yl[(16 * rh + 0) * (XRS / 2)] = (bf16)f2bf(y[8 * rh] * e0.x + bflo(yd.x)); yl[(16 * rh + 1) * (XRS / 2)] = (bf16)f2bf(y[8 * rh + 1] * e0.y + bfhi(yd.x));
            yl[(16 * rh + 2) * (XRS / 2)] = (bf16)f2bf(y[8 * rh + 2] * e0.z + bflo(yd.y)); yl[(16 * rh + 3) * (XRS / 2)] = (bf16)f2bf(y[8 * rh + 3] * e0.w + bfhi(yd.y));
            yl[(16 * rh + 8) * (XRS / 2)] = (bf16)f2bf(y[8 * rh + 4] * e1.x + bflo(yd.z)); yl[(16 * rh + 9) * (XRS / 2)] = (bf16)f2bf(y[8 * rh + 5] * e1.y + bfhi(yd.z));
            yl[(16 * rh + 10) * (XRS / 2)] = (bf16)f2bf(y[8 * rh + 6] * e1.z + bflo(yd.w)); yl[(16 * rh + 11) * (XRS / 2)] = (bf16)f2bf(y[8 * rh + 7] * e1.w + bfhi(yd.w)); }
    }
    LDS_WAIT(); __syncthreads();
    {
        const int cl = lane & 15;
        const f32x4 g0 = *(const f32x4*)(T.gssd + g * 256 + cl * 8), g1 = *(const f32x4*)(T.gssd + g * 256 + cl * 8 + 4), g2 = *(const f32x4*)(T.gssd + g * 256 + 128 + cl * 8), g3 = *(const f32x4*)(T.gssd + g * 256 + 128 + cl * 8 + 4);
#pragma unroll
        for (int ps = 0; ps < 4; ++ps) { const int row = 16 * wave + 4 * ps + (lane >> 4);
            const v4u u0 = *(const LAS v4u*)(L + OFF_X + row * XRS + cl * 16), u1 = *(const LAS v4u*)(L + OFF_X + row * XRS + 256 + cl * 16);
            float a[16] = {bflo(u0.x), bfhi(u0.x), bflo(u0.y), bfhi(u0.y), bflo(u0.z), bfhi(u0.z), bflo(u0.w), bfhi(u0.w), bflo(u1.x), bfhi(u1.x), bflo(u1.y), bfhi(u1.y), bflo(u1.z), bfhi(u1.z), bflo(u1.w), bfhi(u1.w)};
            const bf16* zp = T.PROJ + (size_t)(tok0 + row) * NPROJ + OZ + g * 256 + cl * 8;
            const v4u z0 = *(const v4u*)zp, z1 = *(const v4u*)(zp + 128);
            const float zz[16] = {bflo(z0.x), bfhi(z0.x), bflo(z0.y), bfhi(z0.y), bflo(z0.z), bfhi(z0.z), bflo(z0.w), bfhi(z0.w), bflo(z1.x), bfhi(z1.x), bflo(z1.y), bfhi(z1.y), bflo(z1.z), bfhi(z1.z), bflo(z1.w), bfhi(z1.w)};
            float ss = 0.f;
#pragma unroll
            for (int i = 0; i < 16; ++i) { a[i] *= zz[i] * __builtin_amdgcn_rcpf(1.f + __builtin_amdgcn_exp2f(-LOG2E * zz[i])); ss += a[i] * a[i]; }
            ss += __shfl_xor(ss, 1); ss += __shfl_xor(ss, 2); ss += __shfl_xor(ss, 4); ss += __shfl_xor(ss, 8);
            const float rs = 1.f / sqrtf(ss * (1.f / 256.f) + EPS);
            v4u o0, o1; o0.x = cvtpk(a[0] * rs * g0.x, a[1] * rs * g0.y); o0.y = cvtpk(a[2] * rs * g0.z, a[3] * rs * g0.w); o0.z = cvtpk(a[4] * rs * g1.x, a[5] * rs * g1.y); o0.w = cvtpk(a[6] * rs * g1.z, a[7] * rs * g1.w);
            o1.x = cvtpk(a[8] * rs * g2.x, a[9] * rs * g2.y); o1.y = cvtpk(a[10] * rs * g2.z, a[11] * rs * g2.w); o1.z = cvtpk(a[12] * rs * g3.x, a[13] * rs * g3.y); o1.w = cvtpk(a[14] * rs * g3.z, a[15] * rs * g3.w);
            bf16* op = T.AO + (size_t)(tok0 + row) * 1024 + 512 + g * 256 + cl * 8;
            *(v4u*)op = o0; *(v4u*)(op + 128) = o1; }
    }
    LDS_WAIT(); __syncthreads();
}
}

__device__ __forceinline__ void dt_tail(const bf16* XBi, const bf16* WDTl, const float* rss, float* DTR, LAS unsigned char* lds, const int vcu, const int G, const int wave, const int lane, const int tid) {
    typedef float f32x16 __attribute__((ext_vector_type(16)));
    const int r32 = lane & 31, hi = lane >> 5;
    for (int p = vcu; p < MT / 64; p += G) {
        const int mb = wave & 1, kq = wave >> 1;
        f32x16 d;
#pragma unroll
        for (int r = 0; r < 16; ++r) d[r] = 0.f;
        const bf16* ap = XBi + (size_t)(64 * p + 32 * mb + r32) * DM + 256 * kq + 8 * hi;
        const bf16* bp = WDTl + (size_t)(r32 & 7) * DM + 256 * kq + 8 * hi;
        const bf16x8 zero8 = {0, 0, 0, 0, 0, 0, 0, 0};
        bf16x8 af[16], bq[16];
#pragma unroll
        for (int ks = 0; ks < 16; ++ks) { af[ks] = *(const bf16x8*)(ap + 16 * ks); bq[ks] = *(const bf16x8*)(bp + 16 * ks); }
#pragma unroll
        for (int ks = 0; ks < 16; ++ks) d = __builtin_amdgcn_mfma_f32_32x32x16_bf16(af[ks], (r32 < 8) ? bq[ks] : zero8, d, 0, 0, 0);
        LAS float* dp = (LAS float*)lds + ((kq * 64 + 32 * mb + 4 * hi) * 8 + r32);
        if (r32 < 8) {
#pragma unroll
            for (int r = 0; r < 16; ++r) dp[((r & 3) + 8 * (r >> 2)) * 8] = d[r]; }
        LDS_WAIT(); __syncthreads();
        { const int row = tid >> 3, j = tid & 7; const LAS float* q = (const LAS float*)lds + row * 8 + j;
          DTR[(size_t)(64 * p + row) * 8 + j] = ((q[0] + q[512]) + (q[1024] + q[1536])) * pg8::rstd_of(rss, 64 * p + row); }
        LDS_WAIT(); __syncthreads();
    }
}

__device__ __forceinline__ int moe_tables(LAS int* pan, gu32* ecnt, int tid) {
    int cnt[NE], ps[NE + 1]; ps[0] = 0;
#pragma unroll
    for (int e = 0; e < NE; ++e) { cnt[e] = (int)__hip_atomic_load(ecnt + 64 * e, RLX_AGENT); ps[e + 1] = ps[e] + ((cnt[e] + 255) >> 8); }
    if (tid < 256) { int e = 0, c = cnt[0], p0 = 0;
#pragma unroll
        for (int q = 1; q < NE; ++q) if (tid >= ps[q]) { e = q; c = cnt[q]; p0 = ps[q]; }
        const int j = tid - p0, real = min(256, c - 256 * j);
        if (tid < ps[NE]) pan[tid] = e | (j << 8) | ((real - 1) << 16); }
    LDS_WAIT(); __syncthreads();
    return ps[NE];
}
#define KARGP ((const __attribute__((address_space(4))) char*)__builtin_amdgcn_kernarg_segment_ptr())
enum { PH_PRO = 0, PH_L0 = 1, PH_FFNUP = 6, PH_FFNDN = 7, PH_L1 = 8, PH_ROUTE = 13, PH_MOEUP = 14, PH_MOEDN = 15, PH_FINAL = 16, PH_N = 17 };
#define ws (*(unsigned char* const __attribute__((address_space(4)))*)(KARGP + 168))
#define ctl ((gu32*)(ws + WS_CTL))
#define IN(k) (lo <= (k) && (k) < hi)
#ifndef PROBE_MASK
#define PROBE_MASK 0u
#endif
#define PB(k) _Pragma("unroll") for (int rep_ = 0; rep_ < (int)((PROBE_MASK >> (k)) & 1u) + 1; ++rep_) {
#define PE(k) if (rep_ + 1 < (int)((PROBE_MASK >> (k)) & 1u) + 1) xcd_barrier(bar); }
#define SEAM(k) do { if (IN(k) && IN((k) + 1)) xcd_barrier(bar); } while (0)
#define KARG_F(i) (*(const float* const __attribute__((address_space(4)))*)(KARGP + 8 * (i)))
#define x_in KARG_F(0)
#define mix_g KARG_F(1)
#define w_in KARG_F(2)
#define attn_g KARG_F(8)
#define ssd_g KARG_F(9)
#define w_out KARG_F(10)
#define ffn_g KARG_F(11)
#define dwg KARG_F(12)
#define dwu KARG_F(13)
#define dwd KARG_F(14)
#define router_w KARG_F(15)
#define mwg KARG_F(16)
#define mwu KARG_F(17)
#define mwd KARG_F(18)
#define final_g KARG_F(19)
#define conv_w KARG_F(3)
#define conv_b KARG_F(4)
#define dt_bias KARG_F(5)
#define a_log KARG_F(6)
#define d_skip KARG_F(7)
#define OUTF (*(float* const __attribute__((address_space(4)))*)(KARGP + 160))
#define XR ((bf16*)(ws + WS_XR))
#define WIN_T ((bf16*)(ws + WS_WIN))
#define WOUT_T ((bf16*)(ws + WS_WOUT))
#define WDGU_T ((bf16*)(ws + WS_WDGU))
#define WDD_T ((bf16*)(ws + WS_WDD))
#define WDGU8 ((unsigned char*)(ws + WS_WDGU))
#define WDD8 ((unsigned char*)(ws + WS_WDD))
#define HB8 ((unsigned char*)(ws + WS_HB))
#define WMGU_T ((bf16*)(ws + WS_R1))
#define WMGU8 ((unsigned char*)(ws + WS_R1))
#define WMD8 ((unsigned char*)(ws + WS_R1 + 60 * MiB))
#define XB8 ((unsigned char*)(ws + WS_XBCC))
#define HID8 ((unsigned char*)(ws + WS_R3))
#define PROJ ((bf16*)(ws + WS_PROJ))
#define AO ((bf16*)(ws + WS_AO))
#define HB ((bf16*)(ws + WS_HB))
#define HPERM ((bf16*)(ws + WS_R2))
#define YB ((bf16*)(ws + WS_R2))
#define YPB ((bf16*)(ws + WS_XN))
#define HID ((bf16*)(ws + WS_R3))
#define RSS(s) ((float*)(ws + WS_RSS) + (size_t)(s) * MT * 16)
#define DTRAW ((float*)(ws + WS_DTRAW))
#define WDT ((bf16*)(ws + WS_WDT))
#define ROWTOK_V ((int*)(ws + WS_RTOKV))
#define ROWG_V ((float*)(ws + WS_RGV))
#define ROWS_V ((float*)(ws + WS_RSV))
#define ACUM ((float*)(ws + WS_DTV))
#define CCB ((bf16*)(ws + WS_XBCC))
#define YDB ((float*)(ws + WS_ATTRAW))
#define STB ((float*)(ws + WS_YRAW))
#define ST2B ((float*)(ws + WS_ST2))
#define TOKE ((int*)(ws + WS_TOKE))
#define TOKR ((int*)(ws + WS_TOKR))
#define TOKG ((float*)(ws + WS_TOKG))
#define TOKP ((int*)(ws + WS_TOKP))
#define ROWG ((float*)(ws + WS_ROWG))
#define PTAB ((int*)(ws + WS_PTAB))
#define ECNT (ctl + CW_ECNT)

struct ConvDesc { const float* src; unsigned char* dst; int gko, ldw, pitch; float scale; int fp8; };
constexpr int GT_MIX1 = 0, GT_FFN0 = DM, GT_FFN1 = 2 * DM, GT_ONE = 3 * DM, GT_N = 3 * DM + 64;
constexpr int CI_IN = (DM / 64) * (NPROJ / 64), CI_OUT = (DM / 64) * (DM / 64), CI_DGU = 2 * (DM / 64) * (DFF / 64), CI_DD = (DFF / 64) * (DM / 64), CI_MGU = 2 * (DM / 64) * (DFFE / 64), CI_MD = (DFFE / 64) * (DM / 64);
constexpr int CI_DONOR = CI_IN + 2 * CI_OUT + CI_DGU + CI_DD + NE * CI_MGU + NE_PRO * CI_MD;
__device__ __forceinline__ ConvDesc conv_decode(int r) {
    ConvDesc d; d.gko = GT_ONE; d.scale = 1.f; d.fp8 = 0;
    if (r < CI_IN) { const int kb = r / (NPROJ / 64), nb = r % (NPROJ / 64);
        d.src = w_in + (size_t)DM * DINP + (size_t)(64 * kb) * DINP + 64 * nb; d.ldw = DINP; d.gko = GT_MIX1 + 64 * kb; d.dst = (unsigned char*)(WIN_T + (size_t)NPROJ * DM + (size_t)(64 * nb) * DM + 64 * kb); d.pitch = DM * 2; return d; }
    r -= CI_IN;
    if (r < 2 * CI_OUT) { const int l = r / CI_OUT, q = r % CI_OUT, kb = q / (DM / 64), nb = q % (DM / 64);
        d.src = w_out + (size_t)l * DM * DM + (size_t)(64 * kb) * DM + 64 * nb; d.ldw = DM; d.dst = (unsigned char*)(WOUT_T + (size_t)l * DM * DM + (size_t)(64 * nb) * DM + 64 * kb); d.pitch = DM * 2; return d; }
    r -= 2 * CI_OUT;
    if (r < CI_DGU) { const int nblk = DFF / 64, per = (DM / 64) * nblk, half = r / per, q = r % per, kb = q / nblk, nb = q % nblk, f0 = 64 * nb, drow0 = (f0 / 128) * 256 + half * 128 + (f0 % 128);
        d.src = (half ? dwu : dwg) + (size_t)(64 * kb) * DFF + f0; d.ldw = DFF; d.gko = GT_FFN0 + 64 * kb; d.scale = WU_SCALE; d.fp8 = 1; d.dst = WDGU8 + (size_t)drow0 * DM + 64 * kb; d.pitch = DM; return d; }
    r -= CI_DGU;
    if (r < CI_DD) { const int kb = r / (DM / 64), nb = r % (DM / 64);
        d.src = dwd + (size_t)(64 * kb) * DM + 64 * nb; d.ldw = DM; d.dst = (unsigned char*)(WDD_T + (size_t)(64 * nb) * DFF + 64 * kb); d.pitch = DFF * 2; return d; }
    r -= CI_DD;
    if (r < NE * CI_MGU) { const int e = r / CI_MGU, q = r % CI_MGU, nblk = DFFE / 64, per = (DM / 64) * nblk, half = q / per, qq = q % per, kb = qq / nblk, nb = qq % nblk, f0 = 64 * nb, drow0 = (f0 / 128) * 256 + half * 128 + (f0 % 128);
        d.src = (half ? mwu : mwg) + (size_t)e * DM * DFFE + (size_t)(64 * kb) * DFFE + f0; d.ldw = DFFE; d.gko = GT_FFN1 + 64 * kb; d.scale = WU_SCALE; d.fp8 = 1;
        d.dst = WMGU8 + (size_t)e * 2 * DFFE * DM + (size_t)drow0 * DM + 64 * kb; d.pitch = DM; return d; }
    r -= NE * CI_MGU;
    { const int e = (NE - NE_PRO) + r / CI_MD, q = r % CI_MD, kb = q / (DM / 64), nb = q % (DM / 64);
        d.src = mwd + (size_t)e * DFFE * DM + (size_t)(64 * kb) * DM + 64 * nb; d.ldw = DM; d.scale = WD_SCALE; d.fp8 = 1; d.dst = WMD8 + (size_t)e * DM * DFFE + (size_t)(64 * nb) * DFFE + 64 * kb; d.pitch = DFFE; return d; }
}
__device__ __forceinline__ void conv_ld(const ConvDesc& d, f32x4 (&v)[16], int lane) {
    asm volatile("" : "+v"(lane));
    const float* s = d.src + (size_t)(16 * (lane >> 4)) * d.ldw + 4 * (lane & 15);
#pragma unroll
    for (int i = 0; i < 16; ++i) v[i] = __builtin_nontemporal_load((const GAS f32x4*)(s + (size_t)i * d.ldw));
}
__device__ __forceinline__ void conv_st(const ConvDesc& d, f32x4 (&v)[16], LAS unsigned char* scr, const LAS float* gtab, int lane) {
    asm volatile("" : "+v"(lane));
    const int kq = lane >> 4, n4 = lane & 15;
    { const LAS f32x4* gt = (const LAS f32x4*)(gtab + d.gko + 16 * kq);
#pragma unroll
      for (int q = 0; q < 4; ++q) { const f32x4 g4 = gt[q] * d.scale;
#pragma unroll
          for (int i = 0; i < 4; ++i) v[4 * q + i] = v[4 * q + i] * g4[i]; } }
    if (d.fp8) {
#pragma unroll
        for (int j = 0; j < 4; ++j) { int w[4];
#pragma unroll
            for (int q = 0; q < 4; ++q) { w[q] = __builtin_amdgcn_cvt_pk_fp8_f32(v[4 * q][j], v[4 * q + 1][j], 0, false); w[q] = __builtin_amdgcn_cvt_pk_fp8_f32(v[4 * q + 2][j], v[4 * q + 3][j], w[q], true); }
            *(LAS v4u*)(scr + (4 * n4 + j) * 80 + kq * 16) = (v4u){(unsigned)w[0], (unsigned)w[1], (unsigned)w[2], (unsigned)w[3]}; }
        LDS_WAIT(); asm volatile("" ::: "memory");
#pragma unroll
        for (int i = 0; i < 4; ++i) { const int idx = lane + 64 * i, n = idx >> 2, c = idx & 3;
            __builtin_nontemporal_store(*(const LAS v4u*)(scr + n * 80 + c * 16), (GAS v4u*)(d.dst + (size_t)n * d.pitch + 16 * c)); }
        LDS_WAIT(); asm volatile("" ::: "memory");
    } else {
#pragma unroll
        for (int j = 0; j < 4; ++j) { v4u a, b;
            a.x = sba::cvtpk(v[0][j], v[1][j]); a.y = sba::cvtpk(v[2][j], v[3][j]); a.z = sba::cvtpk(v[4][j], v[5][j]); a.w = sba::cvtpk(v[6][j], v[7][j]);
            b.x = sba::cvtpk(v[8][j], v[9][j]); b.y = sba::cvtpk(v[10][j], v[11][j]); b.z = sba::cvtpk(v[12][j], v[13][j]); b.w = sba::cvtpk(v[14][j], v[15][j]);
            LAS unsigned char* p = scr + (4 * n4 + j) * 144 + kq * 32;
            *(LAS v4u*)p = a; *(LAS v4u*)(p + 16) = b; }
        LDS_WAIT(); asm volatile("" ::: "memory");
#pragma unroll
        for (int i = 0; i < 8; ++i) { const int n = 8 * i + (lane >> 3), c = lane & 7;
            __builtin_nontemporal_store(*(const LAS v4u*)(scr + n * 144 + c * 16), (GAS v4u*)(d.dst + (size_t)n * d.pitch + 16 * c)); }
        LDS_WAIT(); asm volatile("" ::: "memory");
    }
}
__device__ __forceinline__ void donor_convert(LAS unsigned char* lds, const int w0, const int nw, const int wave, const int lane, const int tid) {
    LAS float* gtab = (LAS float*)(lds + NWAVES * 16384); LAS unsigned char* scr = lds + wave * 16384;
    for (int i = tid; i < GT_N; i += NWAVES * 64) gtab[i] = (i < DM) ? mix_g[DM + i] : (i < 3 * DM) ? ffn_g[i - DM] : 1.f;
    LDS_WAIT(); __syncthreads();
    f32x4 va[16], vb[16];
    conv_ld(conv_decode(min(w0, CI_DONOR - 1)), va, lane);
    for (int r = w0; r < CI_DONOR; r += 2 * nw) {
        const int r2 = r + nw, r3 = r + 2 * nw;
        conv_ld(conv_decode(min(r2, CI_DONOR - 1)), vb, lane);
        conv_st(conv_decode(r), va, scr, gtab, lane);
        conv_ld(conv_decode(min(r3, CI_DONOR - 1)), va, lane);
        if (r2 < CI_DONOR) conv_st(conv_decode(r2), vb, scr, gtab, lane);
    }
    asm volatile("" :: "v"(va[0]), "v"(va[15]));
}

template <int layer>
__device__ __forceinline__ void layer_phases(LAS unsigned char* L, const XcdBarrier& bar, const int lo, const int hi, const int tid, const int lane, const int wave, const int G, const int bx, const int gw, const int NGW) {
        const int pb = layer ? PH_L1 : PH_L0;
        if (IN(pb + 0)) {
            PB(pb + 0)
            const int GG = (layer == 0 && G >= 8) ? G - 3 * G / 8 : G;
            if (bx < GG) {
            pg8::Gemm g{XR, WIN_T + (size_t)layer * NPROJ * DM, MT, NPROJ, DM, DM}; pg8::StaticOrder S; S.init(MT, NPROJ, GG, bx);
            pg8::fill_rs<1>((LAS float*)(L + RS_TAB_OFF), S, RSS(layer ? 2 : 0), tid);
            pg8::EpiBf16 E{PROJ, NPROJ, 512, 0.125f * 1.4426950408889634f, (const LAS float*)(L + RS_TAB_OFF)};
            pg8::gemm_phase<pg8::EpiBf16, pg8::StaticOrder, true, true>(L + RING_OFF, g, S, E);
            dt_tail(XR, WDT + layer * 8 * DM, RSS(layer ? 2 : 0), DTRAW, L + RING_OFF, (GG % 8 == 0) ? (bx % 8) * (GG / 8) + bx / 8 : bx, GG, wave, lane, tid);
            } else { if constexpr (layer == 0) donor_convert(L + RING_OFF, (bx - GG) * NWAVES + wave, (G - GG) * NWAVES, wave, lane, tid); }
            PE(pb + 0)
        }
        SEAM(pb + 0);
        if (IN(pb + 1)) {
            PB(pb + 1)
            const ssd::ATensors T{PROJ, conv_w + layer * 4096, conv_b + layer * 1024, DTRAW, dt_bias + layer * 8, a_log + layer * 8, d_skip + layer * 8, (bf16*)YDB, (bf16*)STB, CCB, ACUM};
            for (int u = ((G % 8 == 0) ? (bx % 8) * (G / 8) + bx / 8 : bx); u < BATCH * 16 * 2; u += G) ssd::phaseA_unit(u >> 5, (u >> 1) & 15, u & 1, T, L + RING_OFF, wave, lane);
            PE(pb + 1)
        }
        const bool split12 = IN(pb + 1) && IN(pb + 2);
        if (split12) xcd_arrive(bar, (unsigned*)(ctl + CW_BAR2));
        if (IN(pb + 2)) {
            PB(pb + 2)
            int par = 0;
            for (int u = ((G % 8 == 0) ? (bx % 8) * (G / 8) + bx / 8 : bx); u < BATCH * (SEQ / 64); u += G) { sba::attn_unit(u >> 5, (SEQ / 64 - 1) - (u & 31), PROJ, attn_g + layer * 512, AO, L + RING_OFF, wave, lane, par); par ^= 1; }
            if (split12) xcd_wait(bar, (unsigned*)(ctl + CW_BAR2), (unsigned)layer + 1u);
            ssd::scan_states((const bf16*)STB, (bf16*)ST2B, ACUM, bx * (NWAVES * 64) + tid, G * NWAVES * 64);
            PE(pb + 2)
        }
        SEAM(pb + 2);
        if (IN(pb + 3)) {
            PB(pb + 3)
            const ssd::BTensors T{PROJ, (const bf16*)YDB, (const bf16*)ST2B, CCB, ACUM, ssd_g + layer * 512, AO};
            for (int u = ((G % 8 == 0) ? (bx % 8) * (G / 8) + bx / 8 : bx); u < BATCH * 16 * 2; u += G) ssd::phaseB_unit(u >> 5, (u >> 1) & 15, u & 1, T, L + RING_OFF, wave, lane, tid);
            PE(pb + 3)
        }
        SEAM(pb + 3);
        if (IN(pb + 4)) {
            PB(pb + 4)
            pg8::Gemm g{AO, WOUT_T + (size_t)layer * DM * DM, MT, DM, DM, DM}; pg8::StaticOrder S; S.init(MT, DM, G, bx, 8);
            pg8::EpiResAddNorm E{XR, DM, RSS(layer ? 3 : 1), XB8, 1.f};
            pg8::gemm_phase<pg8::EpiResAddNorm, pg8::StaticOrder, true, true>(L + RING_OFF, g, S, E);
            PE(pb + 4)
        }
        SEAM(pb + 4);
    }
__global__ void __launch_bounds__(NWAVES * 64, 2) mk_fwd(Args args) {
    extern __shared__ __attribute__((aligned(16))) unsigned char lds[];
    LAS unsigned char* L = (LAS unsigned char*)lds;
    const int tid = threadIdx.x, lane = tid & 63, wave = __builtin_amdgcn_readfirstlane(tid >> 6);
    const int G = gridDim.x; const int bx = blockIdx.x; const int vcu = (G % 8 == 0) ? (bx % 8) * (G / 8) + bx / 8 : bx;
    const int gw = vcu * NWAVES + wave, NGW = G * NWAVES;
    for (int u = tid; u < (LDS_BYTES - LDSCTL_OFF) / 4; u += NWAVES * 64) ((LAS unsigned*)(L + LDSCTL_OFF))[u] = 0u;
    __syncthreads();
    const int lo = *(const __attribute__((address_space(4))) int*)(KARGP + 176), hi = *(const __attribute__((address_space(4))) int*)(KARGP + 180);
    XcdBarrier bar; bar.bar = (unsigned*)(ctl + CW_BAR); bar.x = 0; bar.st = nullptr;
    if (hi - lo > 1) bar = xcd_barrier_post((unsigned*)(ctl + CW_BAR), (volatile LAS unsigned*)(L + MISC_OFF) + 8);
    if (IN(PH_PRO)) {
        PB(PH_PRO)
        LAS unsigned char* scr = L + RING_OFF + wave * 16384;
        for (int it = gw; it < CI_IN; it += NGW) conv_plain(w_in, DINP, DM, NPROJ, WIN_T, it, scr, lane, mix_g);
        xb_rows(x_in, mix_g, XR, RSS(0), gw, NGW, lane);
        { const int idx = bx * (NWAVES * 64) + tid; if (idx < 2 * 8 * DM) { const int l = idx >> 13, j = (idx >> 10) & 7, k = idx & 1023; WDT[idx] = (bf16)f2bf(w_in[(size_t)l * DM * DINP + (size_t)k * DINP + NPROJ + j] * mix_g[l * DM + k]); } }
        PE(PH_PRO)
    }
    SEAM(PH_PRO);
    layer_phases<0>(L, bar, lo, hi, tid, lane, wave, G, bx, gw, NGW);
    if (IN(PH_FFNUP)) {
        PB(PH_FFNUP)
        pg8::Gemm g{(const pg8::bf16_t*)XB8, (const pg8::bf16_t*)WDGU8, MT, 2 * DFF, DM, DM}; pg8::StaticOrder S; S.init(MT, 2 * DFF, G, bx);
        pg8::fill_rs<1>((LAS float*)(L + RS_TAB_OFF), S, RSS(1), tid, 1.f / WU_SCALE);
        pg8::EpiSwiGLU E{HB, DFF, (const LAS float*)(L + RS_TAB_OFF)};
        pg8::gemm_phase<pg8::EpiSwiGLU, pg8::StaticOrder, true, true, 1>(L + RING_OFF, g, S, E);
        {
            const int nfull = S.nwg % G;
            if (nfull > 0 && bx >= nfull) { LAS unsigned char* scr = L + RING_OFF + wave * 16384; constexpr int I_MD = (DFFE / 64) * (DM / 64); const int nid = (G - nfull) * NWAVES;
                for (int it = (bx - nfull) * NWAVES + wave; it < (NE - NE_PRO) * I_MD; it += nid) { const int e = it / I_MD, q = it % I_MD, kb = q / (DM / 64), nb = q % (DM / 64);
                    transpose_item8(mwd + (size_t)e * DFFE * DM, DM, WMD8 + (size_t)e * DM * DFFE, DFFE, 64 * kb, 64 * nb, 64 * nb, WD_SCALE, scr, lane); } }
            else if (nfull == 0) { LAS unsigned char* scr = L + RING_OFF + wave * 16384; constexpr int I_MD = (DFFE / 64) * (DM / 64);
                for (int it = gw; it < (NE - NE_PRO) * I_MD; it += NGW) { const int e = it / I_MD, q = it % I_MD, kb = q / (DM / 64), nb = q % (DM / 64);
                    transpose_item8(mwd + (size_t)e * DFFE * DM, DM, WMD8 + (size_t)e * DM * DFFE, DFFE, 64 * kb, 64 * nb, 64 * nb, WD_SCALE, scr, lane); } }
        }
        PE(PH_FFNUP)
    }
    SEAM(PH_FFNUP);
    if (IN(PH_FFNDN)) {
        PB(PH_FFNDN)
        pg8::Gemm g{HB, WDD_T, MT, DM, DFF, DFF}; pg8::StaticOrder S; S.init(MT, DM, G, bx, 8);
        pg8::EpiResAddNorm E{XR, DM, RSS(2), nullptr, 1.f};
        pg8::gemm_phase<pg8::EpiResAddNorm, pg8::StaticOrder, true, true>(L + RING_OFF, g, S, E);
        PE(PH_FFNDN)
    }
    SEAM(PH_FFNDN);
    layer_phases<1>(L, bar, lo, hi, tid, lane, wave, G, bx, gw, NGW);
    if (IN(PH_ROUTE)) {
        PB(PH_ROUTE)
        LAS float* tab = (LAS float*)(L + RING_OFF);
        load_tab8(router_w, 8, tab, tid);
        route_rows(XR, ffn_g + DM, RSS(3), tab, (LAS int*)(L + RING_OFF + 32768), TOKE, TOKR, ROWTOK_V, ROWG_V, ROWS_V, ECNT, gw, NGW, lane, tid);
        PE(PH_ROUTE)
    }
    SEAM(PH_ROUTE);
    if (IN(PH_MOEUP)) {
        PB(PH_MOEUP)
        const int P = moe_tables((LAS int*)(L + PAN_TAB_OFF), ECNT, tid);
        pg8::Gemm g{(const pg8::bf16_t*)XB8, (const pg8::bf16_t*)WMGU8, P * 256, 2 * DFFE, DM, DM}; pg8::GroupedOrder<true> S; S.init(P, 2 * DFFE / 256, G, bx, (const LAS int*)(L + PAN_TAB_OFF), (const LAS unsigned short*)(L + TOK_TAB_OFF), (long)2 * DFFE * DM);
        pg8::fill_grouped((LAS float*)(L + RS_TAB_OFF), (LAS unsigned short*)(L + TOK_TAB_OFF), S, ROWS_V, ROWTOK_V, tid, 1.f / WU_SCALE);
        pg8::EpiSwiGLU8 E{HID8, DFFE, (const LAS float*)(L + RS_TAB_OFF)};
        pg8::gemm_phase<pg8::EpiSwiGLU8, pg8::GroupedOrder<true>, true, true, 1>(L + RING_OFF, g, S, E);
        PE(PH_MOEUP)
    }
    SEAM(PH_MOEUP);
    if (IN(PH_MOEDN)) {
        PB(PH_MOEDN)
        const int P = moe_tables((LAS int*)(L + PAN_TAB_OFF), ECNT, tid);
        {
            pg8::Gemm g{(const pg8::bf16_t*)HID8, (const pg8::bf16_t*)WMD8, 128 * 256, DM, DFFE, DFFE}; pg8::GroupedOrder<false> S; S.init(128, DM / 256, G, bx, (const LAS int*)(L + PAN_TAB_OFF), nullptr, (long)DM * DFFE, 8);
            pg8::fill_grouped((LAS float*)(L + RS_TAB_OFF), (LAS unsigned short*)nullptr, S, ROWG_V, nullptr, tid, 1.f / WD_SCALE);
            pg8::EpiRowScaleBf16 E{YB, DM, (const LAS float*)(L + RS_TAB_OFF)};
            pg8::gemm_phase<pg8::EpiRowScaleBf16, pg8::GroupedOrder<false>, true, true, 1>(L + RING_OFF, g, S, E);
        }
        if (P > 128) {
            pg8::Gemm g{(const pg8::bf16_t*)HID8, (const pg8::bf16_t*)WMD8, P * 256, DM, 512, DFFE}; pg8::TailOrder S; S.init(P, G, bx, (const LAS int*)(L + PAN_TAB_OFF), (long)DM * DFFE, 1);
            pg8::fill_grouped((LAS float*)(L + RS_TAB_OFF), (LAS unsigned short*)nullptr, S, ROWG_V, nullptr, tid, 1.f / WD_SCALE);
            pg8::EpiRowScaleBf16 E{YPB, DM, (const LAS float*)(L + RS_TAB_OFF)};
            pg8::gemm_phase<pg8::EpiRowScaleBf16, pg8::TailOrder, true, true, 1>(L + RING_OFF, g, S, E);
        }
        PE(PH_MOEDN)
    }
    SEAM(PH_MOEDN);
    if (IN(PH_FINAL)) {
        PB(PH_FINAL)
        int off[NE + 1]; off[0] = 0;
#pragma unroll
        for (int e = 0; e < NE; ++e) { const int c = (int)__hip_atomic_load(ECNT + 64 * e, RLX_AGENT); off[e + 1] = off[e] + ((c + 255) & ~255); }
        f32x4 gv[4];
#pragma unroll
        for (int j = 0; j < 4; ++j) gv[j] = *((const GAS f32x4*)final_g + lane + 64 * j);
#define ADD4(v_, a_) do { v_.x += bfbits2f((unsigned)(a_) & 0xffffu); v_.y += bfbits2f((unsigned)(a_) >> 16); v_.z += bfbits2f((unsigned)((a_) >> 32) & 0xffffu); v_.w += bfbits2f((unsigned)((a_) >> 48)); } while (0)
        for (int m0 = gw; m0 < MT; m0 += 8 * NGW) {
            int pa[8], pc[8];
#pragma unroll
            for (int k = 0; k < 8; ++k) { const int m = m0 + k * NGW; pa[k] = 0; pc[k] = 0;
                if (m < MT) { const int ea = TOKE[2 * m], ec = TOKE[2 * m + 1]; int oa = 0, oc = 0;
#pragma unroll
                    for (int q = 0; q < NE; ++q) { oa = (ea == q) ? off[q] : oa; oc = (ec == q) ? off[q] : oc; }
                    pa[k] = oa + TOKR[2 * m]; pc[k] = oc + TOKR[2 * m + 1]; } }
#pragma unroll
            for (int k = 0; k < 8; k += 2) {
                unsigned long long xa[2][4], ya[2][4], yc[2][4];
#pragma unroll
                for (int h = 0; h < 2; ++h) { const int m = m0 + (k + h) * NGW;
                    if (m < MT) { const GAS unsigned long long* xb = (const GAS unsigned long long*)(XR + (size_t)m * DM) + lane;
#pragma unroll
                        for (int j = 0; j < 4; ++j) xa[h][j] = xb[64 * j];
                        if (pa[k + h] < 32768) { const GAS unsigned long long* y = (const GAS unsigned long long*)(YB + (size_t)pa[k + h] * DM) + lane;
#pragma unroll
                            for (int j = 0; j < 4; ++j) ya[h][j] = y[64 * j]; }
                        if (pc[k + h] < 32768) { const GAS unsigned long long* y = (const GAS unsigned long long*)(YB + (size_t)pc[k + h] * DM) + lane;
#pragma unroll
                            for (int j = 0; j < 4; ++j) yc[h][j] = y[64 * j]; } } }
#pragma unroll
                for (int h = 0; h < 2; ++h) { const int m = m0 + (k + h) * NGW;
                    if (m < MT) { GAS f32x4* xr = (GAS f32x4*)(OUTF + (size_t)m * DM) + lane;
                        f32x4 v[4]; float s = 0.f;
#pragma unroll
                        for (int j = 0; j < 4; ++j) { const unsigned long long a = xa[h][j]; v[j] = (f32x4){bfbits2f((unsigned)a & 0xffffu), bfbits2f((unsigned)a >> 16), bfbits2f((unsigned)(a >> 32) & 0xffffu), bfbits2f((unsigned)(a >> 48))}; }
#pragma unroll
                        for (int side = 0; side < 2; ++side) { const int pos = side ? pc[k + h] : pa[k + h];
                            if (pos < 32768) {
#pragma unroll
                                for (int j = 0; j < 4; ++j) { const unsigned long long a = side ? yc[h][j] : ya[h][j]; ADD4(v[j], a); } }
                            else { unsigned long long tp[7][4];
#pragma unroll
                                for (int sl = 0; sl < 7; ++sl) { const GAS unsigned long long* y = (const GAS unsigned long long*)(YPB + ((size_t)sl * 2048 + (pos - 32768)) * DM) + lane;
#pragma unroll
                                    for (int j = 0; j < 4; ++j) tp[sl][j] = y[64 * j]; }
#pragma unroll
                                for (int sl = 0; sl < 7; ++sl) {
#pragma unroll
                                    for (int j = 0; j < 4; ++j) ADD4(v[j], tp[sl][j]); } } }
#pragma unroll
                        for (int j = 0; j < 4; ++j) s += (v[j].x * v[j].x + v[j].y * v[j].y) + (v[j].z * v[j].z + v[j].w * v[j].w);
                        const float rstd = 1.f / sqrtf(wave_sum(s) * (1.f / DM) + EPS);
#pragma unroll
                        for (int j = 0; j < 4; ++j) xr[64 * j] = v[j] * rstd * gv[j]; } }
            }
        }
#undef ADD4
        PE(PH_FINAL)
    }
#undef IN
}

#undef ws
#undef ctl
#undef X
extern "C" void kernel_launch(void* const* d_in, const int* in_sizes, int n_in, void* d_out, int out_size, void* d_ws, size_t ws_size, hipStream_t stream) {
    static int grid = 0;
    if (grid == 0) {
        if (n_in != 20 || in_sizes[0] != MT * DM || out_size != MT * DM || ws_size < WS_END) { fprintf(stderr, "kernel_launch: unexpected shapes / workspace (n_in %d, ws %zu < %zu); nothing launched\n", n_in, ws_size, (size_t)WS_END); grid = -1; return; }
        int dev = 0, cus = 0;
        if (hipGetDevice(&dev) != hipSuccess || hipDeviceGetAttribute(&cus, hipDeviceAttributeMultiprocessorCount, dev) != hipSuccess) { grid = -1; return; }
        if (hipFuncSetAttribute((const void*)mk_fwd, hipFuncAttributeMaxDynamicSharedMemorySize, LDS_BYTES) != hipSuccess) { fprintf(stderr, "kernel_launch: hipFuncSetAttribute failed\n"); grid = -1; return; }
        int per_cu = 0;
        if (hipOccupancyMaxActiveBlocksPerMultiprocessor(&per_cu, (const void*)mk_fwd, NWAVES * 64, LDS_BYTES) != hipSuccess || per_cu < 1) { fprintf(stderr, "kernel_launch: occupancy query reports %d workgroups per CU for %d B of LDS; the grid would not be resident; nothing launched\n", per_cu, LDS_BYTES); grid = -1; return; }
        (void)hipGetLastError();
        grid = cus;
    }
    if (grid < 0) return;
    (void)hipMemsetAsync((char*)d_ws + WS_CTL, 0, CTL_ZERO_BYTES, stream);
    Args a{};
    for (int i = 0; i < 20; ++i) a.in[i] = (const float*)d_in[i];
    a.out = (float*)d_out; a.ws = (unsigned char*)d_ws;
    auto run = [&](int lo, int hi) { a.ph_lo = lo; a.ph_hi = hi; hipLaunchKernelGGL(mk_fwd, dim3(grid), dim3(NWAVES * 64), LDS_BYTES, stream, a); };
    run(PH_PRO, PH_N);
}
```

```cpp
#include <hip/hip_runtime.h>
#include <cstdio>
#include <cstdint>
namespace pg8 {
#define PG8_LAS __attribute__((address_space(3)))
typedef unsigned short bf16_t;
typedef short bf16x8 __attribute__((ext_vector_type(8)));
typedef short bf16x16 __attribute__((ext_vector_type(16)));
typedef int i32x8 __attribute__((ext_vector_type(8)));
typedef float f32x4 __attribute__((ext_vector_type(4)));
typedef unsigned u32x4 __attribute__((ext_vector_type(4)));
constexpr int BM = 256, BK = 64, HALF = 128, HTB = HALF * BK * 2  , STAGE_BYTES = 8 * HTB, NXCD = 8;

__host__ __device__ __forceinline__ int lds_byte(int r, int c) { const int st = (r >> 4) * 2 + (c >> 5), rr = r & 15, cc = c & 31, ob = rr * 64 + cc * 2; return st * 1024 + (ob ^ (((ob >> 9) & 1) << 5)); }
__host__ __device__ __forceinline__ void stage_rc(int b, int& R, int& C) { const int st = b / 1024, sb = b % 1024, swz = sb ^ (((sb >> 9) & 1) << 5); R = (st >> 1) * 16 + swz / 64; C = (st & 1) * 32 + (swz % 64) / 2; }
__host__ __device__ __forceinline__ int perm32(int rho) { const int n = rho >> 4, i = rho & 15; return 8 * (i >> 2) + 4 * n + (i & 3); }

struct Unit { int pm, pn; long boff; int ord; int arow0, avalid; long aoff, ooff; };
struct Gemm { const bf16_t* A; const bf16_t* Bt; int M, N, K, ld; };

struct StaticOrder {
    int nM, nN, nwg, G, c, WGM;
    __host__ __device__ void init(int M, int N, int G_, int c_, int wgm = 4) { nM = M / BM; nN = N / BM; nwg = nM * nN; G = G_; c = c_; WGM = wgm; }
    __host__ __device__ bool next(int i, Unit& u) const {
        const long L = (long)i * G + c; if (L >= nwg) return false;
        int wgid = (int)L; { const int q = nwg / NXCD, r = nwg % NXCD, xcd = wgid % NXCD, off = wgid / NXCD; wgid = (xcd < r ? xcd * (q + 1) : r * (q + 1) + (xcd - r) * q) + off; }
        const int nig = WGM * nN, gid = wgid / nig, fm = gid * WGM, gsz = (nM - fm) < WGM ? (nM - fm) : WGM;
        u.pm = fm + ((wgid % nig) % gsz); u.pn = (wgid % nig) / gsz; u.boff = 0; u.ord = i; u.arow0 = 0; u.avalid = BM; u.aoff = 0; u.ooff = 0; return true;
    }
    static constexpr bool GATHER = false;
    __device__ __forceinline__ int arow(const Unit&, int r) const { return r; }
    __device__ __forceinline__ void a_ready(const Unit&) const {}
    __device__ __forceinline__ void done(const Unit&) const {}
};

__device__ __forceinline__ unsigned cvt_pk_bf16(float lo, float hi) { unsigned r; asm volatile("v_cvt_pk_bf16_f32 %0, %1, %2" : "=v"(r) : "v"(lo), "v"(hi)); return r; }
typedef float f32x2 __attribute__((ext_vector_type(2)));

__device__ __forceinline__ float rstd_of(const float* rss, int row) {
    const f32x4 a = *(const f32x4*)(rss + (size_t)row * 16), b = *(const f32x4*)(rss + (size_t)row * 16 + 4), c = *(const f32x4*)(rss + (size_t)row * 16 + 8), d = *(const f32x4*)(rss + (size_t)row * 16 + 12);
    const float s = (((a[0] + a[1]) + (a[2] + a[3])) + ((b[0] + b[1]) + (b[2] + b[3]))) + (((c[0] + c[1]) + (c[2] + c[3])) + ((d[0] + d[1]) + (d[2] + d[3])));
    return __builtin_amdgcn_rsqf(s * (1.f / 1024.f) + 1e-5f);
}
__device__ __forceinline__ void epi_st16(void* p, u32x4 w, bool nt) { if (nt) __builtin_nontemporal_store(w, (__attribute__((address_space(1))) u32x4*)p); else *(u32x4*)p = w; }
__device__ __forceinline__ void epi_st8(void* p, unsigned long long w, bool nt) { if (nt) __builtin_nontemporal_store(w, (__attribute__((address_space(1))) unsigned long long*)p); else *(unsigned long long*)p = w; }
struct EpiBf16 {
    static constexpr bool PERM = true, AFTER_DRAIN = false;
    bf16_t* O; int ldc; int scale_cols; float scale0; const PG8_LAS float* rs;
    __device__ __forceinline__ void operator()(const f32x4 (&acc)[2][2][4][2], const Unit& u, int wr, int wc, int fr, int fq, const bool nt) const {
        const int row0 = u.pm * BM + wr * 64 + fr; const int colt = u.pn * BM;
        const float sc = (colt < scale_cols) ? scale0 : 1.f;
        const int col0 = colt + wc * 32 + 8 * fq;
        const PG8_LAS float* rsu = rs + u.ord * 256 + wr * 64 + fr;
#pragma unroll
        for (int ai = 0; ai < 2; ++ai)
#pragma unroll
            for (int m = 0; m < 4; ++m) { bf16_t* rowp = O + (size_t)(row0 + ai * HALF + m * 16) * ldc + col0;
                const float rsv = sc * rsu[ai * HALF + m * 16];
#pragma unroll
                for (int bj = 0; bj < 2; ++bj) { f32x4 v0 = acc[ai][bj][m][0] * rsv, v1 = acc[ai][bj][m][1] * rsv;
                    u32x4 w; w.x = cvt_pk_bf16(v0[0], v0[1]); w.y = cvt_pk_bf16(v0[2], v0[3]); w.z = cvt_pk_bf16(v1[0], v1[1]); w.w = cvt_pk_bf16(v1[2], v1[3]);
                    epi_st16(rowp + bj * HALF, w, nt); } }
    }
};
__device__ __forceinline__ float silu_mul(float g, float u) { return g * u * __builtin_amdgcn_rcpf(1.f + __builtin_amdgcn_exp2f(-1.4426950408889634f * g)); }
__device__ __forceinline__ f32x2 silu_mul2(f32x2 g, f32x2 u) {
    const f32x2 t = g * (-1.4426950408889634f); f32x2 e; e.x = __builtin_amdgcn_exp2f(t.x); e.y = __builtin_amdgcn_exp2f(t.y);
    const f32x2 d = e + 1.0f; f32x2 r; r.x = __builtin_amdgcn_rcpf(d.x); r.y = __builtin_amdgcn_rcpf(d.y);
    return (g * u) * r;
}
__device__ __forceinline__ f32x2 silu_mul2s(f32x2 g, f32x2 u, const float cs, const float is2) {
    const f32x2 t = g * cs; f32x2 e; e.x = __builtin_amdgcn_exp2f(t.x); e.y = __builtin_amdgcn_exp2f(t.y);
    const f32x2 d = e * is2 + is2; f32x2 r; r.x = __builtin_amdgcn_rcpf(d.x); r.y = __builtin_amdgcn_rcpf(d.y);
    return (g * u) * r;
}
__device__ __forceinline__ float inv_sq_scale(float s) { return s > 0.f ? __builtin_amdgcn_rcpf(s * s) : 1e30f; }
struct EpiSwiGLU {
    static constexpr bool PERM = true, AFTER_DRAIN = false;
    bf16_t* O; int ldc; const PG8_LAS float* rs;
    __device__ __forceinline__ void operator()(const f32x4 (&acc)[2][2][4][2], const Unit& u, int wr, int wc, int fr, int fq, const bool nt) const {
        const int row0 = u.pm * BM + wr * 64 + fr; const int col0 = u.pn * HALF + wc * 32 + 8 * fq;
        const PG8_LAS float* rsu = rs + u.ord * 256 + wr * 64 + fr;
#pragma unroll
        for (int ai = 0; ai < 2; ++ai)
#pragma unroll
            for (int m = 0; m < 4; ++m) { bf16_t* rowp = O + (size_t)(row0 + ai * HALF + m * 16) * ldc + col0;
                const float rsv = rsu[ai * HALF + m * 16], cs = rsv * -1.4426950408889634f, is2 = inv_sq_scale(rsv);
                const f32x4 g0 = acc[ai][0][m][0], g1 = acc[ai][0][m][1], u0 = acc[ai][1][m][0], u1 = acc[ai][1][m][1];
                const f32x2 s0 = silu_mul2s((f32x2){g0[0], g0[1]}, (f32x2){u0[0], u0[1]}, cs, is2), s1 = silu_mul2s((f32x2){g0[2], g0[3]}, (f32x2){u0[2], u0[3]}, cs, is2), s2 = silu_mul2s((f32x2){g1[0], g1[1]}, (f32x2){u1[0], u1[1]}, cs, is2), s3 = silu_mul2s((f32x2){g1[2], g1[3]}, (f32x2){u1[2], u1[3]}, cs, is2);
                u32x4 w; w.x = cvt_pk_bf16(s0.x, s0.y); w.y = cvt_pk_bf16(s1.x, s1.y); w.z = cvt_pk_bf16(s2.x, s2.y); w.w = cvt_pk_bf16(s3.x, s3.y);
                epi_st16(rowp, w, nt); }
    }
};
struct EpiSwiGLU8 {
    static constexpr bool PERM = true, AFTER_DRAIN = false;
    unsigned char* O; int ldc; const PG8_LAS float* rs;
    __device__ __forceinline__ void operator()(const f32x4 (&acc)[2][2][4][2], const Unit& u, int wr, int wc, int fr, int fq, const bool nt) const {
        const int row0 = u.pm * BM + wr * 64 + fr; const int col0 = u.pn * HALF + wc * 32 + 8 * fq;
        const PG8_LAS float* rsu = rs + u.ord * 256 + wr * 64 + fr;
#pragma unroll
        for (int ai = 0; ai < 2; ++ai)
#pragma unroll
            for (int m = 0; m < 4; ++m) { unsigned char* rowp = O + (size_t)(row0 + ai * HALF + m * 16) * ldc + col0;
                const float rsv = rsu[ai * HALF + m * 16], cs = rsv * -1.4426950408889634f, is2 = inv_sq_scale(rsv);
                const f32x4 g0 = acc[ai][0][m][0], g1 = acc[ai][0][m][1], u0 = acc[ai][1][m][0], u1 = acc[ai][1][m][1];
                const f32x2 s0 = silu_mul2s((f32x2){g0[0], g0[1]}, (f32x2){u0[0], u0[1]}, cs, is2), s1 = silu_mul2s((f32x2){g0[2], g0[3]}, (f32x2){u0[2], u0[3]}, cs, is2), s2 = silu_mul2s((f32x2){g1[0], g1[1]}, (f32x2){u1[0], u1[1]}, cs, is2), s3 = silu_mul2s((f32x2){g1[2], g1[3]}, (f32x2){u1[2], u1[3]}, cs, is2);
                int w0 = __builtin_bit_cast(int, s0.x), w1 = __builtin_bit_cast(int, s2.x);
                w0 = __builtin_amdgcn_cvt_pk_fp8_f32(s0.x, s0.y, w0, false); w0 = __builtin_amdgcn_cvt_pk_fp8_f32(s1.x, s1.y, w0, true);
                w1 = __builtin_amdgcn_cvt_pk_fp8_f32(s2.x, s2.y, w1, false); w1 = __builtin_amdgcn_cvt_pk_fp8_f32(s3.x, s3.y, w1, true);
                epi_st8(rowp, (unsigned long long)(unsigned)w0 | ((unsigned long long)(unsigned)w1 << 32), nt); }
    }
};
struct EpiResAddNorm {
    static constexpr bool PERM = true, AFTER_DRAIN = false;
    bf16_t* xr; int ldc; float* rss; unsigned char* X8; float asc;
    __device__ __forceinline__ void operator()(const f32x4 (&acc)[2][2][4][2], const Unit& u, int wr, int wc, int fr, int fq, const bool nt) const {
        const int col0 = u.pn * BM + wc * 32 + 8 * fq;
#pragma unroll
        for (int ai = 0; ai < 2; ++ai)
#pragma unroll
            for (int m = 0; m < 4; ++m) { const int row = u.pm * BM + ai * HALF + wr * 64 + m * 16 + fr; const size_t off = (size_t)row * ldc + col0; float ss = 0.f;
#pragma unroll
                for (int bj = 0; bj < 2; ++bj) {
                    const u32x4 q = *(const u32x4*)(xr + off + bj * HALF);
                    const f32x4 b0 = (f32x4){__builtin_bit_cast(float, q.x << 16), __builtin_bit_cast(float, q.x & 0xffff0000u), __builtin_bit_cast(float, q.y << 16), __builtin_bit_cast(float, q.y & 0xffff0000u)};
                    const f32x4 b1 = (f32x4){__builtin_bit_cast(float, q.z << 16), __builtin_bit_cast(float, q.z & 0xffff0000u), __builtin_bit_cast(float, q.w << 16), __builtin_bit_cast(float, q.w & 0xffff0000u)};
                    const f32x4 v0 = b0 + acc[ai][bj][m][0] * asc, v1 = b1 + acc[ai][bj][m][1] * asc;
                    { u32x4 w; w.x = cvt_pk_bf16(v0[0], v0[1]); w.y = cvt_pk_bf16(v0[2], v0[3]); w.z = cvt_pk_bf16(v1[0], v1[1]); w.w = cvt_pk_bf16(v1[2], v1[3]); epi_st16(xr + off + bj * HALF, w, nt); }
                    ss += (v0[0] * v0[0] + v0[1] * v0[1]) + (v0[2] * v0[2] + v0[3] * v0[3]) + (v1[0] * v1[0] + v1[1] * v1[1]) + (v1[2] * v1[2] + v1[3] * v1[3]);
                    if (X8) { int q0 = 0, q1 = 0;
                        q0 = __builtin_amdgcn_cvt_pk_fp8_f32(v0[0], v0[1], q0, false); q0 = __builtin_amdgcn_cvt_pk_fp8_f32(v0[2], v0[3], q0, true);
                        q1 = __builtin_amdgcn_cvt_pk_fp8_f32(v1[0], v1[1], q1, false); q1 = __builtin_amdgcn_cvt_pk_fp8_f32(v1[2], v1[3], q1, true);
                        epi_st8(X8 + off + bj * HALF, (unsigned long long)(unsigned)q0 | ((unsigned long long)(unsigned)q1 << 32), nt); } }
                ss += __shfl_xor(ss, 16); ss += __shfl_xor(ss, 32);
                if (fq == 0) rss[(size_t)row * 16 + u.pn * 4 + wc] = ss; }
    }
};
struct EpiRowScaleBf16 {
    static constexpr bool PERM = true, AFTER_DRAIN = false;
    bf16_t* O; int ldc; const PG8_LAS float* rs;
    __device__ __forceinline__ void operator()(const f32x4 (&acc)[2][2][4][2], const Unit& u, int wr, int wc, int fr, int fq, const bool nt) const {
        const int row0 = u.pm * BM + wr * 64 + fr; const int col0 = u.pn * BM + wc * 32 + 8 * fq;
        const PG8_LAS float* rsu = rs + u.ord * 256 + wr * 64 + fr;
#pragma unroll
        for (int ai = 0; ai < 2; ++ai)
#pragma unroll
            for (int m = 0; m < 4; ++m) { const int row = row0 + ai * HALF + m * 16; const float sc = rsu[ai * HALF + m * 16]; bf16_t* rowp = O + u.ooff + (long)row * ldc + col0;
#pragma unroll
                for (int bj = 0; bj < 2; ++bj) { f32x4 v0 = acc[ai][bj][m][0] * sc, v1 = acc[ai][bj][m][1] * sc;
                    u32x4 w; w.x = cvt_pk_bf16(v0[0], v0[1]); w.y = cvt_pk_bf16(v0[2], v0[3]); w.z = cvt_pk_bf16(v1[0], v1[1]); w.w = cvt_pk_bf16(v1[2], v1[3]);
                    epi_st16(rowp + bj * HALF, w, nt); } }
    }
};
template <bool GATHER_> struct GroupedOrder {
    static constexpr bool GATHER = GATHER_;
    int nM, nN, nwg, G, c, WGM; const PG8_LAS int* pan; const PG8_LAS unsigned short* tok; long estride;
    __device__ void init(int nM_, int nN_, int G_, int c_, const PG8_LAS int* pan_, const PG8_LAS unsigned short* tok_, long estride_, int wgm = 4) { nM = nM_; nN = nN_; nwg = nM * nN; G = G_; c = c_; pan = pan_; tok = tok_; estride = estride_; WGM = wgm; }
    __device__ bool next(int i, Unit& u) const {
        const long L = (long)i * G + c; if (L >= nwg) return false;
        int wgid = (int)L; { const int q = nwg / NXCD, r = nwg % NXCD, xcd = wgid % NXCD, off = wgid / NXCD; wgid = (xcd < r ? xcd * (q + 1) : r * (q + 1) + (xcd - r) * q) + off; }
        const int nig = WGM * nN, gid = wgid / nig, fm = gid * WGM, gsz = (nM - fm) < WGM ? (nM - fm) : WGM;
        u.pm = fm + ((wgid % nig) % gsz); u.pn = (wgid % nig) / gsz;
        const int pe = __builtin_amdgcn_readfirstlane(pan[u.pm]); const int e = pe & 255, j = (pe >> 8) & 255;
        u.boff = (long)e * estride; u.ord = i; u.arow0 = e * 16384 + 256 * j; u.avalid = ((pe >> 16) & 255) + 1; u.aoff = 0; u.ooff = 0; return true;
    }
    __device__ __forceinline__ int arow(const Unit& u, int r) const { return (int)tok[u.ord * 256 + r]; }
    __device__ __forceinline__ void a_ready(const Unit&) const {}
    __device__ __forceinline__ void done(const Unit&) const {}
};
struct TailOrder {
    static constexpr bool GATHER = false;
    int ntail, G, c; const PG8_LAS int* pan; long estride; int es;
    __device__ void init(int P, int G_, int c_, const PG8_LAS int* pan_, long estride_, int es_) { ntail = (P - 128) * 4 * 7; G = G_; c = c_; pan = pan_; estride = estride_; es = es_; }
    __device__ bool next(int i, Unit& u) const {
        const int L = i * G + c; if (L >= ntail) return false;
        const int s = L % 7, t = L / 7; u.pn = t & 3; u.pm = 128 + (t >> 2);
        const int pe = __builtin_amdgcn_readfirstlane(pan[u.pm]); const int e = pe & 255, j = (pe >> 8) & 255;
        u.aoff = (long)s * 512 * es; u.boff = (long)e * estride + (long)s * 512 * es; u.ord = i; u.arow0 = e * 16384 + 256 * j; u.avalid = ((pe >> 16) & 255) + 1;
        u.ooff = ((long)s * 2048 - 32768) * 1024; return true;
    }
    __device__ __forceinline__ int arow(const Unit&, int r) const { return r; }
    __device__ __forceinline__ void a_ready(const Unit&) const {}
    __device__ __forceinline__ void done(const Unit&) const {}
};
template <int MODE, class Sched> __device__ __forceinline__ void fill_rs(PG8_LAS float* tab, const Sched& S, const float* src, int tid, const float mul = 1.f) {
    for (int idx = tid;; idx += 512) { Unit u; if (!S.next(idx >> 8, u)) break;
        const int row = u.pm * BM + (idx & 255);
        tab[idx] = ((MODE == 1) ? rstd_of(src, row) : src[row]) * mul; }
    asm volatile("s_waitcnt lgkmcnt(0)" ::: "memory"); __syncthreads();
}
template <class Sched> __device__ __forceinline__ void fill_grouped(PG8_LAS float* tab, PG8_LAS unsigned short* tok, const Sched& S, const float* srcv, const int* tokv, int tid, const float mul = 1.f) {
    for (int idx = tid;; idx += 512) { Unit u; if (!S.next(idx >> 8, u)) break;
        const int r = idx & 255; const bool v = r < u.avalid;
        tab[idx] = v ? srcv[u.arow0 + r] * mul : 0.f;
        if (tok) tok[idx] = (unsigned short)(v ? tokv[u.arow0 + r] : 0); }
    asm volatile("s_waitcnt lgkmcnt(0)" ::: "memory"); __syncthreads();
}

template <class Epi, class Sched, bool ALIGN_EPI = false, bool SP2 = false, int ES = 2>
__device__ __forceinline__ void gemm_phase(PG8_LAS unsigned char* lds, const Gemm g, const Sched& S, const Epi& E) {
    const int tid = threadIdx.x, wid = __builtin_amdgcn_readfirstlane(tid >> 6), lane = tid & 63, wr = wid >> 2, wc = wid & 3, fr = lane & 15, fq = lane >> 4;
    const int PBy = g.ld * ES, nt = g.K * ES / 128;
    unsigned voffA0[2], voffA1[2], voffB[2];
    const size_t kstep = (size_t)(BK * 2);
    const size_t hstep = (size_t)HALF * PBy;
#pragma unroll
    for (int i = 0; i < 2; ++i) { int R, C; stage_rc(tid * 16 + i * 8192, R, C); const int Rb = Epi::PERM ? ((R & ~31) + perm32(R & 31)) : R;
        voffA0[i] = (unsigned)(R * PBy + C * 2); voffA1[i] = voffA0[i] + (unsigned)hstep; voffB[i] = (unsigned)(Rb * PBy + C * 2); }
#define PG8_SETA(u_) do { if constexpr (Sched::GATHER) { _Pragma("unroll") for (int i_ = 0; i_ < 2; ++i_) { int R_, C_; stage_rc(tid * 16 + i_ * 8192, R_, C_); \
        voffA0[i_] = (unsigned)(S.arow(u_, R_) * PBy + C_ * 2); voffA1[i_] = (unsigned)(S.arow(u_, R_ + HALF) * PBy + C_ * 2); } } } while (0)
    const size_t tstep = 2 * hstep;
    const unsigned ldsw = (unsigned)wid * 1024u;
    const int aoff = lds_byte(wr * 64 + fr, fq * 8), boff = lds_byte(wc * 32 + fr, fq * 8);
#define PG8_SA(b, h) (((b) * 2 + (h)) * HTB)
#define PG8_SB(b, h) ((4 + (b) * 2 + (h)) * HTB)
#define PG8_STAGE(bufoff, gbase, voff) do { _Pragma("unroll") for (int _i = 0; _i < 2; ++_i) \
        __builtin_amdgcn_global_load_lds((const unsigned*)((const char*)(gbase) + (voff)[_i]), (PG8_LAS unsigned*)(lds + (bufoff) + ldsw + _i * 8192), 16, 0, 0); } while (0)
#define PG8_LD8(p_) ({ const u32x4 lo_ = *(const PG8_LAS u32x4*)(p_), hi_ = *(const PG8_LAS u32x4*)((p_) + 1024); (i32x8){(int)lo_.x, (int)lo_.y, (int)lo_.z, (int)lo_.w, (int)hi_.x, (int)hi_.y, (int)hi_.z, (int)hi_.w}; })
#define PG8_LDA(dst, b, h) do { if constexpr (ES == 2) { _Pragma("unroll") for (int m = 0; m < 4; ++m) _Pragma("unroll") for (int k = 0; k < 2; ++k) dst[m][k] = *(const PG8_LAS bf16x8*)(lds + PG8_SA(b, h) + aoff + m * 2048 + k * 1024); } \
        else { _Pragma("unroll") for (int m = 0; m < 4; ++m) dst##8[m] = PG8_LD8(lds + PG8_SA(b, h) + aoff + m * 2048); } } while (0)
#define PG8_LDB(dst, b, h) do { if constexpr (ES == 2) { _Pragma("unroll") for (int n = 0; n < 2; ++n) _Pragma("unroll") for (int k = 0; k < 2; ++k) dst[n][k] = *(const PG8_LAS bf16x8*)(lds + PG8_SB(b, h) + boff + n * 2048 + k * 1024); } \
        else { _Pragma("unroll") for (int n = 0; n < 2; ++n) dst##8[n] = PG8_LD8(lds + PG8_SB(b, h) + boff + n * 2048); } } while (0)
#define PG8_MMA(ai, bj, At, Bt) do { __builtin_amdgcn_s_setprio(1); _Pragma("unroll") for (int m = 0; m < 4; ++m) _Pragma("unroll") for (int n = 0; n < 2; ++n) { \
        if constexpr (ES == 2) { _Pragma("unroll") for (int k = 0; k < 2; ++k) acc[ai][bj][m][n] = __builtin_amdgcn_mfma_f32_16x16x32_bf16(Bt[n][k], At[m][k], acc[ai][bj][m][n], 0, 0, 0); } \
        else asm volatile("v_mfma_scale_f32_16x16x128_f8f6f4 %0, %1, %2, %0, %3, %3 op_sel_hi:[0,0,0]" : "+v"(acc[ai][bj][m][n]) : "v"(Bt##8[n]), "v"(At##8[m]), "v"(0x7F7F7F7F)); } \
        __builtin_amdgcn_s_setprio(0); } while (0)
#define PG8_WAIT_V(n) asm volatile("s_waitcnt vmcnt(" #n ")" ::: "memory")
#define PG8_WAIT_L(n) asm volatile("s_waitcnt lgkmcnt(" #n ")" ::: "memory")
#define PG8_BAR __builtin_amdgcn_s_barrier()
#define PG8_SCHED __builtin_amdgcn_sched_barrier(0)
    Unit cur, nxt; int ui = 0;
    if (!S.next(0, cur)) return;
    f32x4 acc[2][2][4][2];
#pragma unroll
    for (int a = 0; a < 2; ++a)
#pragma unroll
        for (int b = 0; b < 2; ++b)
#pragma unroll
            for (int m = 0; m < 4; ++m)
#pragma unroll
                for (int n = 0; n < 2; ++n) acc[a][b][m][n] = (f32x4){0.f, 0.f, 0.f, 0.f};
    bf16x8 At[4][2], B0[2][2], B1[2][2]; i32x8 At8[4], B08[2], B18[2];
    const char* cA = (const char*)g.A + (Sched::GATHER ? (size_t)0 : (size_t)cur.pm * tstep) + cur.aoff; const char* cB = (const char*)g.Bt + (size_t)cur.pn * tstep + cur.boff;
    S.a_ready(cur);
    static_assert(SP2, "only the two-super-phase loop is kept in this file");
    PG8_SETA(cur);
    {
        PG8_STAGE(PG8_SB(0, 0), cB, voffB); PG8_STAGE(PG8_SB(0, 1), cB + hstep, voffB); PG8_STAGE(PG8_SA(0, 0), cA, voffA0); PG8_STAGE(PG8_SA(0, 1), cA, voffA1);
        if (wr == 1) PG8_BAR;
        PG8_WAIT_V(2); PG8_BAR;
        PG8_STAGE(PG8_SB(1, 0), cB + kstep, voffB); PG8_STAGE(PG8_SA(1, 0), cA + kstep, voffA0); PG8_STAGE(PG8_SB(1, 1), cB + hstep + kstep, voffB);
        PG8_WAIT_V(6); PG8_BAR;
    }
    for (;;) {
        const bool has_next = S.next(ui + 1, nxt);
        const char* nA = has_next ? (const char*)g.A + (Sched::GATHER ? (size_t)0 : (size_t)nxt.pm * tstep) + nxt.aoff : cA; const char* nB = has_next ? (const char*)g.Bt + (size_t)nxt.pn * tstep + nxt.boff : cB;
        for (int t = 0; t < nt; t += 2) {
            const bool last = (t == nt - 2);
            const char* a1 = cA + (size_t)(t + 1) * kstep;
            const char* a2 = last ? nA : cA + (size_t)(t + 2) * kstep; const char* b2 = last ? nB : cB + (size_t)(t + 2) * kstep;
            const char* a3 = a2 + kstep; const char* b3 = b2 + kstep;
            if (last && has_next) S.a_ready(nxt);
            {
            PG8_LDB(B0, 0, 0); PG8_LDB(B1, 0, 1); PG8_SCHED; PG8_LDA(At, 0, 0); PG8_STAGE(PG8_SA(1, 1), a1, voffA1);
            if (last && has_next) PG8_SETA(nxt);
            PG8_WAIT_V(8); PG8_WAIT_L(0); PG8_BAR; PG8_MMA(0, 0, At, B0); PG8_MMA(0, 1, At, B1); PG8_BAR; PG8_SCHED;
            PG8_LDA(At, 0, 1); PG8_STAGE(PG8_SB(0, 0), b2, voffB); PG8_STAGE(PG8_SB(0, 1), b2 + hstep, voffB); PG8_STAGE(PG8_SA(0, 0), a2, voffA0);
            PG8_WAIT_V(8); PG8_WAIT_L(0); PG8_BAR; PG8_MMA(1, 0, At, B0); PG8_MMA(1, 1, At, B1); PG8_BAR; PG8_SCHED;
            PG8_LDB(B0, 1, 0); PG8_LDB(B1, 1, 1); PG8_SCHED; PG8_LDA(At, 1, 0); PG8_STAGE(PG8_SA(0, 1), a2, voffA1);
            PG8_WAIT_V(8); PG8_WAIT_L(0); PG8_BAR; PG8_MMA(0, 0, At, B0); PG8_MMA(0, 1, At, B1); PG8_BAR; PG8_SCHED;
            PG8_LDA(At, 1, 1); PG8_STAGE(PG8_SB(1, 0), b3, voffB); PG8_STAGE(PG8_SB(1, 1), b3 + hstep, voffB); PG8_STAGE(PG8_SA(1, 0), a3, voffA0);
            PG8_WAIT_V(8); PG8_WAIT_L(0); PG8_BAR; PG8_MMA(1, 0, At, B0); PG8_MMA(1, 1, At, B1); PG8_BAR; PG8_SCHED;
            }
        }
        if constexpr (ALIGN_EPI) { if (wr == 0) PG8_BAR; }
        if constexpr (ES == 1) asm volatile("s_nop 15\n\ts_nop 15\n\ts_nop 15" ::: "memory");
        if constexpr (!Epi::AFTER_DRAIN) { E(acc, cur, wr, wc, fr, fq, !has_next); S.done(cur); }
        if (!has_next) break;
#pragma unroll
        for (int a = 0; a < 2; ++a)
#pragma unroll
            for (int b = 0; b < 2; ++b)
#pragma unroll
                for (int m = 0; m < 4; ++m)
#pragma unroll
                    for (int n = 0; n < 2; ++n) acc[a][b][m][n] = (f32x4){0.f, 0.f, 0.f, 0.f};
        cur = nxt; cA = nA; cB = nB; ++ui;
        if constexpr (ALIGN_EPI) { if (wr == 1) PG8_BAR; }
    }
    PG8_WAIT_V(0);
    if constexpr (!ALIGN_EPI) { if (wr == 0) PG8_BAR; }
    PG8_BAR;
    if constexpr (Epi::AFTER_DRAIN) { E.fused(acc, cur, wr, wc, fr, fq, lds, wid, lane); S.done(cur); }
#undef PG8_SA
#undef PG8_SB
#undef PG8_STAGE
#undef PG8_SETA
#undef PG8_LDA
#undef PG8_LDB
#undef PG8_MMA
#undef PG8_LD8
#undef PG8_WAIT_V
#undef PG8_WAIT_L
#undef PG8_BAR
#undef PG8_SCHED
}
}

#define GAS __attribute__((address_space(1)))
#define LAS __attribute__((address_space(3)))
typedef unsigned short bf16;
typedef unsigned v4u __attribute__((ext_vector_type(4)));
typedef float f32x4 __attribute__((ext_vector_type(4)));
typedef short bf16x8 __attribute__((ext_vector_type(8)));
typedef GAS unsigned gu32;
typedef GAS unsigned long long gu64;
#define RLX_AGENT __ATOMIC_RELAXED, __HIP_MEMORY_SCOPE_AGENT
#define LDS_WAIT() asm volatile("s_waitcnt lgkmcnt(0)" ::: "memory")
#define VM_WAIT() asm volatile("s_waitcnt vmcnt(0)" ::: "memory")
__device__ __forceinline__ unsigned long long rt() { return __builtin_amdgcn_s_memrealtime(); }
__device__ __forceinline__ unsigned f2bf(float f) { unsigned u = __builtin_bit_cast(unsigned, f); return (u + 0x7fffu + ((u >> 16) & 1u)) >> 16; }
__device__ __forceinline__ unsigned pk2(float lo, float hi) { return f2bf(lo) | (f2bf(hi) << 16); }

#define XB_TMO      128
#define XB_XCNT(j)  (256  + 64 * (j))
#define XB_XSUB(j)  (1280 + 64 * (j))
#define XB_XGEN(j)  (2304 + 64 * (j))
#define XB_TOP      3328
#define XB_TOPGEN   3392
#define XCD_BAR_WORDS 3456
#define XB_SPIN_CAP (1u << 18)

__device__ __forceinline__ unsigned xb_ld(unsigned* p)              { return __hip_atomic_load(p, __ATOMIC_RELAXED, __HIP_MEMORY_SCOPE_AGENT); }
__device__ __forceinline__ unsigned xb_add(unsigned* p, unsigned v) { return __hip_atomic_fetch_add(p, v, __ATOMIC_RELAXED, __HIP_MEMORY_SCOPE_AGENT); }
__device__ __forceinline__ unsigned xb_xcc_id() { return (unsigned)__builtin_amdgcn_s_getreg((3 << 11) | 20) & 0xFu; }
#define XB_SPIN(cond, bar) do { unsigned _sp = 0; while (cond) { __builtin_amdgcn_s_sleep(1); \
    if ((++_sp & 255u) == 0u) { if (xb_ld(&(bar)[XB_TMO])) break; if (_sp > XB_SPIN_CAP) { atomicAdd(&(bar)[XB_TMO], 1u); break; } } } } while (0)

struct XcdBarrier {
    unsigned* bar; unsigned x;
    volatile LAS unsigned* st;
};

__device__ __forceinline__ XcdBarrier xcd_barrier_post(unsigned* bar, volatile LAS unsigned* st) {
    XcdBarrier b; b.bar = bar; b.x = xb_xcc_id(); b.st = st;
    if (threadIdx.x == 0) (void)xb_add(&bar[XB_XCNT(b.x)], 1u);
    return b;
}
__device__ __forceinline__ void xcd_barrier_complete(unsigned* bar, unsigned x, unsigned& nloc, unsigned& nx) {
    const unsigned G = gridDim.x * gridDim.y * gridDim.z;
    unsigned sum, cnt, mine, sp = 0u;
    for (;;) {
        sum = 0u; cnt = 0u; mine = 0u;
#pragma unroll
        for (unsigned j = 0; j < 16; ++j) { const unsigned c = xb_ld(&bar[XB_XCNT(j)]); sum += c; cnt += (c > 0u) ? 1u : 0u; mine = (j == x) ? c : mine; }
        if (sum == G) break;
        __builtin_amdgcn_s_sleep(1);
        if ((++sp & 255u) == 0u) { if (xb_ld(&bar[XB_TMO])) break; if (sp > XB_SPIN_CAP) { atomicAdd(&bar[XB_TMO], 1u); break; } }
    }
    nloc = mine > 0u ? mine : 1u; nx = cnt > 0u ? cnt : 1u;
}

__device__ __forceinline__ void xcd_barrier(const XcdBarrier& b) {
    asm volatile("s_waitcnt vmcnt(0)" ::: "memory");
    __syncthreads();
    if (threadIdx.x == 0) {
        unsigned* bar = b.bar;
        __builtin_amdgcn_s_waitcnt(0);
        unsigned nloc = b.st[0], nx = b.st[1];
        if (nloc == 0u) { xcd_barrier_complete(bar, b.x, nloc, nx); b.st[0] = nloc; b.st[1] = nx; }
        const unsigned old = xb_add(&bar[XB_XSUB(b.x)], 1u);
        const unsigned gen = old / nloc;
        if (old + 1u == (gen + 1u) * nloc) {
            __builtin_amdgcn_fence(__ATOMIC_RELEASE, "agent");
            asm volatile("s_waitcnt vmcnt(0)" ::: "memory");
            const unsigned og = xb_add(&bar[XB_TOP], 1u);
            const unsigned tg = og / nx;
            if (og + 1u == (tg + 1u) * nx) xb_add(&bar[XB_TOPGEN], 1u);
            else XB_SPIN(xb_ld(&bar[XB_TOPGEN]) == tg, bar);
            __builtin_amdgcn_fence(__ATOMIC_ACQUIRE, "agent");
            xb_add(&bar[XB_XGEN(b.x)], 1u);
            asm volatile("s_waitcnt vmcnt(0)" ::: "memory");
        } else {
            XB_SPIN(xb_ld(&bar[XB_XGEN(b.x)]) == gen, bar);
            __builtin_amdgcn_fence(__ATOMIC_ACQUIRE, "agent");
            asm volatile("s_waitcnt vmcnt(0)" ::: "memory");
        }
    }
    __syncthreads();
}

__device__ __forceinline__ void xcd_arrive(const XcdBarrier& b, unsigned* bar2) {
    asm volatile("s_waitcnt vmcnt(0)" ::: "memory");
    __syncthreads();
    if (threadIdx.x == 0) {
        __builtin_amdgcn_s_waitcnt(0);
        const unsigned nloc = b.st[0], nx = b.st[1];
        const unsigned old = xb_add(&bar2[XB_XSUB(b.x)], 1u);
        const unsigned gen = old / nloc;
        if (old + 1u == (gen + 1u) * nloc) {
            __builtin_amdgcn_fence(__ATOMIC_RELEASE, "agent");
            asm volatile("s_waitcnt vmcnt(0)" ::: "memory");
            const unsigned og = xb_add(&bar2[XB_TOP], 1u);
            const unsigned tg = og / nx;
            if (og + 1u == (tg + 1u) * nx) xb_add(&bar2[XB_TOPGEN], 1u);
        }
    }
}
__device__ __forceinline__ void xcd_wait(const XcdBarrier& b, unsigned* bar2, const unsigned g) {
    if (threadIdx.x == 0) {
        XB_SPIN(xb_ld(&bar2[XB_TOPGEN]) < g, b.bar);
        __builtin_amdgcn_fence(__ATOMIC_ACQUIRE, "agent");
        asm volatile("s_waitcnt vmcnt(0)" ::: "memory");
    }
    __syncthreads();
}

__device__ __forceinline__ float bf2f(bf16 v) { return __builtin_bit_cast(float, (unsigned)v << 16); }
__device__ __forceinline__ float bfbits2f(unsigned bits) { return __builtin_bit_cast(float, bits << 16); }

constexpr int NWAVES = 8;
constexpr int BATCH = 8, SEQ = 2048, DM = 1024, MT = BATCH * SEQ;
constexpr int DINP = 3080, NPROJ = 3072;
constexpr int OQ = 0, OK_ = 512, OV = 1024, OZ = 1536, OXBC = 2048;
constexpr int NH = 8, HD = 64, SSTATE = 128;
constexpr int DFF = 2816, DFFE = 3584, NE = 8;
constexpr int MOE_ROWS = 2 * MT + NE * 256;
constexpr float EPS = 1e-5f;
constexpr int NE_PRO = 5;
constexpr float WU_SCALE = 32.f;
constexpr float WD_SCALE = 64.f;

constexpr size_t MiB = 1u << 20;
constexpr size_t WS_CTL = 0, CTL_ZERO_BYTES = 1 * MiB;
constexpr size_t WS_DTRAW = 1 * MiB, WS_DTV = WS_DTRAW + 512 * 1024;
constexpr size_t WS_TOKE = 2 * MiB, WS_TOKR = WS_TOKE + 128 * 1024, WS_TOKG = WS_TOKR + 128 * 1024, WS_TOKP = WS_TOKG + 128 * 1024;
constexpr size_t WS_ROWG = 2 * MiB + 512 * 1024, WS_ROWS = WS_ROWG + 160 * 1024, WS_PTAB = 3 * MiB, WS_WDT = 3 * MiB + 64 * 1024;
constexpr size_t WS_RTOKV = 1 * MiB, WS_RGV = 1 * MiB + 512 * 1024, WS_RSV = 3 * MiB + 256 * 1024;
constexpr size_t WS_RSS = 424 * MiB;
constexpr size_t WS_R1 = 4 * MiB;
constexpr size_t WS_WIN = 116 * MiB, WS_WOUT = 128 * MiB, WS_WDGU = 132 * MiB, WS_WDD = 143 * MiB;
constexpr size_t WS_AO = 149 * MiB;
constexpr size_t WS_R2 = 116 * MiB;
constexpr size_t WS_R3 = 184 * MiB;
constexpr size_t WS_PROJ = WS_R3, WS_HB = WS_R3, WS_XN = 428 * MiB;
constexpr size_t WS_XBCC = 312 * MiB, WS_ATTRAW = 328 * MiB, WS_XR = 344 * MiB, WS_YRAW = 376 * MiB;
constexpr size_t WS_ST2 = 408 * MiB;
constexpr size_t WS_END = 460 * MiB;
static_assert(WS_R3 + (size_t)MOE_ROWS * DFFE * 2 <= WS_END && WS_R2 + (size_t)MOE_ROWS * DM * 2 <= WS_R3 && WS_WDD + (size_t)DM * DFF * 2 <= WS_AO, "ws map");
constexpr int CW_TMO = 0, CW_CODE = 1, CW_BAR = 4096, CW_BAR2 = 8192, CW_ECNT = 16384;

constexpr int RING_OFF = 0, RING_BYTES = 159744;
constexpr int LDSCTL_OFF = RING_BYTES, MISC_OFF = LDSCTL_OFF + 320;
constexpr int TOK_TAB_OFF = 131072 + 15360, PAN_TAB_OFF = TOK_TAB_OFF + 7680;
constexpr int RS_TAB_OFF = 131072;
constexpr int LDS_BYTES = 163840;

typedef const float* cfp;
struct Args { const float* in[20]; float* out; unsigned char* ws; int ph_lo, ph_hi; };
static_assert(sizeof(Args) == 184, "Args layout");

template <int CTRL, int RMASK> __device__ __forceinline__ float dpp_addf(float v) {
    return v + __builtin_bit_cast(float, __builtin_amdgcn_update_dpp(0, __builtin_bit_cast(int, v), CTRL, RMASK, 0xf, true)); }
__device__ __forceinline__ float half_sums(float x) { x = dpp_addf<0xB1, 0xf>(x); x = dpp_addf<0x4E, 0xf>(x); x = dpp_addf<0x141, 0xf>(x); x = dpp_addf<0x140, 0xf>(x); return dpp_addf<0x142, 0xa>(x); }
__device__ __forceinline__ float wave_sum(float v) {
    const float x = half_sums(v);
    return __builtin_bit_cast(float, __builtin_amdgcn_readlane(__builtin_bit_cast(int, x), 31)) + __builtin_bit_cast(float, __builtin_amdgcn_readlane(__builtin_bit_cast(int, x), 63));
}
__device__ __forceinline__ void transpose_item(const float* W, int ldw, bf16* WT, int K, int k0, int n0, int drow0, LAS unsigned char* scr, int lane, const float* gk = nullptr) {
    const int kq = lane >> 4, n4 = lane & 15;
    const float* src = W + (size_t)(k0 + 16 * kq) * ldw + n0 + 4 * n4;
    f32x4 v[16];
#pragma unroll
    for (int i = 0; i < 16; ++i) v[i] = __builtin_nontemporal_load((const GAS f32x4*)(src + (size_t)i * ldw));
    if (gk) {
#pragma unroll
        for (int i = 0; i < 16; ++i) v[i] = v[i] * gk[k0 + 16 * kq + i]; }
#pragma unroll
    for (int j = 0; j < 4; ++j) {
        v4u a, b;
        a.x = pk2(v[0][j], v[1][j]); a.y = pk2(v[2][j], v[3][j]); a.z = pk2(v[4][j], v[5][j]); a.w = pk2(v[6][j], v[7][j]);
        b.x = pk2(v[8][j], v[9][j]); b.y = pk2(v[10][j], v[11][j]); b.z = pk2(v[12][j], v[13][j]); b.w = pk2(v[14][j], v[15][j]);
        LAS unsigned char* p = scr + (4 * n4 + j) * 144 + kq * 32;
        *(LAS v4u*)p = a; *(LAS v4u*)(p + 16) = b; }
    LDS_WAIT(); asm volatile("" ::: "memory");
#pragma unroll
    for (int i = 0; i < 8; ++i) { const int n = 8 * i + (lane >> 3), c = lane & 7;
        __builtin_nontemporal_store(*(const LAS v4u*)(scr + n * 144 + c * 16), (GAS v4u*)(WT + (size_t)(drow0 + n) * K + k0 + 8 * c)); }
    LDS_WAIT(); asm volatile("" ::: "memory");
}
__device__ __forceinline__ void transpose_item8(const float* W, int ldw, unsigned char* WT, int K, int k0, int n0, int drow0, float scale, LAS unsigned char* scr, int lane, const float* gk = nullptr) {
    const int kq = lane >> 4, n4 = lane & 15;
    const float* src = W + (size_t)(k0 + 16 * kq) * ldw + n0 + 4 * n4;
    f32x4 v[16];
#pragma unroll
    for (int i = 0; i < 16; ++i) v[i] = __builtin_nontemporal_load((const GAS f32x4*)(src + (size_t)i * ldw)) * (gk ? scale * gk[k0 + 16 * kq + i] : scale);
#pragma unroll
    for (int j = 0; j < 4; ++j) { int w[4];
#pragma unroll
        for (int q = 0; q < 4; ++q) { w[q] = __builtin_amdgcn_cvt_pk_fp8_f32(v[4 * q][j], v[4 * q + 1][j], 0, false); w[q] = __builtin_amdgcn_cvt_pk_fp8_f32(v[4 * q + 2][j], v[4 * q + 3][j], w[q], true); }
        *(LAS v4u*)(scr + (4 * n4 + j) * 80 + kq * 16) = (v4u){(unsigned)w[0], (unsigned)w[1], (unsigned)w[2], (unsigned)w[3]}; }
    LDS_WAIT(); asm volatile("" ::: "memory");
#pragma unroll
    for (int i = 0; i < 4; ++i) { const int idx = lane + 64 * i, n = idx >> 2, c = idx & 3;
        __builtin_nontemporal_store(*(const LAS v4u*)(scr + n * 80 + c * 16), (GAS v4u*)(WT + (size_t)(drow0 + n) * K + k0 + 16 * c)); }
    LDS_WAIT(); asm volatile("" ::: "memory");
}
__device__ __forceinline__ void conv_plain(const float* W, int ldw, int K, int N, bf16* WT, int it, LAS unsigned char* scr, int lane, const float* gk = nullptr) {
    const int nblk = N / 64, kb = it / nblk, nb = it % nblk;
    transpose_item(W, ldw, WT, K, 64 * kb, 64 * nb, 64 * nb, scr, lane, gk);
}
__device__ __forceinline__ void conv_gu(const float* Wg, const float* Wu, int K, int F, bf16* WT, int it, LAS unsigned char* scr, int lane, const float* gk = nullptr) {
    const int nblk = F / 64, per = (K / 64) * nblk, half = it / per, r = it % per, kb = r / nblk, nb = r % nblk, f0 = 64 * nb;
    transpose_item(half ? Wu : Wg, F, WT, K, 64 * kb, f0, (f0 / 128) * 256 + half * 128 + (f0 % 128), scr, lane, gk);
}

__device__ __forceinline__ void xb_rows(const float* Xf, const float* g, bf16* XBo, float* rss, int gw, int NGW, int lane) {
    f32x4 gv[4];
#pragma unroll
    for (int j = 0; j < 4; ++j) gv[j] = *((const GAS f32x4*)g + lane + 64 * j);
    for (int m = gw; m < MT; m += NGW) {
        const GAS f32x4* xr = (const GAS f32x4*)(Xf + (size_t)m * DM) + lane;
        f32x4 v[4]; float s = 0.f;
#pragma unroll
        for (int j = 0; j < 4; ++j) { v[j] = xr[64 * j]; s += (v[j].x * v[j].x + v[j].y * v[j].y) + (v[j].z * v[j].z + v[j].w * v[j].w); }
        s = wave_sum(s);
        GAS unsigned long long* o8 = (GAS unsigned long long*)(XBo + (size_t)m * DM) + lane;
#pragma unroll
        for (int j = 0; j < 4; ++j) o8[64 * j] = (unsigned long long)pk2(v[j].x, v[j].y) | ((unsigned long long)pk2(v[j].z, v[j].w) << 32);
        if (lane < 16) rss[(size_t)m * 16 + lane] = lane ? 0.f : s;
    }
}
__device__ __forceinline__ void route_rows(const bf16* XBi, const float* gain, const float* rss, const LAS float* tab, LAS int* lcnt, int* toke, int* tokr, int* rtokv, float* rgv, float* rsv, gu32* ecnt, int gw, int NGW, int lane, int tid) {
    const f32x4 ga0 = *(const GAS f32x4*)(gain + 8 * lane), ga1 = *(const GAS f32x4*)(gain + 8 * lane + 4), gb0 = *(const GAS f32x4*)(gain + 512 + 8 * lane), gb1 = *(const GAS f32x4*)(gain + 512 + 8 * lane + 4);
    f32x4 rt[8][4];
#pragma unroll
    for (int q = 0; q < 8; ++q) { const LAS float* t = tab + q * 1024 + 8 * lane; rt[q][0] = *(const LAS f32x4*)t; rt[q][1] = *(const LAS f32x4*)(t + 4); rt[q][2] = *(const LAS f32x4*)(t + 512); rt[q][3] = *(const LAS f32x4*)(t + 516); }
    for (int m0 = 0; m0 < MT; m0 += 8 * NGW) {
        if (tid < 16) lcnt[tid] = 0;
        LDS_WAIT(); __syncthreads();
        int ee[8], ll[8]; float gg[8], rr[8];
#pragma unroll
        for (int r = 0; r < 8; ++r) { const int m = m0 + r * NGW + gw; ee[r] = -1; ll[r] = 0; gg[r] = 0.f; rr[r] = 0.f;
            if (m < MT) {
        const v4u u0 = *(const GAS v4u*)(XBi + (size_t)m * DM + 8 * lane), u1 = *(const GAS v4u*)(XBi + (size_t)m * DM + 512 + 8 * lane);
        const float h0[8] = {bfbits2f(u0.x & 0xffffu) * ga0.x, bfbits2f(u0.x >> 16) * ga0.y, bfbits2f(u0.y & 0xffffu) * ga0.z, bfbits2f(u0.y >> 16) * ga0.w, bfbits2f(u0.z & 0xffffu) * ga1.x, bfbits2f(u0.z >> 16) * ga1.y, bfbits2f(u0.w & 0xffffu) * ga1.z, bfbits2f(u0.w >> 16) * ga1.w};
        const float h1[8] = {bfbits2f(u1.x & 0xffffu) * gb0.x, bfbits2f(u1.x >> 16) * gb0.y, bfbits2f(u1.y & 0xffffu) * gb0.z, bfbits2f(u1.y >> 16) * gb0.w, bfbits2f(u1.z & 0xffffu) * gb1.x, bfbits2f(u1.z >> 16) * gb1.y, bfbits2f(u1.w & 0xffffu) * gb1.z, bfbits2f(u1.w >> 16) * gb1.w};
        float d[8];
#pragma unroll
        for (int q = 0; q < 8; ++q) { const f32x4 a0 = rt[q][0], a1 = rt[q][1], b0 = rt[q][2], b1 = rt[q][3];
            d[q] = ((h0[0] * a0.x + h0[1] * a0.y) + (h0[2] * a0.z + h0[3] * a0.w)) + ((h0[4] * a1.x + h0[5] * a1.y) + (h0[6] * a1.z + h0[7] * a1.w))
                 + ((h1[0] * b0.x + h1[1] * b0.y) + (h1[2] * b0.z + h1[3] * b0.w)) + ((h1[4] * b1.x + h1[5] * b1.y) + (h1[6] * b1.z + h1[7] * b1.w)); }
#pragma unroll
        for (int q = 0; q < 8; ++q) d[q] = wave_sum(d[q]);
        if (lane == 0) {
            const float rstd = pg8::rstd_of(rss, m);
            int e1 = 0; float v1 = d[0];
#pragma unroll
            for (int q = 1; q < 8; ++q) if (d[q] > v1) { v1 = d[q]; e1 = q; }
            int e2 = -1; float v2 = -3.0e38f;
#pragma unroll
            for (int q = 0; q < 8; ++q) if (q != e1 && d[q] > v2) { v2 = d[q]; e2 = q; }
            const int l1 = __hip_atomic_fetch_add(lcnt + e1, 1, __ATOMIC_RELAXED, __HIP_MEMORY_SCOPE_WORKGROUP), l2 = __hip_atomic_fetch_add(lcnt + e2, 1, __ATOMIC_RELAXED, __HIP_MEMORY_SCOPE_WORKGROUP);
            ee[r] = e1 | (e2 << 4); ll[r] = l1 | (l2 << 16); gg[r] = 1.f / (1.f + expf((v2 - v1) * rstd)); rr[r] = rstd;
        } } }
        LDS_WAIT(); __syncthreads();
        if (tid < 8) lcnt[8 + tid] = (int)__hip_atomic_fetch_add(ecnt + 64 * tid, (unsigned)lcnt[tid], RLX_AGENT);
        LDS_WAIT(); __syncthreads();
        if (lane == 0) {
#pragma unroll
            for (int r = 0; r < 8; ++r) if (ee[r] >= 0) { const int m = m0 + r * NGW + gw, e1 = ee[r] & 15, e2 = ee[r] >> 4, r1 = lcnt[8 + e1] + (ll[r] & 0xffff), r2 = lcnt[8 + e2] + (ll[r] >> 16);
                const float g1 = gg[r], g2 = 1.f - g1, rstd = rr[r];
                toke[2 * m] = e1; toke[2 * m + 1] = e2; tokr[2 * m] = r1; tokr[2 * m + 1] = r2;
                rtokv[e1 * 16384 + r1] = m; rtokv[e2 * 16384 + r2] = m; rgv[e1 * 16384 + r1] = g1; rgv[e2 * 16384 + r2] = g2; rsv[e1 * 16384 + r1] = rstd; rsv[e2 * 16384 + r2] = rstd; } }
        LDS_WAIT(); __syncthreads();
    }
}
__device__ __forceinline__ void load_tab8(const float* W, int ldw, LAS float* tab, int tid) {
    for (int i = tid; i < 8192; i += NWAVES * 64) { const int k = i >> 3, j = i & 7; tab[j * 1024 + k] = W[(size_t)k * ldw + j]; }
    LDS_WAIT(); __syncthreads();
}

namespace sba {
typedef float f32x16 __attribute__((ext_vector_type(16)));
typedef short v4i16_t __attribute__((ext_vector_type(4)));
__device__ __forceinline__ v4i16_t vtr(const LAS char* p) { return __builtin_amdgcn_ds_read_tr16_b64_v4i16((LAS v4i16_t*)p); }
typedef float f32x2_t __attribute__((ext_vector_type(2))); typedef __bf16 bf16x2_t __attribute__((ext_vector_type(2)));
__device__ __forceinline__ unsigned cvtpk(float lo, float hi) { f32x2_t v = {lo, hi}; bf16x2_t b = __builtin_convertvector(v, bf16x2_t); return __builtin_bit_cast(unsigned, b); }
__device__ __forceinline__ float hsum32(float v) { auto rr = __builtin_amdgcn_permlane32_swap(__float_as_uint(v), __float_as_uint(v), false, false); return __uint_as_float(rr[0]) + __uint_as_float(rr[1]); }
constexpr int ATT_LDS = 131072 + 4096;
constexpr float RSTOP = 104.f * 1.4426950408889634f;
__device__ __forceinline__ void glds16(const void* gsrc, unsigned lds_dst) { unsigned keep;
    asm volatile("s_mov_b32 %0, m0\n\ts_mov_b32 m0, %2\n\ts_nop 0\n\tglobal_load_lds_dwordx4 %1, off\n\ts_mov_b32 m0, %0" : "=&s"(keep) : "v"(gsrc), "s"(lds_dst) : "memory"); }

__device__ __forceinline__ void attn_unit(const int b, const int qt2, const bf16* __restrict__ P, const float* __restrict__ gattn, bf16* __restrict__ AOo, LAS unsigned char* lds, const int wave, const int lane, const int parity) {
    const int h = wave, r32 = lane & 31, hi = lane >> 5;
    LAS char* vl = (LAS char*)lds + wave * 16384;
    LAS float* red = (LAS float*)(lds + 131072) + parity * 512;
    const size_t row0 = (size_t)b * SEQ;
    bf16x8 qa[4], qb[4];
#pragma unroll
    for (int ks = 0; ks < 4; ++ks) { qa[ks] = *(const bf16x8*)(P + (row0 + 64 * qt2 + r32) * NPROJ + OQ + h * 64 + 16 * ks + 8 * hi); qb[ks] = *(const bf16x8*)(P + (row0 + 64 * qt2 + 32 + r32) * NPROJ + OQ + h * 64 + 16 * ks + 8 * hi); }
    f32x16 oa0, oa1, ob0, ob1;
#pragma unroll
    for (int r = 0; r < 16; ++r) { oa0[r] = 0.f; oa1[r] = 0.f; ob0[r] = 0.f; ob1[r] = 0.f; }
    float Ra = 1.f, Rb = 1.f;
    const int grp = lane >> 4, i16 = lane & 15;
    const LAS char* vrd = vl + 4096 + (4 * (grp >> 1) + (i16 >> 2)) * 128 + (16 * (grp & 1) + 4 * (i16 & 3)) * 2;
    const LAS char* krd = vl + r32 * 128;
    const unsigned vdma = (unsigned)__builtin_amdgcn_readfirstlane((int)(unsigned)(uintptr_t)vl);
    const bf16* ksrc = P + (row0 + (lane >> 3)) * NPROJ + OK_ + h * 64 + (((lane & 7) ^ ((lane >> 3) & 7)) * 8);
    const bf16* vsrc = P + (row0 + (lane >> 3)) * NPROJ + OV + h * 64 + (lane & 7) * 8;
#define SBA_ISSUE(SLOT, kt_) do { const size_t ko_ = (size_t)(kt_) * 32 * NPROJ; \
        _Pragma("unroll") for (int i = 0; i < 4; ++i) glds16(ksrc + ko_ + (size_t)(8 * i) * NPROJ, vdma + (SLOT) * 8192 + i * 1024); \
        _Pragma("unroll") for (int i = 0; i < 4; ++i) glds16(vsrc + ko_ + (size_t)(8 * i) * NPROJ, vdma + (SLOT) * 8192 + 4096 + i * 1024); } while (0)
#define SBA_BLOCK(QR, O0, O1, R, DIAG) do { \
        f32x16 p; \
        _Pragma("unroll") for (int r = 0; r < 16; ++r) p[r] = 0.f; \
        _Pragma("unroll") for (int ks = 0; ks < 4; ++ks) p = __builtin_amdgcn_mfma_f32_32x32x16_bf16(kf[ks], QR[ks], p, 0, 0, 0); \
        if (DIAG) { _Pragma("unroll") for (int r = 0; r < 16; ++r) { const int kl = (r & 3) + 8 * (r >> 2) + 4 * hi; if (kl >= r32) p[r] = -1.0e30f; } } \
        float sg[16], qn[16], G[4], PG[4];                       \
        _Pragma("unroll") for (int r = 0; r < 16; ++r) { const float e = __builtin_amdgcn_exp2f(fminf(p[r], 126.f)); const float qq = __builtin_amdgcn_rcpf(1.f + e); qn[r] = qq; sg[r] = e * qq; } \
        _Pragma("unroll") for (int g = 0; g < 4; ++g) { G[g] = (qn[4 * g] * qn[4 * g + 1]) * (qn[4 * g + 2] * qn[4 * g + 3]); \
            auto rr_ = __builtin_amdgcn_permlane32_swap(__float_as_uint(G[g]), __float_as_uint(G[g]), false, false); PG[g] = __uint_as_float(hi ? rr_[0] : rr_[1]); }     \
        float base[4]; \
        { float acc = R; \
          _Pragma("unroll") for (int g = 3; g >= 0; --g) { base[g] = hi == 0 ? acc * PG[g] : acc; acc *= G[g] * PG[g]; } \
          R = acc; } \
        float w[16]; \
        _Pragma("unroll") for (int g = 0; g < 4; ++g) { float lat = base[g]; \
            _Pragma("unroll") for (int i = 3; i >= 0; --i) { const int r = 4 * g + i; w[r] = sg[r] * lat; lat *= qn[r]; } } \
        v4u pb0, pb1; \
        pb0.x = cvtpk(w[0], w[1]); pb0.y = cvtpk(w[2], w[3]); pb0.z = cvtpk(w[4], w[5]); pb0.w = cvtpk(w[6], w[7]); \
        pb1.x = cvtpk(w[8], w[9]); pb1.y = cvtpk(w[10], w[11]); pb1.z = cvtpk(w[12], w[13]); pb1.w = cvtpk(w[14], w[15]); \
        const bf16x8 b0 = __builtin_bit_cast(bf16x8, pb0), b1 = __builtin_bit_cast(bf16x8, pb1); \
        O0 = __builtin_amdgcn_mfma_f32_32x32x16_bf16(vf00, b0, O0, 0, 0, 0); O0 = __builtin_amdgcn_mfma_f32_32x32x16_bf16(vf01, b1, O0, 0, 0, 0); \
        O1 = __builtin_amdgcn_mfma_f32_32x32x16_bf16(vf10, b0, O1, 0, 0, 0); O1 = __builtin_amdgcn_mfma_f32_32x32x16_bf16(vf11, b1, O1, 0, 0, 0); \
    } while (0)
#define SBA_TILE(SLOT, kt_) do { \
        if ((kt_) >= 1) asm volatile("s_waitcnt vmcnt(8)" ::: "memory"); else asm volatile("s_waitcnt vmcnt(0)" ::: "memory");     \
        bf16x8 kf[4]; \
        _Pragma("unroll") for (int ks = 0; ks < 4; ++ks) kf[ks] = *(const LAS bf16x8*)(krd + (SLOT) * 8192 + (((2 * ks + hi) ^ (r32 & 7)) * 16)); \
        const LAS char* vr_ = vrd + (SLOT) * 8192; \
        const v4i16_t a00 = vtr(vr_), a01 = vtr(vr_ + 8 * 128), a02 = vtr(vr_ + 16 * 128), a03 = vtr(vr_ + 24 * 128); \
        const v4i16_t a10 = vtr(vr_ + 64), a11 = vtr(vr_ + 8 * 128 + 64), a12 = vtr(vr_ + 16 * 128 + 64), a13 = vtr(vr_ + 24 * 128 + 64); \
        asm volatile("s_waitcnt lgkmcnt(0)" ::: "memory");      \
        if ((kt_) >= 2) SBA_ISSUE(SLOT, (kt_) - 2); \
        const bf16x8 vf00 = {a00[0], a00[1], a00[2], a00[3], a01[0], a01[1], a01[2], a01[3]}, vf01 = {a02[0], a02[1], a02[2], a02[3], a03[0], a03[1], a03[2], a03[3]}; \
        const bf16x8 vf10 = {a10[0], a10[1], a10[2], a10[3], a11[0], a11[1], a11[2], a11[3]}, vf11 = {a12[0], a12[1], a12[2], a12[3], a13[0], a13[1], a13[2], a13[3]}; \
        if (!doneB) { SBA_BLOCK(qb, ob0, ob1, Rb, (kt_) == 2 * qt2 + 1); doneB = __all(Rb == 0.f); } \
        if ((kt_) <= 2 * qt2 && !doneA) { SBA_BLOCK(qa, oa0, oa1, Ra, (kt_) == 2 * qt2); doneA = __all(Ra == 0.f); } \
    } while (0)
    SBA_ISSUE(0, 2 * qt2 + 1); SBA_ISSUE(1, 2 * qt2);
    asm volatile("" : "+v"(qa[0]), "+v"(qa[1]), "+v"(qa[2]), "+v"(qa[3]), "+v"(qb[0]), "+v"(qb[1]), "+v"(qb[2]), "+v"(qb[3]));
    bool doneA = false, doneB = false;
    for (int kt = 2 * qt2 + 1;;) {
        SBA_TILE(0, kt); if (kt == 0 || (doneA && doneB)) break; --kt;
        SBA_TILE(1, kt); if (kt == 0 || (doneA && doneB)) break; --kt;
    }
    asm volatile("s_waitcnt vmcnt(0)" ::: "memory");
#undef SBA_TILE
#undef SBA_BLOCK
#undef SBA_ISSUE
    float ssa = 0.f, ssb = 0.f;
#pragma unroll
    for (int r = 0; r < 16; ++r) { ssa += oa0[r] * oa0[r] + oa1[r] * oa1[r]; ssb += ob0[r] * ob0[r] + ob1[r] * ob1[r]; }
    ssa = hsum32(ssa); ssb = hsum32(ssb);
    if (hi == 0) { red[h * 64 + r32] = ssa; red[h * 64 + 32 + r32] = ssb; }
    LDS_WAIT(); __syncthreads();
    float ta = 0.f, tb = 0.f;
#pragma unroll
    for (int j = 0; j < 8; ++j) { ta += red[j * 64 + r32]; tb += red[j * 64 + 32 + r32]; }
    const float rsa = 1.f / sqrtf(ta * (1.f / 512.f) + EPS), rsb = 1.f / sqrtf(tb * (1.f / 512.f) + EPS);
#pragma unroll
    for (int db = 0; db < 2; ++db)
#pragma unroll
        for (int g = 0; g < 4; ++g) { const int d = 32 * db + 8 * g + 4 * hi; const f32x4 gv = *(const f32x4*)(gattn + h * 64 + d);
            const f32x16& xa = db ? oa1 : oa0; const f32x16& xb = db ? ob1 : ob0;
            const unsigned la = cvtpk(xa[4 * g] * rsa * gv.x, xa[4 * g + 1] * rsa * gv.y), ha = cvtpk(xa[4 * g + 2] * rsa * gv.z, xa[4 * g + 3] * rsa * gv.w);
            const unsigned lb = cvtpk(xb[4 * g] * rsb * gv.x, xb[4 * g + 1] * rsb * gv.y), hb = cvtpk(xb[4 * g + 2] * rsb * gv.z, xb[4 * g + 3] * rsb * gv.w);
            *(LAS unsigned long long*)(vl + r32 * 128 + d * 2) = (unsigned long long)la | ((unsigned long long)ha << 32);
            *(LAS unsigned long long*)(vl + (32 + r32) * 128 + d * 2) = (unsigned long long)lb | ((unsigned long long)hb << 32); }
    LDS_WAIT();
#pragma unroll
    for (int i = 0; i < 8; ++i) { const int row = (lane >> 3) + 8 * i; const v4u v = *(const LAS v4u*)(vl + row * 128 + (lane & 7) * 16);
        *(v4u*)(AOo + (row0 + 64 * qt2 + row) * 1024 + h * 64 + (lane & 7) * 8) = v; }
    LDS_WAIT();
}
}
namespace ssd {
typedef float f32x16 __attribute__((ext_vector_type(16)));
typedef short v4i16_t __attribute__((ext_vector_type(4)));
constexpr int RS = 272, XRS = 528;
constexpr int OFF_B = 0, OFF_C = 128 * RS, OFF_X = 2 * 128 * RS, OFF_TAB = OFF_X + 128 * XRS, OFF_T = OFF_C;
constexpr int TAB_HEAD = 2048, TAB_ACUM = 0, TAB_DT = 512, TAB_CF = 1024, TAB_DECS = 1536;
constexpr int OFF_DTP = OFF_TAB + 4 * TAB_HEAD;
constexpr int LDS_NEED = OFF_DTP + 8192;
constexpr float LOG2E = 1.4426950408889634f;
__device__ __forceinline__ v4i16_t vtr(const LAS char* p) { return __builtin_amdgcn_ds_read_tr16_b64_v4i16((LAS v4i16_t*)p); }
typedef float f32x2_t __attribute__((ext_vector_type(2))); typedef __bf16 bf16x2_t __attribute__((ext_vector_type(2)));
__device__ __forceinline__ unsigned cvtpk(float lo, float hi) { f32x2_t v = {lo, hi}; bf16x2_t b = __builtin_convertvector(v, bf16x2_t); return __builtin_bit_cast(unsigned, b); }
__device__ __forceinline__ float bflo(unsigned u) { return __builtin_bit_cast(float, u << 16); }
__device__ __forceinline__ float bfhi(unsigned u) { return __builtin_bit_cast(float, u & 0xffff0000u); }
__device__ __forceinline__ float ex(float x) { return __builtin_amdgcn_exp2f(LOG2E * x); }
__device__ __forceinline__ int crow(int r, int hi) { return (r & 3) + 8 * (r >> 2) + 4 * hi; }

struct ATensors { const bf16* PROJ; const float* cw; const float* cb; const float* dtraw; const float* dtbias; const float* alog; const float* dskip;
                  bf16* YD; bf16* ST; bf16* CC; float* ACUM; };

__device__ __forceinline__ void phaseA_unit(const int b, const int c, const int g, const ATensors& T, LAS unsigned char* lds, const int wave, const int lane) {
    const int r32 = lane & 31, hi = lane >> 5, grp = lane >> 4, i16 = lane & 15;
    const int tok0 = b * SEQ + c * 128;
    LAS char* L = (LAS char*)lds;
    if (wave < 4) {
        const int h = g * 4 + wave; const float a = -expf(T.alog[h]), bias = T.dtbias[h];
        LAS float* tab = (LAS float*)(L + OFF_TAB + wave * TAB_HEAD);
        const int l0 = 2 * lane;
        float z0 = T.dtraw[(size_t)(tok0 + l0) * 8 + h] + bias, z1 = T.dtraw[(size_t)(tok0 + l0 + 1) * 8 + h] + bias;
        const float d0 = (z0 > 20.f) ? z0 : log1pf(expf(z0)), d1 = (z1 > 20.f) ? z1 : log1pf(expf(z1));
        const float a0 = d0 * a, a1 = d1 * a, ps = a0 + a1;
        float inc = ps;
#pragma unroll
        for (int o = 1; o < 64; o <<= 1) { const float t = __shfl_up(inc, o); if (lane >= o) inc += t; }
        const float exc = inc - ps, c0 = exc + a0, c1 = exc + ps;
        const float alast = __shfl(inc, 63);
        tab[TAB_ACUM / 4 + l0] = c0; tab[TAB_ACUM / 4 + l0 + 1] = c1; tab[TAB_DT / 4 + l0] = d0; tab[TAB_DT / 4 + l0 + 1] = d1;
        LDS_WAIT();
        const float eb = tab[TAB_ACUM / 4 + (l0 | 31)];
        tab[TAB_CF / 4 + l0] = ex(eb - c0) * d0; tab[TAB_CF / 4 + l0 + 1] = ex(eb - c1) * d1;
        tab[TAB_DECS / 4 + l0] = ex(alast - c0) * d0; tab[TAB_DECS / 4 + l0 + 1] = ex(alast - c1) * d1;
        T.ACUM[(size_t)(tok0 + l0) * 8 + h] = c0; T.ACUM[(size_t)(tok0 + l0 + 1) * 8 + h] = c1;
    }
    {
        const int scol = (lane < 32) ? (g * 256 + lane * 8) : (lane < 48) ? (512 + g * 128 + (lane - 32) * 8) : (768 + g * 128 + (lane - 48) * 8);
        float wt[4][8], bs[8];
#pragma unroll
        for (int k = 0; k < 4; ++k) { const f32x4 w0 = *(const f32x4*)(T.cw + k * 1024 + scol), w1 = *(const f32x4*)(T.cw + k * 1024 + scol + 4);
            wt[k][0] = w0.x; wt[k][1] = w0.y; wt[k][2] = w0.z; wt[k][3] = w0.w; wt[k][4] = w1.x; wt[k][5] = w1.y; wt[k][6] = w1.z; wt[k][7] = w1.w; }
        { const f32x4 b0 = *(const f32x4*)(T.cb + scol), b1 = *(const f32x4*)(T.cb + scol + 4); bs[0] = b0.x; bs[1] = b0.y; bs[2] = b0.z; bs[3] = b0.w; bs[4] = b1.x; bs[5] = b1.y; bs[6] = b1.z; bs[7] = b1.w; }
        const bf16* src = T.PROJ + (size_t)(tok0 + 16 * wave) * NPROJ + OXBC + scol;
        const bool first = (c == 0) && (wave == 0);
        v4u raw[19];
#pragma unroll
        for (int j = 0; j < 19; ++j) { const v4u zz = {0u, 0u, 0u, 0u}; raw[j] = (first && j < 3) ? zz : *(const v4u*)(src + (long)(j - 3) * NPROJ); }
        LAS char* dst = (lane < 32) ? (L + OFF_X + lane * 16) : (lane < 48) ? (L + OFF_B + (lane - 32) * 16) : (L + OFF_C + (lane - 48) * 16);
        const int drs = (lane < 32) ? XRS : RS;
#pragma unroll
        for (int j = 0; j < 16; ++j) {
            float o[8];
#pragma unroll
            for (int i = 0; i < 8; ++i) o[i] = bs[i];
#pragma unroll
            for (int k = 0; k < 4; ++k) { const v4u rv = raw[j + k];
                o[0] += wt[k][0] * bflo(rv.x); o[1] += wt[k][1] * bfhi(rv.x); o[2] += wt[k][2] * bflo(rv.y); o[3] += wt[k][3] * bfhi(rv.y);
                o[4] += wt[k][4] * bflo(rv.z); o[5] += wt[k][5] * bfhi(rv.z); o[6] += wt[k][6] * bflo(rv.w); o[7] += wt[k][7] * bfhi(rv.w); }
#pragma unroll
            for (int i = 0; i < 8; ++i) o[i] = o[i] * __builtin_amdgcn_rcpf(1.f + __builtin_amdgcn_exp2f(-LOG2E * o[i]));
            v4u pk; pk.x = cvtpk(o[0], o[1]); pk.y = cvtpk(o[2], o[3]); pk.z = cvtpk(o[4], o[5]); pk.w = cvtpk(o[6], o[7]);
            const int l = 16 * wave + j;
            *(LAS v4u*)(dst + l * drs) = pk;
            if (lane >= 48) *(v4u*)(T.CC + (size_t)(tok0 + l) * 256 + g * 128 + (lane - 48) * 8) = pk;
        }
    }
    LDS_WAIT(); __syncthreads();
    f32x16 t0, t1;
#pragma unroll
    for (int r = 0; r < 16; ++r) { t0[r] = 0.f; t1[r] = 0.f; }
    {
        const int ti = wave, lb = (ti >= 6) ? 3 : (ti >= 3) ? 2 : (ti >= 1) ? 1 : 0, sb = ti - lb * (lb + 1) / 2;
        const LAS char* ap = L + OFF_B + (32 * sb + r32) * RS + 16 * hi; const LAS char* bp = L + OFF_C + (32 * lb + r32) * RS + 16 * hi;
#pragma unroll
        for (int ks = 0; ks < 8; ++ks) t0 = __builtin_amdgcn_mfma_f32_32x32x16_bf16(*(const LAS bf16x8*)(ap + 32 * ks), *(const LAS bf16x8*)(bp + 32 * ks), t0, 0, 0, 0);
        if (wave < 2) { const int sb2 = 2 + wave;
            const LAS char* ap2 = L + OFF_B + (32 * sb2 + r32) * RS + 16 * hi; const LAS char* bp2 = L + OFF_C + (96 + r32) * RS + 16 * hi;
#pragma unroll
            for (int ks = 0; ks < 8; ++ks) t1 = __builtin_amdgcn_mfma_f32_32x32x16_bf16(*(const LAS bf16x8*)(ap2 + 32 * ks), *(const LAS bf16x8*)(bp2 + 32 * ks), t1, 0, 0, 0); }
    }
    LDS_WAIT(); __syncthreads();
    {
        LAS char* tp = L + OFF_T + wave * 2048 + lane * 32;
        v4u w0, w1; w0.x = cvtpk(t0[0], t0[1]); w0.y = cvtpk(t0[2], t0[3]); w0.z = cvtpk(t0[4], t0[5]); w0.w = cvtpk(t0[6], t0[7]);
        w1.x = cvtpk(t0[8], t0[9]); w1.y = cvtpk(t0[10], t0[11]); w1.z = cvtpk(t0[12], t0[13]); w1.w = cvtpk(t0[14], t0[15]);
        *(LAS v4u*)tp = w0; *(LAS v4u*)(tp + 16) = w1;
        if (wave < 2) { LAS char* tp2 = L + OFF_T + (8 + wave) * 2048 + lane * 32;
            w0.x = cvtpk(t1[0], t1[1]); w0.y = cvtpk(t1[2], t1[3]); w0.z = cvtpk(t1[4], t1[5]); w0.w = cvtpk(t1[6], t1[7]);
            w1.x = cvtpk(t1[8], t1[9]); w1.y = cvtpk(t1[10], t1[11]); w1.z = cvtpk(t1[12], t1[13]); w1.w = cvtpk(t1[14], t1[15]);
            *(LAS v4u*)tp2 = w0; *(LAS v4u*)(tp2 + 16) = w1; }
    }
    LDS_WAIT(); __syncthreads();
    const int hl = wave >> 1, ph = wave & 1, h = g * 4 + hl;
    const LAS float* tab = (const LAS float*)(L + OFF_TAB + hl * TAB_HEAD);
    const float Dh = T.dskip[h];
    bf16x8 xf[8];
    {
        const LAS char* xp = L + OFF_X + (4 * (grp >> 1) + (i16 >> 2)) * XRS + (hl * 64 + 32 * ph + 16 * (grp & 1) + 4 * (i16 & 3)) * 2;
#pragma unroll
        for (int ks = 0; ks < 8; ++ks) { const v4i16_t a0 = vtr(xp + (16 * ks) * XRS), a1 = vtr(xp + (16 * ks + 8) * XRS);
            xf[ks] = (bf16x8){a0[0], a0[1], a0[2], a0[3], a1[0], a1[1], a1[2], a1[3]}; }
    }
#pragma unroll
    for (int lb = 0; lb < 4; ++lb) {
        f32x16 y;
#pragma unroll
        for (int r = 0; r < 16; ++r) y[r] = 0.f;
        const float acl = tab[TAB_ACUM / 4 + 32 * lb + r32];
#pragma unroll
        for (int sb = 0; sb <= lb; ++sb) {
            const LAS char* tp = L + OFF_T + (lb * (lb + 1) / 2 + sb) * 2048 + lane * 32;
            const v4u q0 = *(const LAS v4u*)tp, q1 = *(const LAS v4u*)(tp + 16);
            float tv[16] = {bflo(q0.x), bfhi(q0.x), bflo(q0.y), bfhi(q0.y), bflo(q0.z), bfhi(q0.z), bflo(q0.w), bfhi(q0.w),
                            bflo(q1.x), bfhi(q1.x), bflo(q1.y), bfhi(q1.y), bflo(q1.z), bfhi(q1.z), bflo(q1.w), bfhi(q1.w)};
            float m[16];
            if (sb < lb) {
                const float rowf = ex(acl - tab[TAB_ACUM / 4 + 32 * sb + 31]);
#pragma unroll
                for (int q = 0; q < 4; ++q) { const f32x4 cf = *(const LAS f32x4*)(tab + TAB_CF / 4 + 32 * sb + 8 * q + 4 * hi);
                    m[4 * q] = tv[4 * q] * (rowf * cf.x); m[4 * q + 1] = tv[4 * q + 1] * (rowf * cf.y); m[4 * q + 2] = tv[4 * q + 2] * (rowf * cf.z); m[4 * q + 3] = tv[4 * q + 3] * (rowf * cf.w); }
            } else {
#pragma unroll
                for (int q = 0; q < 4; ++q) { const f32x4 as = *(const LAS f32x4*)(tab + TAB_ACUM / 4 + 32 * sb + 8 * q + 4 * hi), ds = *(const LAS f32x4*)(tab + TAB_DT / 4 + 32 * sb + 8 * q + 4 * hi);
                    const float asv[4] = {as.x, as.y, as.z, as.w}, dsv[4] = {ds.x, ds.y, ds.z, ds.w};
#pragma unroll
                    for (int i = 0; i < 4; ++i) { const int sl = 8 * q + 4 * hi + i;
                        const float f = (sl <= r32) ? ex(acl - asv[i]) * dsv[i] : 0.f;
                        m[4 * q + i] = tv[4 * q + i] * f + ((sl == r32) ? Dh : 0.f); } }
            }
            v4u p0, p1; p0.x = cvtpk(m[0], m[1]); p0.y = cvtpk(m[2], m[3]); p0.z = cvtpk(m[4], m[5]); p0.w = cvtpk(m[6], m[7]);
            p1.x = cvtpk(m[8], m[9]); p1.y = cvtpk(m[10], m[11]); p1.z = cvtpk(m[12], m[13]); p1.w = cvtpk(m[14], m[15]);
            y = __builtin_amdgcn_mfma_f32_32x32x16_bf16(__builtin_bit_cast(bf16x8, p0), xf[2 * sb], y, 0, 0, 0);
            y = __builtin_amdgcn_mfma_f32_32x32x16_bf16(__builtin_bit_cast(bf16x8, p1), xf[2 * sb + 1], y, 0, 0, 0);
        }
        v4u* yp = (v4u*)T.YD + ((size_t)((((b * 16 + c) * 2 + g) * 8 + wave) * 4 + lb) * 2) * 64 + lane;
#pragma unroll
        for (int rh = 0; rh < 2; ++rh) yp[rh * 64] = (v4u){cvtpk(y[8 * rh], y[8 * rh + 1]), cvtpk(y[8 * rh + 2], y[8 * rh + 3]), cvtpk(y[8 * rh + 4], y[8 * rh + 5]), cvtpk(y[8 * rh + 6], y[8 * rh + 7])};
    }
    {
        f32x16 xs[4];
#pragma unroll
        for (int nb = 0; nb < 4; ++nb)
#pragma unroll
            for (int r = 0; r < 16; ++r) xs[nb][r] = 0.f;
        const LAS char* bp = L + OFF_B + (4 * (grp >> 1) + (i16 >> 2)) * RS + (16 * (grp & 1) + 4 * (i16 & 3)) * 2;
#pragma unroll
        for (int ks = 0; ks < 8; ++ks) {
            const f32x4 e0 = *(const LAS f32x4*)(tab + TAB_DECS / 4 + 16 * ks + 4 * hi), e1 = *(const LAS f32x4*)(tab + TAB_DECS / 4 + 16 * ks + 8 + 4 * hi);
            const v4u xu = __builtin_bit_cast(v4u, xf[ks]);
            v4u su; su.x = cvtpk(bflo(xu.x) * e0.x, bfhi(xu.x) * e0.y); su.y = cvtpk(bflo(xu.y) * e0.z, bfhi(xu.y) * e0.w);
            su.z = cvtpk(bflo(xu.z) * e1.x, bfhi(xu.z) * e1.y); su.w = cvtpk(bflo(xu.w) * e1.z, bfhi(xu.w) * e1.w);
            const bf16x8 sx = __builtin_bit_cast(bf16x8, su);
#pragma unroll
            for (int nb = 0; nb < 4; ++nb) { const v4i16_t a0 = vtr(bp + (16 * ks) * RS + nb * 64), a1 = vtr(bp + (16 * ks + 8) * RS + nb * 64);
                xs[nb] = __builtin_amdgcn_mfma_f32_32x32x16_bf16((bf16x8){a0[0], a0[1], a0[2], a0[3], a1[0], a1[1], a1[2], a1[3]}, sx, xs[nb], 0, 0, 0); }
        }
        v4u* sp = (v4u*)T.ST + (size_t)((b * 16 + c) * 8 + h) * 1024 + (size_t)(ph * 8) * 64 + lane;
#pragma unroll
        for (int nb = 0; nb < 4; ++nb)
#pragma unroll
            for (int rh = 0; rh < 2; ++rh) sp[(nb * 2 + rh) * 64] = (v4u){cvtpk(xs[nb][8 * rh], xs[nb][8 * rh + 1]), cvtpk(xs[nb][8 * rh + 2], xs[nb][8 * rh + 3]), cvtpk(xs[nb][8 * rh + 4], xs[nb][8 * rh + 5]), cvtpk(xs[nb][8 * rh + 6], xs[nb][8 * rh + 7])};
    }
    LDS_WAIT(); __syncthreads();
}

__device__ __forceinline__ void scan_states(const bf16* ST, bf16* SF, const float* ACUM, const int gtid, const int nthr) {
    for (int e = gtid; e < BATCH * 8 * 1024; e += nthr) {
        const int bh = e >> 10, b = bh >> 3, h = bh & 7, q = e & 1023;
        float S[8];
#pragma unroll
        for (int j = 0; j < 8; ++j) S[j] = 0.f;
        v4u v[16]; float dc[16];
#pragma unroll
        for (int c = 0; c < 16; ++c) { v[c] = *((const v4u*)ST + (size_t)((b * 16 + c) * 8 + h) * 1024 + q); dc[c] = ACUM[(size_t)(b * SEQ + c * 128 + 127) * 8 + h]; }
#pragma unroll
        for (int c = 0; c < 16; ++c) {
            *((v4u*)SF + (size_t)((b * 16 + c) * 8 + h) * 1024 + q) = (v4u){cvtpk(S[0], S[1]), cvtpk(S[2], S[3]), cvtpk(S[4], S[5]), cvtpk(S[6], S[7])};
            const float d = ex(dc[c]);
            S[0] = S[0] * d + bflo(v[c].x); S[1] = S[1] * d + bfhi(v[c].x); S[2] = S[2] * d + bflo(v[c].y); S[3] = S[3] * d + bfhi(v[c].y);
            S[4] = S[4] * d + bflo(v[c].z); S[5] = S[5] * d + bfhi(v[c].z); S[6] = S[6] * d + bflo(v[c].w); S[7] = S[7] * d + bfhi(v[c].w); }
    }
}

struct BTensors { const bf16* PROJ; const bf16* YD; const bf16* SF; const bf16* CC; const float* ACUM; const float* gssd; bf16* AO; };

__device__ __forceinline__ void phaseB_unit(const int b, const int c, const int g, const BTensors& T, LAS unsigned char* lds, const int wave, const int lane, const int tid) {
    const int r32 = lane & 31, hi = lane >> 5;
    const int tok0 = b * SEQ + c * 128;
    LAS char* L = (LAS char*)lds;
#pragma unroll
    for (int i = 0; i < 4; ++i) { const int ch = tid + 512 * i, row = ch >> 4, cc = ch & 15;
        *(LAS v4u*)(L + OFF_C + row * RS + cc * 16) = *(const v4u*)(T.CC + (size_t)(tok0 + row) * 256 + g * 128 + cc * 8); }
    { const int hl = tid >> 7, l = tid & 127; ((LAS float*)(L + OFF_TAB))[hl * 128 + l] = ex(T.ACUM[(size_t)(tok0 + l) * 8 + g * 4 + hl]); }
    LDS_WAIT(); __syncthreads();
    const int hl = wave >> 1, ph = wave & 1, h = g * 4 + hl;
    bf16x8 sf[8];
    {
        const bf16x8* sp = (const bf16x8*)T.SF + (size_t)((((b * 16 + c) * 8 + h) * 2 + ph) * 8) * 64 + lane;
#pragma unroll
        for (int ks = 0; ks < 8; ++ks) sf[ks] = sp[ks * 64];
    }
    const LAS float* ea = (const LAS float*)(L + OFF_TAB) + hl * 128;
#pragma unroll
    for (int lb = 0; lb < 4; ++lb) {
        f32x16 y;
#pragma unroll
        for (int r = 0; r < 16; ++r) y[r] = 0.f;
        const LAS char* cp = L + OFF_C + (32 * lb + r32) * RS + 8 * hi;
#pragma unroll
        for (int ks = 0; ks < 8; ++ks) { const unsigned long long c0 = *(const LAS unsigned long long*)(cp + 32 * ks), c1 = *(const LAS unsigned long long*)(cp + 32 * ks + 16);
            v4u cu; cu.x = (unsigned)c0; cu.y = (unsigned)(c0 >> 32); cu.z = (unsigned)c1; cu.w = (unsigned)(c1 >> 32);
            y = __builtin_amdgcn_mfma_f32_32x32x16_bf16(__builtin_bit_cast(bf16x8, cu), sf[ks], y, 0, 0, 0); }
        const v4u* ydp = (const v4u*)T.YD + ((size_t)((((b * 16 + c) * 2 + g) * 8 + wave) * 4 + lb) * 2) * 64 + lane;
        LAS bf16* yl = (LAS bf16*)(L + OFF_X + (32 * lb + 4 * hi) * XRS) + hl * 64 + 32 * ph + r32;
#pragma unroll
        for (int rh = 0; rh < 2; ++rh) { const v4u yd = ydp[rh * 64];
            const f32x4 e0 = *(const LAS f32x4*)(ea + 32 * lb + 16 * rh + 4 * hi), e1 = *(const LAS f32x4*)(ea + 32 * lb + 16 * rh + 8 + 4 * hi);
            yl[(16 * rh + 0) * (XRS / 2)] = (bf16)f2bf(y[8 * rh] * e0.x + bflo(yd.x)); yl[(16 * rh + 1) * (XRS / 2)] = (bf16)f2bf(y[8 * rh + 1] * e0.y + bfhi(yd.x));
            yl[(16 * rh + 2) * (XRS / 2)] = (bf16)f2bf(y[8 * rh + 2] * e0.z + bflo(yd.y)); yl[(16 * rh + 3) * (XRS / 2)] = (bf16)f2bf(y[8 * rh + 3] * e0.w + bfhi(yd.y));
            yl[(16 * rh + 8) * (XRS / 2)] = (bf16)f2bf(y[8 * rh + 4] * e1.x + bflo(yd.z)); yl[(16 * rh + 9) * (XRS / 2)] = (bf16)f2bf(y[8 * rh + 5] * e1.y + bfhi(yd.z));
            yl[(16 * rh + 10) * (XRS / 2)] = (bf16)f2bf(y[8 * rh + 6] * e1.z + bflo(yd.w)); yl[(16 * rh + 11) * (XRS / 2)] = (bf16)f2bf(y[8 * rh + 7] * e1.w + bfhi(yd.w)); }
    }
    LDS_WAIT(); __syncthreads();
    {
        const int cl = lane & 15;
        const f32x4 g0 = *(const f32x4*)(T.gssd + g * 256 + cl * 8), g1 = *(const f32x4*)(T.gssd + g * 256 + cl * 8 + 4), g2 = *(const f32x4*)(T.gssd + g * 256 + 128 + cl * 8), g3 = *(const f32x4*)(T.gssd + g * 256 + 128 + cl * 8 + 4);
#pragma unroll
        for (int ps = 0; ps < 4; ++ps) { const int row = 16 * wave + 4 * ps + (lane >> 4);
            const v4u u0 = *(const LAS v4u*)(L + OFF_X + row * XRS + cl * 16), u1 = *(const LAS v4u*)(L + OFF_X + row * XRS + 256 + cl * 16);
            float a[16] = {bflo(u0.x), bfhi(u0.x), bflo(u0.y), bfhi(u0.y), bflo(u0.z), bfhi(u0.z), bflo(u0.w), bfhi(u0.w), bflo(u1.x), bfhi(u1.x), bflo(u1.y), bfhi(u1.y), bflo(u1.z), bfhi(u1.z), bflo(u1.w), bfhi(u1.w)};
            const bf16* zp = T.PROJ + (size_t)(tok0 + row) * NPROJ + OZ + g * 256 + cl * 8;
            const v4u z0 = *(const v4u*)zp, z1 = *(const v4u*)(zp + 128);
            const float zz[16] = {bflo(z0.x), bfhi(z0.x), bflo(z0.y), bfhi(z0.y), bflo(z0.z), bfhi(z0.z), bflo(z0.w), bfhi(z0.w), bflo(z1.x), bfhi(z1.x), bflo(z1.y), bfhi(z1.y), bflo(z1.z), bfhi(z1.z), bflo(z1.w), bfhi(z1.w)};
            float ss = 0.f;
#pragma unroll
            for (int i = 0; i < 16; ++i) { a[i] *= zz[i] * __builtin_amdgcn_rcpf(1.f + __builtin_amdgcn_exp2f(-LOG2E * zz[i])); ss += a[i] * a[i]; }
            ss += __shfl_xor(ss, 1); ss += __shfl_xor(ss, 2); ss += __shfl_xor(ss, 4); ss += __shfl_xor(ss, 8);
            const float rs = 1.f / sqrtf(ss * (1.f / 256.f) + EPS);
            v4u o0, o1; o0.x = cvtpk(a[0] * rs * g0.x, a[1] * rs * g0.y); o0.y = cvtpk(a[2] * rs * g0.z, a[3] * rs * g0.w); o0.z = cvtpk(a[4] * rs * g1.x, a[5] * rs * g1.y); o0.w = cvtpk(a[6] * rs * g1.z, a[7] * rs * g1.w);
            o1.x = cvtpk(a[8] * rs * g2.x, a[9] * rs * g2.y); o1.y = cvtpk(a[10] * rs * g2.z, a[11] * rs * g2.w); o1.z = cvtpk(a[12] * rs * g3.x, a[13] * rs * g3.y); o1.w = cvtpk(a[14] * rs * g3.z, a[15] * rs * g3.w);
            bf16* op = T.AO + (size_t)(tok0 + row) * 1024 + 512 + g * 256 + cl * 8;
            *(v4u*)op = o0; *(v4u*)(op + 128) = o1; }
    }
    LDS_WAIT(); __syncthreads();
}
}

__device__ __forceinline__ void dt_tail(const bf16* XBi, const bf16* WDTl, const float* rss, float* DTR, LAS unsigned char* lds, const int vcu, const int G, const int wave, const int lane, const int tid) {
    typedef float f32x16 __attribute__((ext_vector_type(16)));
    const int r32 = lane & 31, hi = lane >> 5;
    for (int p = vcu; p < MT / 64; p += G) {
        const int mb = wave & 1, kq = wave >> 1;
        f32x16 d;
#pragma unroll
        for (int r = 0; r < 16; ++r) d[r] = 0.f;
        const bf16* ap = XBi + (size_t)(64 * p + 32 * mb + r32) * DM + 256 * kq + 8 * hi;
        const bf16* bp = WDTl + (size_t)(r32 & 7) * DM + 256 * kq + 8 * hi;
        const bf16x8 zero8 = {0, 0, 0, 0, 0, 0, 0, 0};
        bf16x8 af[16], bq[16];
#pragma unroll
        for (int ks = 0; ks < 16; ++ks) { af[ks] = *(const bf16x8*)(ap + 16 * ks); bq[ks] = *(const bf16x8*)(bp + 16 * ks); }
#pragma unroll
        for (int ks = 0; ks < 16; ++ks) d = __builtin_amdgcn_mfma_f32_32x32x16_bf16(af[ks], (r32 < 8) ? bq[ks] : zero8, d, 0, 0, 0);
        LAS float* dp = (LAS float*)lds + ((kq * 64 + 32 * mb + 4 * hi) * 8 + r32);
        if (r32 < 8) {
#pragma unroll
            for (int r = 0; r < 16; ++r) dp[((r & 3) + 8 * (r >> 2)) * 8] = d[r]; }
        LDS_WAIT(); __syncthreads();
        { const int row = tid >> 3, j = tid & 7; const LAS float* q = (const LAS float*)lds + row * 8 + j;
          DTR[(size_t)(64 * p + row) * 8 + j] = ((q[0] + q[512]) + (q[1024] + q[1536])) * pg8::rstd_of(rss, 64 * p + row); }
        LDS_WAIT(); __syncthreads();
    }
}

__device__ __forceinline__ int moe_tables(LAS int* pan, gu32* ecnt, int tid) {
    int cnt[NE], ps[NE + 1]; ps[0] = 0;
#pragma unroll
    for (int e = 0; e < NE; ++e) { cnt[e] = (int)__hip_atomic_load(ecnt + 64 * e, RLX_AGENT); ps[e + 1] = ps[e] + ((cnt[e] + 255) >> 8); }
    if (tid < 256) { int e = 0, c = cnt[0], p0 = 0;
#pragma unroll
        for (int q = 1; q < NE; ++q) if (tid >= ps[q]) { e = q; c = cnt[q]; p0 = ps[q]; }
        const int j = tid - p0, real = min(256, c - 256 * j);
        if (tid < ps[NE]) pan[tid] = e | (j << 8) | ((real - 1) << 16); }
    LDS_WAIT(); __syncthreads();
    return ps[NE];
}
#define KARGP ((const __attribute__((address_space(4))) char*)__builtin_amdgcn_kernarg_segment_ptr())
enum { PH_PRO = 0, PH_L0 = 1, PH_FFNUP = 6, PH_FFNDN = 7, PH_L1 = 8, PH_ROUTE = 13, PH_MOEUP = 14, PH_MOEDN = 15, PH_FINAL = 16, PH_N = 17 };
#define ws (*(unsigned char* const __attribute__((address_space(4)))*)(KARGP + 168))
#define ctl ((gu32*)(ws + WS_CTL))
#define IN(k) (lo <= (k) && (k) < hi)
#ifndef PROBE_MASK
#define PROBE_MASK 0u
#endif
#define PB(k) _Pragma("unroll") for (int rep_ = 0; rep_ < (int)((PROBE_MASK >> (k)) & 1u) + 1; ++rep_) {
#define PE(k) if (rep_ + 1 < (int)((PROBE_MASK >> (k)) & 1u) + 1) xcd_barrier(bar); }
#define SEAM(k) do { if (IN(k) && IN((k) + 1)) xcd_barrier(bar); } while (0)
#define KARG_F(i) (*(const float* const __attribute__((address_space(4)))*)(KARGP + 8 * (i)))
#define x_in KARG_F(0)
#define mix_g KARG_F(1)
#define w_in KARG_F(2)
#define attn_g KARG_F(8)
#define ssd_g KARG_F(9)
#define w_out KARG_F(10)
#define ffn_g KARG_F(11)
#define dwg KARG_F(12)
#define dwu KARG_F(13)
#define dwd KARG_F(14)
#define router_w KARG_F(15)
#define mwg KARG_F(16)
#define mwu KARG_F(17)
#define mwd KARG_F(18)
#define final_g KARG_F(19)
#define conv_w KARG_F(3)
#define conv_b KARG_F(4)
#define dt_bias KARG_F(5)
#define a_log KARG_F(6)
#define d_skip KARG_F(7)
#define OUTF (*(float* const __attribute__((address_space(4)))*)(KARGP + 160))
#define XR ((bf16*)(ws + WS_XR))
#define WIN_T ((bf16*)(ws + WS_WIN))
#define WOUT_T ((bf16*)(ws + WS_WOUT))
#define WDGU_T ((bf16*)(ws + WS_WDGU))
#define WDD_T ((bf16*)(ws + WS_WDD))
#define WDGU8 ((unsigned char*)(ws + WS_WDGU))
#define WDD8 ((unsigned char*)(ws + WS_WDD))
#define HB8 ((unsigned char*)(ws + WS_HB))
#define WMGU_T ((bf16*)(ws + WS_R1))
#define WMGU8 ((unsigned char*)(ws + WS_R1))
#define WMD8 ((unsigned char*)(ws + WS_R1 + 60 * MiB))
#define XB8 ((unsigned char*)(ws + WS_XBCC))
#define HID8 ((unsigned char*)(ws + WS_R3))
#define PROJ ((bf16*)(ws + WS_PROJ))
#define AO ((bf16*)(ws + WS_AO))
#define HB ((bf16*)(ws + WS_HB))
#define HPERM ((bf16*)(ws + WS_R2))
#define YB ((bf16*)(ws + WS_R2))
#define YPB ((bf16*)(ws + WS_XN))
#define HID ((bf16*)(ws + WS_R3))
#define RSS(s) ((float*)(ws + WS_RSS) + (size_t)(s) * MT * 16)
#define DTRAW ((float*)(ws + WS_DTRAW))
#define WDT ((bf16*)(ws + WS_WDT))
#define ROWTOK_V ((int*)(ws + WS_RTOKV))
#define ROWG_V ((float*)(ws + WS_RGV))
#define ROWS_V ((float*)(ws + WS_RSV))
#define ACUM ((float*)(ws + WS_DTV))
#define CCB ((bf16*)(ws + WS_XBCC))
#define YDB ((float*)(ws + WS_ATTRAW))
#define STB ((float*)(ws + WS_YRAW))
#define ST2B ((float*)(ws + WS_ST2))
#define TOKE ((int*)(ws + WS_TOKE))
#define TOKR ((int*)(ws + WS_TOKR))
#define TOKG ((float*)(ws + WS_TOKG))
#define TOKP ((int*)(ws + WS_TOKP))
#define ROWG ((float*)(ws + WS_ROWG))
#define PTAB ((int*)(ws + WS_PTAB))
#define ECNT (ctl + CW_ECNT)

struct ConvDesc { const float* src; unsigned char* dst; int gko, ldw, pitch; float scale; int fp8; };
constexpr int GT_MIX1 = 0, GT_FFN0 = DM, GT_FFN1 = 2 * DM, GT_ONE = 3 * DM, GT_N = 3 * DM + 64;
constexpr int CI_IN = (DM / 64) * (NPROJ / 64), CI_OUT = (DM / 64) * (DM / 64), CI_DGU = 2 * (DM / 64) * (DFF / 64), CI_DD = (DFF / 64) * (DM / 64), CI_MGU = 2 * (DM / 64) * (DFFE / 64), CI_MD = (DFFE / 64) * (DM / 64);
constexpr int CI_DONOR = CI_IN + 2 * CI_OUT + CI_DGU + CI_DD + NE * CI_MGU + NE_PRO * CI_MD;
__device__ __forceinline__ ConvDesc conv_decode(int r) {
    ConvDesc d; d.gko = GT_ONE; d.scale = 1.f; d.fp8 = 0;
    if (r < CI_IN) { const int kb = r / (NPROJ / 64), nb = r % (NPROJ / 64);
        d.src = w_in + (size_t)DM * DINP + (size_t)(64 * kb) * DINP + 64 * nb; d.ldw = DINP; d.gko = GT_MIX1 + 64 * kb; d.dst = (unsigned char*)(WIN_T + (size_t)NPROJ * DM + (size_t)(64 * nb) * DM + 64 * kb); d.pitch = DM * 2; return d; }
    r -= CI_IN;
    if (r < 2 * CI_OUT) { const int l = r / CI_OUT, q = r % CI_OUT, kb = q / (DM / 64), nb = q % (DM / 64);
        d.src = w_out + (size_t)l * DM * DM + (size_t)(64 * kb) * DM + 64 * nb; d.ldw = DM; d.dst = (unsigned char*)(WOUT_T + (size_t)l * DM * DM + (size_t)(64 * nb) * DM + 64 * kb); d.pitch = DM * 2; return d; }
    r -= 2 * CI_OUT;
    if (r < CI_DGU) { const int nblk = DFF / 64, per = (DM / 64) * nblk, half = r / per, q = r % per, kb = q / nblk, nb = q % nblk, f0 = 64 * nb, drow0 = (f0 / 128) * 256 + half * 128 + (f0 % 128);
        d.src = (half ? dwu : dwg) + (size_t)(64 * kb) * DFF + f0; d.ldw = DFF; d.gko = GT_FFN0 + 64 * kb; d.scale = WU_SCALE; d.fp8 = 1; d.dst = WDGU8 + (size_t)drow0 * DM + 64 * kb; d.pitch = DM; return d; }
    r -= CI_DGU;
    if (r < CI_DD) { const int kb = r / (DM / 64), nb = r % (DM / 64);
        d.src = dwd + (size_t)(64 * kb) * DM + 64 * nb; d.ldw = DM; d.scale = WD_SCALE; d.fp8 = 1; d.dst = WDD8 + (size_t)(64 * nb) * DFF + 64 * kb; d.pitch = DFF; return d; }
    r -= CI_DD;
    if (r < NE * CI_MGU) { const int e = r / CI_MGU, q = r % CI_MGU, nblk = DFFE / 64, per = (DM / 64) * nblk, half = q / per, qq = q % per, kb = qq / nblk, nb = qq % nblk, f0 = 64 * nb, drow0 = (f0 / 128) * 256 + half * 128 + (f0 % 128);
        d.src = (half ? mwu : mwg) + (size_t)e * DM * DFFE + (size_t)(64 * kb) * DFFE + f0; d.ldw = DFFE; d.gko = GT_FFN1 + 64 * kb; d.scale = WU_SCALE; d.fp8 = 1;
        d.dst = WMGU8 + (size_t)e * 2 * DFFE * DM + (size_t)drow0 * DM + 64 * kb; d.pitch = DM; return d; }
    r -= NE * CI_MGU;
    { const int e = (NE - NE_PRO) + r / CI_MD, q = r % CI_MD, kb = q / (DM / 64), nb = q % (DM / 64);
        d.src = mwd + (size_t)e * DFFE * DM + (size_t)(64 * kb) * DM + 64 * nb; d.ldw = DM; d.scale = WD_SCALE; d.fp8 = 1; d.dst = WMD8 + (size_t)e * DM * DFFE + (size_t)(64 * nb) * DFFE + 64 * kb; d.pitch = DFFE; return d; }
}
__device__ __forceinline__ void conv_ld(const ConvDesc& d, f32x4 (&v)[16], int lane) {
    asm volatile("" : "+v"(lane));
    const float* s = d.src + (size_t)(16 * (lane >> 4)) * d.ldw + 4 * (lane & 15);
#pragma unroll
    for (int i = 0; i < 16; ++i) v[i] = __builtin_nontemporal_load((const GAS f32x4*)(s + (size_t)i * d.ldw));
}
__device__ __forceinline__ void conv_st(const ConvDesc& d, f32x4 (&v)[16], LAS unsigned char* scr, const LAS float* gtab, int lane) {
    asm volatile("" : "+v"(lane));
    const int kq = lane >> 4, n4 = lane & 15;
    { const LAS f32x4* gt = (const LAS f32x4*)(gtab + d.gko + 16 * kq);
#pragma unroll
      for (int q = 0; q < 4; ++q) { const f32x4 g4 = gt[q] * d.scale;
#pragma unroll
          for (int i = 0; i < 4; ++i) v[4 * q + i] = v[4 * q + i] * g4[i]; } }
    if (d.fp8) {
#pragma unroll
        for (int j = 0; j < 4; ++j) { int w[4];
#pragma unroll
            for (int q = 0; q < 4; ++q) { w[q] = __builtin_amdgcn_cvt_pk_fp8_f32(v[4 * q][j], v[4 * q + 1][j], 0, false); w[q] = __builtin_amdgcn_cvt_pk_fp8_f32(v[4 * q + 2][j], v[4 * q + 3][j], w[q], true); }
            *(LAS v4u*)(scr + (4 * n4 + j) * 80 + kq * 16) = (v4u){(unsigned)w[0], (unsigned)w[1], (unsigned)w[2], (unsigned)w[3]}; }
        LDS_WAIT(); asm volatile("" ::: "memory");
#pragma unroll
        for (int i = 0; i < 4; ++i) { const int idx = lane + 64 * i, n = idx >> 2, c = idx & 3;
            __builtin_nontemporal_store(*(const LAS v4u*)(scr + n * 80 + c * 16), (GAS v4u*)(d.dst + (size_t)n * d.pitch + 16 * c)); }
        LDS_WAIT(); asm volatile("" ::: "memory");
    } else {
#pragma unroll
        for (int j = 0; j < 4; ++j) { v4u a, b;
            a.x = sba::cvtpk(v[0][j], v[1][j]); a.y = sba::cvtpk(v[2][j], v[3][j]); a.z = sba::cvtpk(v[4][j], v[5][j]); a.w = sba::cvtpk(v[6][j], v[7][j]);
            b.x = sba::cvtpk(v[8][j], v[9][j]); b.y = sba::cvtpk(v[10][j], v[11][j]); b.z = sba::cvtpk(v[12][j], v[13][j]); b.w = sba::cvtpk(v[14][j], v[15][j]);
            LAS unsigned char* p = scr + (4 * n4 + j) * 144 + kq * 32;
            *(LAS v4u*)p = a; *(LAS v4u*)(p + 16) = b; }
        LDS_WAIT(); asm volatile("" ::: "memory");
#pragma unroll
        for (int i = 0; i < 8; ++i) { const int n = 8 * i + (lane >> 3), c = lane & 7;
            __builtin_nontemporal_store(*(const LAS v4u*)(scr + n * 144 + c * 16), (GAS v4u*)(d.dst + (size_t)n * d.pitch + 16 * c)); }
        LDS_WAIT(); asm volatile("" ::: "memory");
    }
}
__device__ __forceinline__ void donor_convert(LAS unsigned char* lds, const int w0, const int nw, const int wave, const int lane, const int tid) {
    LAS float* gtab = (LAS float*)(lds + NWAVES * 16384); LAS unsigned char* scr = lds + wave * 16384;
    for (int i = tid; i < GT_N; i += NWAVES * 64) gtab[i] = (i < DM) ? mix_g[DM + i] : (i < 3 * DM) ? ffn_g[i - DM] : 1.f;
    LDS_WAIT(); __syncthreads();
    f32x4 va[16], vb[16];
    conv_ld(conv_decode(min(w0, CI_DONOR - 1)), va, lane);
    for (int r = w0; r < CI_DONOR; r += 2 * nw) {
        const int r2 = r + nw, r3 = r + 2 * nw;
        conv_ld(conv_decode(min(r2, CI_DONOR - 1)), vb, lane);
        conv_st(conv_decode(r), va, scr, gtab, lane);
        conv_ld(conv_decode(min(r3, CI_DONOR - 1)), va, lane);
        if (r2 < CI_DONOR) conv_st(conv_decode(r2), vb, scr, gtab, lane);
    }
    asm volatile("" :: "v"(va[0]), "v"(va[15]));
}

template <int layer>
__device__ __forceinline__ void layer_phases(LAS unsigned char* L, const XcdBarrier& bar, const int lo, const int hi, const int tid, const int lane, const int wave, const int G, const int bx, const int gw, const int NGW) {
        const int pb = layer ? PH_L1 : PH_L0;
        if (IN(pb + 0)) {
            PB(pb + 0)
            const int GG = (layer == 0 && G >= 8) ? G - 3 * G / 8 : G;
            if (bx < GG) {
            pg8::Gemm g{XR, WIN_T + (size_t)layer * NPROJ * DM, MT, NPROJ, DM, DM}; pg8::StaticOrder S; S.init(MT, NPROJ, GG, bx);
            pg8::fill_rs<1>((LAS float*)(L + RS_TAB_OFF), S, RSS(layer ? 2 : 0), tid);
            pg8::EpiBf16 E{PROJ, NPROJ, 512, 0.125f * 1.4426950408889634f, (const LAS float*)(L + RS_TAB_OFF)};
            pg8::gemm_phase<pg8::EpiBf16, pg8::StaticOrder, true, true>(L + RING_OFF, g, S, E);
            dt_tail(XR, WDT + layer * 8 * DM, RSS(layer ? 2 : 0), DTRAW, L + RING_OFF, (GG % 8 == 0) ? (bx % 8) * (GG / 8) + bx / 8 : bx, GG, wave, lane, tid);
            } else { if constexpr (layer == 0) donor_convert(L + RING_OFF, (bx - GG) * NWAVES + wave, (G - GG) * NWAVES, wave, lane, tid); }
            PE(pb + 0)
        }
        SEAM(pb + 0);
        if (IN(pb + 1)) {
            PB(pb + 1)
            const ssd::ATensors T{PROJ, conv_w + layer * 4096, conv_b + layer * 1024, DTRAW, dt_bias + layer * 8, a_log + layer * 8, d_skip + layer * 8, (bf16*)YDB, (bf16*)STB, CCB, ACUM};
            for (int u = ((G % 8 == 0) ? (bx % 8) * (G / 8) + bx / 8 : bx); u < BATCH * 16 * 2; u += G) ssd::phaseA_unit(u >> 5, (u >> 1) & 15, u & 1, T, L + RING_OFF, wave, lane);
            PE(pb + 1)
        }
        const bool split12 = IN(pb + 1) && IN(pb + 2);
        if (split12) xcd_arrive(bar, (unsigned*)(ctl + CW_BAR2));
        if (IN(pb + 2)) {
            PB(pb + 2)
            int par = 0;
            for (int u = ((G % 8 == 0) ? (bx % 8) * (G / 8) + bx / 8 : bx); u < BATCH * (SEQ / 64); u += G) { sba::attn_unit(u >> 5, (SEQ / 64 - 1) - (u & 31), PROJ, attn_g + layer * 512, AO, L + RING_OFF, wave, lane, par); par ^= 1; }
            if (split12) xcd_wait(bar, (unsigned*)(ctl + CW_BAR2), (unsigned)layer + 1u);
            ssd::scan_states((const bf16*)STB, (bf16*)ST2B, ACUM, bx * (NWAVES * 64) + tid, G * NWAVES * 64);
            PE(pb + 2)
        }
        SEAM(pb + 2);
        if (IN(pb + 3)) {
            PB(pb + 3)
            const ssd::BTensors T{PROJ, (const bf16*)YDB, (const bf16*)ST2B, CCB, ACUM, ssd_g + layer * 512, AO};
            for (int u = ((G % 8 == 0) ? (bx % 8) * (G / 8) + bx / 8 : bx); u < BATCH * 16 * 2; u += G) ssd::phaseB_unit(u >> 5, (u >> 1) & 15, u & 1, T, L + RING_OFF, wave, lane, tid);
            PE(pb + 3)
        }
        SEAM(pb + 3);
        if (IN(pb + 4)) {
            PB(pb + 4)
            pg8::Gemm g{AO, WOUT_T + (size_t)layer * DM * DM, MT, DM, DM, DM}; pg8::StaticOrder S; S.init(MT, DM, G, bx, 8);
            pg8::EpiResAddNorm E{XR, DM, RSS(layer ? 3 : 1), XB8, 1.f};
            pg8::gemm_phase<pg8::EpiResAddNorm, pg8::StaticOrder, true, true>(L + RING_OFF, g, S, E);
            PE(pb + 4)
        }
        SEAM(pb + 4);
    }
__global__ void __launch_bounds__(NWAVES * 64, 2) mk_fwd(Args args) {
    extern __shared__ __attribute__((aligned(16))) unsigned char lds[];
    LAS unsigned char* L = (LAS unsigned char*)lds;
    const int tid = threadIdx.x, lane = tid & 63, wave = __builtin_amdgcn_readfirstlane(tid >> 6);
    const int G = gridDim.x; const int bx = blockIdx.x; const int vcu = (G % 8 == 0) ? (bx % 8) * (G / 8) + bx / 8 : bx;
    const int gw = vcu * NWAVES + wave, NGW = G * NWAVES;
    for (int u = tid; u < (LDS_BYTES - LDSCTL_OFF) / 4; u += NWAVES * 64) ((LAS unsigned*)(L + LDSCTL_OFF))[u] = 0u;
    __syncthreads();
    const int lo = *(const __attribute__((address_space(4))) int*)(KARGP + 176), hi = *(const __attribute__((address_space(4))) int*)(KARGP + 180);
    XcdBarrier bar; bar.bar = (unsigned*)(ctl + CW_BAR); bar.x = 0; bar.st = nullptr;
    if (hi - lo > 1) bar = xcd_barrier_post((unsigned*)(ctl + CW_BAR), (volatile LAS unsigned*)(L + MISC_OFF) + 8);
    if (IN(PH_PRO)) {
        PB(PH_PRO)
        LAS unsigned char* scr = L + RING_OFF + wave * 16384;
        for (int it = gw; it < CI_IN; it += NGW) conv_plain(w_in, DINP, DM, NPROJ, WIN_T, it, scr, lane, mix_g);
        xb_rows(x_in, mix_g, XR, RSS(0), gw, NGW, lane);
        { const int idx = bx * (NWAVES * 64) + tid; if (idx < 2 * 8 * DM) { const int l = idx >> 13, j = (idx >> 10) & 7, k = idx & 1023; WDT[idx] = (bf16)f2bf(w_in[(size_t)l * DM * DINP + (size_t)k * DINP + NPROJ + j] * mix_g[l * DM + k]); } }
        PE(PH_PRO)
    }
    SEAM(PH_PRO);
    layer_phases<0>(L, bar, lo, hi, tid, lane, wave, G, bx, gw, NGW);
    if (IN(PH_FFNUP)) {
        PB(PH_FFNUP)
        pg8::Gemm g{(const pg8::bf16_t*)XB8, (const pg8::bf16_t*)WDGU8, MT, 2 * DFF, DM, DM}; pg8::StaticOrder S; S.init(MT, 2 * DFF, G, bx);
        pg8::fill_rs<1>((LAS float*)(L + RS_TAB_OFF), S, RSS(1), tid, 1.f / WU_SCALE);
        pg8::EpiSwiGLU8 E{HB8, DFF, (const LAS float*)(L + RS_TAB_OFF)};
        pg8::gemm_phase<pg8::EpiSwiGLU8, pg8::StaticOrder, true, true, 1>(L + RING_OFF, g, S, E);
        {
            const int nfull = S.nwg % G;
            if (nfull > 0 && bx >= nfull) { LAS unsigned char* scr = L + RING_OFF + wave * 16384; constexpr int I_MD = (DFFE / 64) * (DM / 64); const int nid = (G - nfull) * NWAVES;
                for (int it = (bx - nfull) * NWAVES + wave; it < (NE - NE_PRO) * I_MD; it += nid) { const int e = it / I_MD, q = it % I_MD, kb = q / (DM / 64), nb = q % (DM / 64);
                    transpose_item8(mwd + (size_t)e * DFFE * DM, DM, WMD8 + (size_t)e * DM * DFFE, DFFE, 64 * kb, 64 * nb, 64 * nb, WD_SCALE, scr, lane); } }
            else if (nfull == 0) { LAS unsigned char* scr = L + RING_OFF + wave * 16384; constexpr int I_MD = (DFFE / 64) * (DM / 64);
                for (int it = gw; it < (NE - NE_PRO) * I_MD; it += NGW) { const int e = it / I_MD, q = it % I_MD, kb = q / (DM / 64), nb = q % (DM / 64);
                    transpose_item8(mwd + (size_t)e * DFFE * DM, DM, WMD8 + (size_t)e * DM * DFFE, DFFE, 64 * kb, 64 * nb, 64 * nb, WD_SCALE, scr, lane); } }
        }
        PE(PH_FFNUP)
    }
    SEAM(PH_FFNUP);
    if (IN(PH_FFNDN)) {
        PB(PH_FFNDN)
        pg8::Gemm g{(const pg8::bf16_t*)HB8, (const pg8::bf16_t*)WDD8, MT, DM, DFF, DFF}; pg8::StaticOrder S; S.init(MT, DM, G, bx, 8);
        pg8::EpiResAddNorm E{XR, DM, RSS(2), nullptr, 1.f / WD_SCALE};
        pg8::gemm_phase<pg8::EpiResAddNorm, pg8::StaticOrder, true, true, 1>(L + RING_OFF, g, S, E);
        PE(PH_FFNDN)
    }
    SEAM(PH_FFNDN);
    layer_phases<1>(L, bar, lo, hi, tid, lane, wave, G, bx, gw, NGW);
    if (IN(PH_ROUTE)) {
        PB(PH_ROUTE)
        LAS float* tab = (LAS float*)(L + RING_OFF);
        load_tab8(router_w, 8, tab, tid);
        route_rows(XR, ffn_g + DM, RSS(3), tab, (LAS int*)(L + RING_OFF + 32768), TOKE, TOKR, ROWTOK_V, ROWG_V, ROWS_V, ECNT, gw, NGW, lane, tid);
        PE(PH_ROUTE)
    }
    SEAM(PH_ROUTE);
    if (IN(PH_MOEUP)) {
        PB(PH_MOEUP)
        const int P = moe_tables((LAS int*)(L + PAN_TAB_OFF), ECNT, tid);
        pg8::Gemm g{(const pg8::bf16_t*)XB8, (const pg8::bf16_t*)WMGU8, P * 256, 2 * DFFE, DM, DM}; pg8::GroupedOrder<true> S; S.init(P, 2 * DFFE / 256, G, bx, (const LAS int*)(L + PAN_TAB_OFF), (const LAS unsigned short*)(L + TOK_TAB_OFF), (long)2 * DFFE * DM);
        pg8::fill_grouped((LAS float*)(L + RS_TAB_OFF), (LAS unsigned short*)(L + TOK_TAB_OFF), S, ROWS_V, ROWTOK_V, tid, 1.f / WU_SCALE);
        pg8::EpiSwiGLU8 E{HID8, DFFE, (const LAS float*)(L + RS_TAB_OFF)};
        pg8::gemm_phase<pg8::EpiSwiGLU8, pg8::GroupedOrder<true>, true, true, 1>(L + RING_OFF, g, S, E);
        PE(PH_MOEUP)
    }
    SEAM(PH_MOEUP);
    if (IN(PH_MOEDN)) {
        PB(PH_MOEDN)
        const int P = moe_tables((LAS int*)(L + PAN_TAB_OFF), ECNT, tid);
        {
            pg8::Gemm g{(const pg8::bf16_t*)HID8, (const pg8::bf16_t*)WMD8, 128 * 256, DM, DFFE, DFFE}; pg8::GroupedOrder<false> S; S.init(128, DM / 256, G, bx, (const LAS int*)(L + PAN_TAB_OFF), nullptr, (long)DM * DFFE, 8);
            pg8::fill_grouped((LAS float*)(L + RS_TAB_OFF), (LAS unsigned short*)nullptr, S, ROWG_V, nullptr, tid, 1.f / WD_SCALE);
            pg8::EpiRowScaleBf16 E{YB, DM, (const LAS float*)(L + RS_TAB_OFF)};
            pg8::gemm_phase<pg8::EpiRowScaleBf16, pg8::GroupedOrder<false>, true, true, 1>(L + RING_OFF, g, S, E);
        }
        if (P > 128) {
            pg8::Gemm g{(const pg8::bf16_t*)HID8, (const pg8::bf16_t*)WMD8, P * 256, DM, 512, DFFE}; pg8::TailOrder S; S.init(P, G, bx, (const LAS int*)(L + PAN_TAB_OFF), (long)DM * DFFE, 1);
            pg8::fill_grouped((LAS float*)(L + RS_TAB_OFF), (LAS unsigned short*)nullptr, S, ROWG_V, nullptr, tid, 1.f / WD_SCALE);
            pg8::EpiRowScaleBf16 E{YPB, DM, (const LAS float*)(L + RS_TAB_OFF)};
            pg8::gemm_phase<pg8::EpiRowScaleBf16, pg8::TailOrder, true, true, 1>(L + RING_OFF, g, S, E);
        }
        PE(PH_MOEDN)
    }
    SEAM(PH_MOEDN);
    if (IN(PH_FINAL)) {
        PB(PH_FINAL)
        int off[NE + 1]; off[0] = 0;
#pragma unroll
        for (int e = 0; e < NE; ++e) { const int c = (int)__hip_atomic_load(ECNT + 64 * e, RLX_AGENT); off[e + 1] = off[e] + ((c + 255) & ~255); }
        f32x4 gv[4];
#pragma unroll
        for (int j = 0; j < 4; ++j) gv[j] = *((const GAS f32x4*)final_g + lane + 64 * j);
#define ADD4(v_, a_) do { v_.x += bfbits2f((unsigned)(a_) & 0xffffu); v_.y += bfbits2f((unsigned)(a_) >> 16); v_.z += bfbits2f((unsigned)((a_) >> 32) & 0xffffu); v_.w += bfbits2f((unsigned)((a_) >> 48)); } while (0)
        for (int m0 = gw; m0 < MT; m0 += 8 * NGW) {
            int pa[8], pc[8];
#pragma unroll
            for (int k = 0; k < 8; ++k) { const int m = m0 + k * NGW; pa[k] = 0; pc[k] = 0;
                if (m < MT) { const int ea = TOKE[2 * m], ec = TOKE[2 * m + 1]; int oa = 0, oc = 0;
#pragma unroll
                    for (int q = 0; q < NE; ++q) { oa = (ea == q) ? off[q] : oa; oc = (ec == q) ? off[q] : oc; }
                    pa[k] = oa + TOKR[2 * m]; pc[k] = oc + TOKR[2 * m + 1]; } }
#pragma unroll
            for (int k = 0; k < 8; k += 2) {
                unsigned long long xa[2][4], ya[2][4], yc[2][4];
#pragma unroll
                for (int h = 0; h < 2; ++h) { const int m = m0 + (k + h) * NGW;
                    if (m < MT) { const GAS unsigned long long* xb = (const GAS unsigned long long*)(XR + (size_t)m * DM) + lane;
#pragma unroll
                        for (int j = 0; j < 4; ++j) xa[h][j] = xb[64 * j];
                        if (pa[k + h] < 32768) { const GAS unsigned long long* y = (const GAS unsigned long long*)(YB + (size_t)pa[k + h] * DM) + lane;
#pragma unroll
                            for (int j = 0; j < 4; ++j) ya[h][j] = y[64 * j]; }
                        if (pc[k + h] < 32768) { const GAS unsigned long long* y = (const GAS unsigned long long*)(YB + (size_t)pc[k + h] * DM) + lane;
#pragma unroll
                            for (int j = 0; j < 4; ++j) yc[h][j] = y[64 * j]; } } }
#pragma unroll
                for (int h = 0; h < 2; ++h) { const int m = m0 + (k + h) * NGW;
                    if (m < MT) { GAS f32x4* xr = (GAS f32x4*)(OUTF + (size_t)m * DM) + lane;
                        f32x4 v[4]; float s = 0.f;
#pragma unroll
                        for (int j = 0; j < 4; ++j) { const unsigned long long a = xa[h][j]; v[j] = (f32x4){bfbits2f((unsigned)a & 0xffffu), bfbits2f((unsigned)a >> 16), bfbits2f((unsigned)(a >> 32) & 0xffffu), bfbits2f((unsigned)(a >> 48))}; }
#pragma unroll
                        for (int side = 0; side < 2; ++side) { const int pos = side ? pc[k + h] : pa[k + h];
                            if (pos < 32768) {
#pragma unroll
                                for (int j = 0; j < 4; ++j) { const unsigned long long a = side ? yc[h][j] : ya[h][j]; ADD4(v[j], a); } }
                            else { unsigned long long tp[7][4];
#pragma unroll
                                for (int sl = 0; sl < 7; ++sl) { const GAS unsigned long long* y = (const GAS unsigned long long*)(YPB + ((size_t)sl * 2048 + (pos - 32768)) * DM) + lane;
#pragma unroll
                                    for (int j = 0; j < 4; ++j) tp[sl][j] = y[64 * j]; }
#pragma unroll
                                for (int sl = 0; sl < 7; ++sl) {
#pragma unroll
                                    for (int j = 0; j < 4; ++j) ADD4(v[j], tp[sl][j]); } } }
#pragma unroll
                        for (int j = 0; j < 4; ++j) s += (v[j].x * v[j].x + v[j].y * v[j].y) + (v[j].z * v[j].z + v[j].w * v[j].w);
                        const float rstd = 1.f / sqrtf(wave_sum(s) * (1.f / DM) + EPS);
#pragma unroll
                        for (int j = 0; j < 4; ++j) xr[64 * j] = v[j] * rstd * gv[j]; } }
            }
        }
#undef ADD4
        PE(PH_FINAL)
    }
#undef IN
}

#undef ws
#undef ctl
#undef X
extern "C" void kernel_launch(void* const* d_in, const int* in_sizes, int n_in, void* d_out, int out_size, void* d_ws, size_t ws_size, hipStream_t stream) {
    static int grid = 0;
    if (grid == 0) {
        if (n_in != 20 || in_sizes[0] != MT * DM || out_size != MT * DM || ws_size < WS_END) { fprintf(stderr, "kernel_launch: unexpected shapes / workspace (n_in %d, ws %zu < %zu); nothing launched\n", n_in, ws_size, (size_t)WS_END); grid = -1; return; }
        int dev = 0, cus = 0;
        if (hipGetDevice(&dev) != hipSuccess || hipDeviceGetAttribute(&cus, hipDeviceAttributeMultiprocessorCount, dev) != hipSuccess) { grid = -1; return; }
        if (hipFuncSetAttribute((const void*)mk_fwd, hipFuncAttributeMaxDynamicSharedMemorySize, LDS_BYTES) != hipSuccess) { fprintf(stderr, "kernel_launch: hipFuncSetAttribute failed\n"); grid = -1; return; }
        int per_cu = 0;
        if (hipOccupancyMaxActiveBlocksPerMultiprocessor(&per_cu, (const void*)mk_fwd, NWAVES * 64, LDS_BYTES) != hipSuccess || per_cu < 1) { fprintf(stderr, "kernel_launch: occupancy query reports %d workgroups per CU for %d B of LDS; the grid would not be resident; nothing launched\n", per_cu, LDS_BYTES); grid = -1; return; }
        (void)hipGetLastError();
        grid = cus;
    }
    if (grid < 0) return;
    (void)hipMemsetAsync((char*)d_ws + WS_CTL, 0, CTL_ZERO_BYTES, stream);
    Args a{};
    for (int i = 0; i < 20; ++i) a.in[i] = (const float*)d_in[i];
    a.out = (float*)d_out; a.ws = (unsigned char*)d_ws;
    auto run = [&](int lo, int hi) { a.ph_lo = lo; a.ph_hi = hi; hipLaunchKernelGGL(mk_fwd, dim3(grid), dim3(NWAVES * 64), LDS_BYTES, stream, a); };
    run(PH_PRO, PH_N);
}
```

```cpp
#include <hip/hip_runtime.h>
#include <cstdio>
#include <cstdint>
namespace pg8 {
#define PG8_LAS __attribute__((address_space(3)))
typedef unsigned short bf16_t;
typedef short bf16x8 __attribute__((ext_vector_type(8)));
typedef short bf16x16 __attribute__((ext_vector_type(16)));
typedef int i32x8 __attribute__((ext_vector_type(8)));
typedef float f32x4 __attribute__((ext_vector_type(4)));
typedef unsigned u32x4 __attribute__((ext_vector_type(4)));
constexpr int BM = 256, BK = 64, HALF = 128, HTB = HALF * BK * 2  , STAGE_BYTES = 8 * HTB, NXCD = 8;

__host__ __device__ __forceinline__ int lds_byte(int r, int c) { const int st = (r >> 4) * 2 + (c >> 5), rr = r & 15, cc = c & 31, ob = rr * 64 + cc * 2; return st * 1024 + (ob ^ (((ob >> 9) & 1) << 5)); }
__host__ __device__ __forceinline__ void stage_rc(int b, int& R, int& C) { const int st = b / 1024, sb = b % 1024, swz = sb ^ (((sb >> 9) & 1) << 5); R = (st >> 1) * 16 + swz / 64; C = (st & 1) * 32 + (swz % 64) / 2; }
__host__ __device__ __forceinline__ int perm32(int rho) { const int n = rho >> 4, i = rho & 15; return 8 * (i >> 2) + 4 * n + (i & 3); }

struct Unit { int pm, pn; long boff; int ord; int arow0, avalid; long aoff, ooff; };
struct Gemm { const bf16_t* A; const bf16_t* Bt; int M, N, K, ld; };

struct StaticOrder {
    int nM, nN, nwg, G, c, WGM;
    __host__ __device__ void init(int M, int N, int G_, int c_, int wgm = 4) { nM = M / BM; nN = N / BM; nwg = nM * nN; G = G_; c = c_; WGM = wgm; }
    __host__ __device__ bool next(int i, Unit& u) const {
        const long L = (long)i * G + c; if (L >= nwg) return false;
        int wgid = (int)L; { const int q = nwg / NXCD, r = nwg % NXCD, xcd = wgid % NXCD, off = wgid / NXCD; wgid = (xcd < r ? xcd * (q + 1) : r * (q + 1) + (xcd - r) * q) + off; }
        const int nig = WGM * nN, gid = wgid / nig, fm = gid * WGM, gsz = (nM - fm) < WGM ? (nM - fm) : WGM;
        u.pm = fm + ((wgid % nig) % gsz); u.pn = (wgid % nig) / gsz; u.boff = 0; u.ord = i; u.arow0 = 0; u.avalid = BM; u.aoff = 0; u.ooff = 0; return true;
    }
    static constexpr bool GATHER = false;
    __device__ __forceinline__ int arow(const Unit&, int r) const { return r; }
    __device__ __forceinline__ void a_ready(const Unit&) const {}
    __device__ __forceinline__ void done(const Unit&) const {}
};

__device__ __forceinline__ unsigned cvt_pk_bf16(float lo, float hi) { unsigned r; asm volatile("v_cvt_pk_bf16_f32 %0, %1, %2" : "=v"(r) : "v"(lo), "v"(hi)); return r; }
typedef float f32x2 __attribute__((ext_vector_type(2)));

__device__ __forceinline__ float rstd_of(const float* rss, int row) {
    const f32x4 a = *(const f32x4*)(rss + (size_t)row * 16), b = *(const f32x4*)(rss + (size_t)row * 16 + 4), c = *(const f32x4*)(rss + (size_t)row * 16 + 8), d = *(const f32x4*)(rss + (size_t)row * 16 + 12);
    const float s = (((a[0] + a[1]) + (a[2] + a[3])) + ((b[0] + b[1]) + (b[2] + b[3]))) + (((c[0] + c[1]) + (c[2] + c[3])) + ((d[0] + d[1]) + (d[2] + d[3])));
    return __builtin_amdgcn_rsqf(s * (1.f / 1024.f) + 1e-5f);
}
__device__ __forceinline__ void epi_st16(void* p, u32x4 w, bool nt) { if (nt) __builtin_nontemporal_store(w, (__attribute__((address_space(1))) u32x4*)p); else *(u32x4*)p = w; }
__device__ __forceinline__ void epi_st8(void* p, unsigned long long w, bool nt) { if (nt) __builtin_nontemporal_store(w, (__attribute__((address_space(1))) unsigned long long*)p); else *(unsigned long long*)p = w; }
struct EpiBf16 { static constexpr bool NT_LAST = true;
    static constexpr bool PERM = true, AFTER_DRAIN = false;
    bf16_t* O; int ldc; int scale_cols; float scale0; const PG8_LAS float* rs;
    __device__ __forceinline__ void operator()(const f32x4 (&acc)[2][2][4][2], const Unit& u, int wr, int wc, int fr, int fq, const bool nt) const {
        const int row0 = u.pm * BM + wr * 64 + fr; const int colt = u.pn * BM;
        const float sc = (colt < scale_cols) ? scale0 : 1.f;
        const int col0 = colt + wc * 32 + 8 * fq;
        const PG8_LAS float* rsu = rs + u.ord * 256 + wr * 64 + fr;
#pragma unroll
        for (int ai = 0; ai < 2; ++ai)
#pragma unroll
            for (int m = 0; m < 4; ++m) { bf16_t* rowp = O + (size_t)(row0 + ai * HALF + m * 16) * ldc + col0;
                const float rsv = sc * rsu[ai * HALF + m * 16];
#pragma unroll
                for (int bj = 0; bj < 2; ++bj) { f32x4 v0 = acc[ai][bj][m][0] * rsv, v1 = acc[ai][bj][m][1] * rsv;
                    u32x4 w; w.x = cvt_pk_bf16(v0[0], v0[1]); w.y = cvt_pk_bf16(v0[2], v0[3]); w.z = cvt_pk_bf16(v1[0], v1[1]); w.w = cvt_pk_bf16(v1[2], v1[3]);
                    epi_st16(rowp + bj * HALF, w, nt); } }
    }
};
__device__ __forceinline__ float silu_mul(float g, float u) { return g * u * __builtin_amdgcn_rcpf(1.f + __builtin_amdgcn_exp2f(-1.4426950408889634f * g)); }
__device__ __forceinline__ f32x2 silu_mul2(f32x2 g, f32x2 u) {
    const f32x2 t = g * (-1.4426950408889634f); f32x2 e; e.x = __builtin_amdgcn_exp2f(t.x); e.y = __builtin_amdgcn_exp2f(t.y);
    const f32x2 d = e + 1.0f; f32x2 r; r.x = __builtin_amdgcn_rcpf(d.x); r.y = __builtin_amdgcn_rcpf(d.y);
    return (g * u) * r;
}
__device__ __forceinline__ f32x2 silu_mul2s(f32x2 g, f32x2 u, const float cs, const float is2) {
    const f32x2 t = g * cs; f32x2 e; e.x = __builtin_amdgcn_exp2f(t.x); e.y = __builtin_amdgcn_exp2f(t.y);
    const f32x2 d = e * is2 + is2; f32x2 r; r.x = __builtin_amdgcn_rcpf(d.x); r.y = __builtin_amdgcn_rcpf(d.y);
    return (g * u) * r;
}
__device__ __forceinline__ float inv_sq_scale(float s) { return s > 0.f ? __builtin_amdgcn_rcpf(s * s) : 1e30f; }
struct EpiSwiGLU { static constexpr bool NT_LAST = true;
    static constexpr bool PERM = true, AFTER_DRAIN = false;
    bf16_t* O; int ldc; const PG8_LAS float* rs;
    __device__ __forceinline__ void operator()(const f32x4 (&acc)[2][2][4][2], const Unit& u, int wr, int wc, int fr, int fq, const bool nt) const {
        const int row0 = u.pm * BM + wr * 64 + fr; const int col0 = u.pn * HALF + wc * 32 + 8 * fq;
        const PG8_LAS float* rsu = rs + u.ord * 256 + wr * 64 + fr;
#pragma unroll
        for (int ai = 0; ai < 2; ++ai)
#pragma unroll
            for (int m = 0; m < 4; ++m) { bf16_t* rowp = O + (size_t)(row0 + ai * HALF + m * 16) * ldc + col0;
                const float rsv = rsu[ai * HALF + m * 16], cs = rsv * -1.4426950408889634f, is2 = inv_sq_scale(rsv);
                const f32x4 g0 = acc[ai][0][m][0], g1 = acc[ai][0][m][1], u0 = acc[ai][1][m][0], u1 = acc[ai][1][m][1];
                const f32x2 s0 = silu_mul2s((f32x2){g0[0], g0[1]}, (f32x2){u0[0], u0[1]}, cs, is2), s1 = silu_mul2s((f32x2){g0[2], g0[3]}, (f32x2){u0[2], u0[3]}, cs, is2), s2 = silu_mul2s((f32x2){g1[0], g1[1]}, (f32x2){u1[0], u1[1]}, cs, is2), s3 = silu_mul2s((f32x2){g1[2], g1[3]}, (f32x2){u1[2], u1[3]}, cs, is2);
                u32x4 w; w.x = cvt_pk_bf16(s0.x, s0.y); w.y = cvt_pk_bf16(s1.x, s1.y); w.z = cvt_pk_bf16(s2.x, s2.y); w.w = cvt_pk_bf16(s3.x, s3.y);
                epi_st16(rowp, w, nt); }
    }
};
struct EpiSwiGLU8 { static constexpr bool NT_LAST = true;
    static constexpr bool PERM = true, AFTER_DRAIN = false;
    unsigned char* O; int ldc; const PG8_LAS float* rs;
    __device__ __forceinline__ void operator()(const f32x4 (&acc)[2][2][4][2], const Unit& u, int wr, int wc, int fr, int fq, const bool nt) const {
        const int row0 = u.pm * BM + wr * 64 + fr; const int col0 = u.pn * HALF + wc * 32 + 8 * fq;
        const PG8_LAS float* rsu = rs + u.ord * 256 + wr * 64 + fr;
#pragma unroll
        for (int ai = 0; ai < 2; ++ai)
#pragma unroll
            for (int m = 0; m < 4; ++m) { unsigned char* rowp = O + (size_t)(row0 + ai * HALF + m * 16) * ldc + col0;
                const float rsv = rsu[ai * HALF + m * 16], cs = rsv * -1.4426950408889634f, is2 = inv_sq_scale(rsv);
                const f32x4 g0 = acc[ai][0][m][0], g1 = acc[ai][0][m][1], u0 = acc[ai][1][m][0], u1 = acc[ai][1][m][1];
                const f32x2 s0 = silu_mul2s((f32x2){g0[0], g0[1]}, (f32x2){u0[0], u0[1]}, cs, is2), s1 = silu_mul2s((f32x2){g0[2], g0[3]}, (f32x2){u0[2], u0[3]}, cs, is2), s2 = silu_mul2s((f32x2){g1[0], g1[1]}, (f32x2){u1[0], u1[1]}, cs, is2), s3 = silu_mul2s((f32x2){g1[2], g1[3]}, (f32x2){u1[2], u1[3]}, cs, is2);
                int w0 = __builtin_bit_cast(int, s0.x), w1 = __builtin_bit_cast(int, s2.x);
                w0 = __builtin_amdgcn_cvt_pk_fp8_f32(s0.x, s0.y, w0, false); w0 = __builtin_amdgcn_cvt_pk_fp8_f32(s1.x, s1.y, w0, true);
                w1 = __builtin_amdgcn_cvt_pk_fp8_f32(s2.x, s2.y, w1, false); w1 = __builtin_amdgcn_cvt_pk_fp8_f32(s3.x, s3.y, w1, true);
                epi_st8(rowp, (unsigned long long)(unsigned)w0 | ((unsigned long long)(unsigned)w1 << 32), nt); }
    }
};
struct EpiResAddNorm {     static constexpr bool NT_LAST = false;
    static constexpr bool PERM = true, AFTER_DRAIN = false;
    bf16_t* xr; int ldc; float* rss; unsigned char* X8; float asc;
    __device__ __forceinline__ void operator()(const f32x4 (&acc)[2][2][4][2], const Unit& u, int wr, int wc, int fr, int fq, const bool nt) const {
        const int col0 = u.pn * BM + wc * 32 + 8 * fq;
        u32x4 qv[8][2];
#define RA_LOAD(k_) do { const size_t o_ = (size_t)(u.pm * BM + ((k_) >> 2) * HALF + wr * 64 + ((k_) & 3) * 16 + fr) * ldc + col0; qv[k_][0] = *(const u32x4*)(xr + o_); qv[k_][1] = *(const u32x4*)(xr + o_ + HALF); } while (0)
        RA_LOAD(0); RA_LOAD(1);
#pragma unroll
        for (int k = 0; k < 8; ++k) { const int ai = k >> 2, m = k & 3;
            if (k + 2 < 8) RA_LOAD(k + 2);
            const int row = u.pm * BM + ai * HALF + wr * 64 + m * 16 + fr; const size_t off = (size_t)row * ldc + col0; float ss = 0.f;
#pragma unroll
            for (int bj = 0; bj < 2; ++bj) {
                const u32x4 q = qv[k][bj];
                const f32x4 b0 = (f32x4){__builtin_bit_cast(float, q.x << 16), __builtin_bit_cast(float, q.x & 0xffff0000u), __builtin_bit_cast(float, q.y << 16), __builtin_bit_cast(float, q.y & 0xffff0000u)};
                const f32x4 b1 = (f32x4){__builtin_bit_cast(float, q.z << 16), __builtin_bit_cast(float, q.z & 0xffff0000u), __builtin_bit_cast(float, q.w << 16), __builtin_bit_cast(float, q.w & 0xffff0000u)};
                const f32x4 v0 = b0 + acc[ai][bj][m][0] * asc, v1 = b1 + acc[ai][bj][m][1] * asc;
                { u32x4 w; w.x = cvt_pk_bf16(v0[0], v0[1]); w.y = cvt_pk_bf16(v0[2], v0[3]); w.z = cvt_pk_bf16(v1[0], v1[1]); w.w = cvt_pk_bf16(v1[2], v1[3]); epi_st16(xr + off + bj * HALF, w, nt); }
                ss += (v0[0] * v0[0] + v0[1] * v0[1]) + (v0[2] * v0[2] + v0[3] * v0[3]) + (v1[0] * v1[0] + v1[1] * v1[1]) + (v1[2] * v1[2] + v1[3] * v1[3]);
                if (X8) { int q0 = 0, q1 = 0;
                    q0 = __builtin_amdgcn_cvt_pk_fp8_f32(v0[0], v0[1], q0, false); q0 = __builtin_amdgcn_cvt_pk_fp8_f32(v0[2], v0[3], q0, true);
                    q1 = __builtin_amdgcn_cvt_pk_fp8_f32(v1[0], v1[1], q1, false); q1 = __builtin_amdgcn_cvt_pk_fp8_f32(v1[2], v1[3], q1, true);
                    epi_st8(X8 + off + bj * HALF, (unsigned long long)(unsigned)q0 | ((unsigned long long)(unsigned)q1 << 32), nt); } }
            { auto r16 = __builtin_amdgcn_permlane16_swap(__builtin_bit_cast(unsigned, ss), __builtin_bit_cast(unsigned, ss), false, false); ss += __builtin_bit_cast(float, (fq & 1) ? r16[0] : r16[1]);
              auto r32 = __builtin_amdgcn_permlane32_swap(__builtin_bit_cast(unsigned, ss), __builtin_bit_cast(unsigned, ss), false, false); ss += __builtin_bit_cast(float, (fq & 2) ? r32[0] : r32[1]); }
            if (fq == 0) rss[(size_t)row * 16 + u.pn * 4 + wc] = ss; }
#undef RA_LOAD
    }
};
struct EpiRowScaleBf16 { static constexpr bool NT_LAST = true;
    static constexpr bool PERM = true, AFTER_DRAIN = false;
    bf16_t* O; int ldc; const PG8_LAS float* rs;
    __device__ __forceinline__ void operator()(const f32x4 (&acc)[2][2][4][2], const Unit& u, int wr, int wc, int fr, int fq, const bool nt) const {
        const int row0 = u.pm * BM + wr * 64 + fr; const int col0 = u.pn * BM + wc * 32 + 8 * fq;
        const PG8_LAS float* rsu = rs + u.ord * 256 + wr * 64 + fr;
#pragma unroll
        for (int ai = 0; ai < 2; ++ai)
#pragma unroll
            for (int m = 0; m < 4; ++m) { const int row = row0 + ai * HALF + m * 16; const float sc = rsu[ai * HALF + m * 16]; bf16_t* rowp = O + u.ooff + (long)row * ldc + col0;
#pragma unroll
                for (int bj = 0; bj < 2; ++bj) { f32x4 v0 = acc[ai][bj][m][0] * sc, v1 = acc[ai][bj][m][1] * sc;
                    u32x4 w; w.x = cvt_pk_bf16(v0[0], v0[1]); w.y = cvt_pk_bf16(v0[2], v0[3]); w.z = cvt_pk_bf16(v1[0], v1[1]); w.w = cvt_pk_bf16(v1[2], v1[3]);
                    epi_st16(rowp + bj * HALF, w, nt); } }
    }
};
template <bool GATHER_> struct GroupedOrder {
    static constexpr bool GATHER = GATHER_;
    int nM, nN, nwg, G, c, WGM; const PG8_LAS int* pan; const PG8_LAS unsigned short* tok; long estride;
    __device__ void init(int nM_, int nN_, int G_, int c_, const PG8_LAS int* pan_, const PG8_LAS unsigned short* tok_, long estride_, int wgm = 4) { nM = nM_; nN = nN_; nwg = nM * nN; G = G_; c = c_; pan = pan_; tok = tok_; estride = estride_; WGM = wgm; }
    __device__ bool next(int i, Unit& u) const {
        const long L = (long)i * G + c; if (L >= nwg) return false;
        int wgid = (int)L; { const int q = nwg / NXCD, r = nwg % NXCD, xcd = wgid % NXCD, off = wgid / NXCD; wgid = (xcd < r ? xcd * (q + 1) : r * (q + 1) + (xcd - r) * q) + off; }
        const int nig = WGM * nN, gid = wgid / nig, fm = gid * WGM, gsz = (nM - fm) < WGM ? (nM - fm) : WGM;
        u.pm = fm + ((wgid % nig) % gsz); u.pn = (wgid % nig) / gsz;
        const int pe = __builtin_amdgcn_readfirstlane(pan[u.pm]); const int e = pe & 255, j = (pe >> 8) & 255;
        u.boff = (long)e * estride; u.ord = i; u.arow0 = e * 16384 + 256 * j; u.avalid = ((pe >> 16) & 255) + 1; u.aoff = 0; u.ooff = 0; return true;
    }
    __device__ __forceinline__ int arow(const Unit& u, int r) const { return (int)tok[u.ord * 256 + r]; }
    __device__ __forceinline__ void a_ready(const Unit&) const {}
    __device__ __forceinline__ void done(const Unit&) const {}
};
struct TailOrder {
    static constexpr bool GATHER = false;
    int ntail, G, c; const PG8_LAS int* pan; long estride; int es;
    __device__ void init(int P, int G_, int c_, const PG8_LAS int* pan_, long estride_, int es_) { ntail = (P - 128) * 4 * 7; G = G_; c = c_; pan = pan_; estride = estride_; es = es_; }
    __device__ bool next(int i, Unit& u) const {
        const int L = i * G + c; if (L >= ntail) return false;
        const int s = L % 7, t = L / 7; u.pn = t & 3; u.pm = 128 + (t >> 2);
        const int pe = __builtin_amdgcn_readfirstlane(pan[u.pm]); const int e = pe & 255, j = (pe >> 8) & 255;
        u.aoff = (long)s * 512 * es; u.boff = (long)e * estride + (long)s * 512 * es; u.ord = i; u.arow0 = e * 16384 + 256 * j; u.avalid = ((pe >> 16) & 255) + 1;
        u.ooff = ((long)s * 2048 - 32768) * 1024; return true;
    }
    __device__ __forceinline__ int arow(const Unit&, int r) const { return r; }
    __device__ __forceinline__ void a_ready(const Unit&) const {}
    __device__ __forceinline__ void done(const Unit&) const {}
};
template <int MODE, class Sched> __device__ __forceinline__ void fill_rs(PG8_LAS float* tab, const Sched& S, const float* src, int tid, const float mul = 1.f) {
    for (int idx = tid;; idx += 512) { Unit u; if (!S.next(idx >> 8, u)) break;
        const int row = u.pm * BM + (idx & 255);
        tab[idx] = ((MODE == 1) ? rstd_of(src, row) : src[row]) * mul; }
    asm volatile("s_waitcnt lgkmcnt(0)" ::: "memory"); __syncthreads();
}
template <class Sched> __device__ __forceinline__ void fill_grouped(PG8_LAS float* tab, PG8_LAS unsigned short* tok, const Sched& S, const float* srcv, const int* tokv, int tid, const float mul = 1.f) {
    for (int idx = tid;; idx += 512) { Unit u; if (!S.next(idx >> 8, u)) break;
        const int r = idx & 255; const bool v = r < u.avalid;
        tab[idx] = v ? srcv[u.arow0 + r] * mul : 0.f;
        if (tok) tok[idx] = (unsigned short)(v ? tokv[u.arow0 + r] : 0); }
    asm volatile("s_waitcnt lgkmcnt(0)" ::: "memory"); __syncthreads();
}

template <class Epi, class Sched, bool ALIGN_EPI = false, bool SP2 = false, int ES = 2>
__device__ __forceinline__ void gemm_phase(PG8_LAS unsigned char* lds, const Gemm g, const Sched& S, const Epi& E) {
    const int tid = threadIdx.x, wid = __builtin_amdgcn_readfirstlane(tid >> 6), lane = tid & 63, wr = wid >> 2, wc = wid & 3, fr = lane & 15, fq = lane >> 4;
    const int PBy = g.ld * ES, nt = g.K * ES / 128;
    unsigned voffA0[2], voffA1[2], voffB[2];
    const size_t kstep = (size_t)(BK * 2);
    const size_t hstep = (size_t)HALF * PBy;
#pragma unroll
    for (int i = 0; i < 2; ++i) { int R, C; stage_rc(tid * 16 + i * 8192, R, C); const int Rb = Epi::PERM ? ((R & ~31) + perm32(R & 31)) : R;
        voffA0[i] = (unsigned)(R * PBy + C * 2); voffA1[i] = voffA0[i] + (unsigned)hstep; voffB[i] = (unsigned)(Rb * PBy + C * 2); }
#define PG8_SETA(u_) do { if constexpr (Sched::GATHER) { _Pragma("unroll") for (int i_ = 0; i_ < 2; ++i_) { int R_, C_; stage_rc(tid * 16 + i_ * 8192, R_, C_); \
        voffA0[i_] = (unsigned)(S.arow(u_, R_) * PBy + C_ * 2); voffA1[i_] = (unsigned)(S.arow(u_, R_ + HALF) * PBy + C_ * 2); } } } while (0)
    const size_t tstep = 2 * hstep;
    const unsigned ldsw = (unsigned)wid * 1024u;
    const int aoff = lds_byte(wr * 64 + fr, fq * 8), boff = lds_byte(wc * 32 + fr, fq * 8);
#define PG8_SA(b, h) (((b) * 2 + (h)) * HTB)
#define PG8_SB(b, h) ((4 + (b) * 2 + (h)) * HTB)
#define PG8_STAGE(bufoff, gbase, voff) do { _Pragma("unroll") for (int _i = 0; _i < 2; ++_i) \
        __builtin_amdgcn_global_load_lds((const unsigned*)((const char*)(gbase) + (voff)[_i]), (PG8_LAS unsigned*)(lds + (bufoff) + ldsw + _i * 8192), 16, 0, 0); } while (0)
#define PG8_LD8(p_) ({ const u32x4 lo_ = *(const PG8_LAS u32x4*)(p_), hi_ = *(const PG8_LAS u32x4*)((p_) + 1024); (i32x8){(int)lo_.x, (int)lo_.y, (int)lo_.z, (int)lo_.w, (int)hi_.x, (int)hi_.y, (int)hi_.z, (int)hi_.w}; })
#define PG8_LDA(dst, b, h) do { if constexpr (ES == 2) { _Pragma("unroll") for (int m = 0; m < 4; ++m) _Pragma("unroll") for (int k = 0; k < 2; ++k) dst[m][k] = *(const PG8_LAS bf16x8*)(lds + PG8_SA(b, h) + aoff + m * 2048 + k * 1024); } \
        else { _Pragma("unroll") for (int m = 0; m < 4; ++m) dst##8[m] = PG8_LD8(lds + PG8_SA(b, h) + aoff + m * 2048); } } while (0)
#define PG8_LDB(dst, b, h) do { if constexpr (ES == 2) { _Pragma("unroll") for (int n = 0; n < 2; ++n) _Pragma("unroll") for (int k = 0; k < 2; ++k) dst[n][k] = *(const PG8_LAS bf16x8*)(lds + PG8_SB(b, h) + boff + n * 2048 + k * 1024); } \
        else { _Pragma("unroll") for (int n = 0; n < 2; ++n) dst##8[n] = PG8_LD8(lds + PG8_SB(b, h) + boff + n * 2048); } } while (0)
#define PG8_MMA(ai, bj, At, Bt) do { __builtin_amdgcn_s_setprio(1); _Pragma("unroll") for (int m = 0; m < 4; ++m) _Pragma("unroll") for (int n = 0; n < 2; ++n) { \
        if constexpr (ES == 2) { _Pragma("unroll") for (int k = 0; k < 2; ++k) acc[ai][bj][m][n] = __builtin_amdgcn_mfma_f32_16x16x32_bf16(Bt[n][k], At[m][k], acc[ai][bj][m][n], 0, 0, 0); } \
        else asm volatile("v_mfma_scale_f32_16x16x128_f8f6f4 %0, %1, %2, %0, %3, %3 op_sel_hi:[0,0,0]" : "+v"(acc[ai][bj][m][n]) : "v"(Bt##8[n]), "v"(At##8[m]), "v"(0x7F7F7F7F)); } \
        __builtin_amdgcn_s_setprio(0); } while (0)
#define PG8_WAIT_V(n) asm volatile("s_waitcnt vmcnt(" #n ")" ::: "memory")
#define PG8_WAIT_L(n) asm volatile("s_waitcnt lgkmcnt(" #n ")" ::: "memory")
#define PG8_BAR __builtin_amdgcn_s_barrier()
#define PG8_SCHED __builtin_amdgcn_sched_barrier(0)
    Unit cur, nxt; int ui = 0;
    if (!S.next(0, cur)) return;
    f32x4 acc[2][2][4][2];
#pragma unroll
    for (int a = 0; a < 2; ++a)
#pragma unroll
        for (int b = 0; b < 2; ++b)
#pragma unroll
            for (int m = 0; m < 4; ++m)
#pragma unroll
                for (int n = 0; n < 2; ++n) acc[a][b][m][n] = (f32x4){0.f, 0.f, 0.f, 0.f};
    bf16x8 At[4][2], B0[2][2], B1[2][2]; i32x8 At8[4], B08[2], B18[2];
    const char* cA = (const char*)g.A + (Sched::GATHER ? (size_t)0 : (size_t)cur.pm * tstep) + cur.aoff; const char* cB = (const char*)g.Bt + (size_t)cur.pn * tstep + cur.boff;
    S.a_ready(cur);
    static_assert(SP2, "only the two-super-phase loop is kept in this file");
    PG8_SETA(cur);
    {
        PG8_STAGE(PG8_SB(0, 0), cB, voffB); PG8_STAGE(PG8_SB(0, 1), cB + hstep, voffB); PG8_STAGE(PG8_SA(0, 0), cA, voffA0); PG8_STAGE(PG8_SA(0, 1), cA, voffA1);
        if (wr == 1) PG8_BAR;
        PG8_WAIT_V(2); PG8_BAR;
        PG8_STAGE(PG8_SB(1, 0), cB + kstep, voffB); PG8_STAGE(PG8_SA(1, 0), cA + kstep, voffA0); PG8_STAGE(PG8_SB(1, 1), cB + hstep + kstep, voffB);
        PG8_WAIT_V(6); PG8_BAR;
    }
    for (;;) {
        const bool has_next = S.next(ui + 1, nxt);
        const char* nA = has_next ? (const char*)g.A + (Sched::GATHER ? (size_t)0 : (size_t)nxt.pm * tstep) + nxt.aoff : cA; const char* nB = has_next ? (const char*)g.Bt + (size_t)nxt.pn * tstep + nxt.boff : cB;
        for (int t = 0; t < nt; t += 2) {
            const bool last = (t == nt - 2);
            const char* a1 = cA + (size_t)(t + 1) * kstep;
            const char* a2 = last ? nA : cA + (size_t)(t + 2) * kstep; const char* b2 = last ? nB : cB + (size_t)(t + 2) * kstep;
            const char* a3 = a2 + kstep; const char* b3 = b2 + kstep;
            if (last && has_next) S.a_ready(nxt);
            {
            PG8_LDB(B0, 0, 0); PG8_LDB(B1, 0, 1); PG8_SCHED; PG8_LDA(At, 0, 0); PG8_STAGE(PG8_SA(1, 1), a1, voffA1);
            if (last && has_next) PG8_SETA(nxt);
            PG8_WAIT_V(8); PG8_WAIT_L(0); PG8_BAR; PG8_MMA(0, 0, At, B0); PG8_MMA(0, 1, At, B1); PG8_BAR; PG8_SCHED;
            PG8_LDA(At, 0, 1); PG8_STAGE(PG8_SB(0, 0), b2, voffB); PG8_STAGE(PG8_SB(0, 1), b2 + hstep, voffB); PG8_STAGE(PG8_SA(0, 0), a2, voffA0);
            PG8_WAIT_V(8); PG8_WAIT_L(0); PG8_BAR; PG8_MMA(1, 0, At, B0); PG8_MMA(1, 1, At, B1); PG8_BAR; PG8_SCHED;
            PG8_LDB(B0, 1, 0); PG8_LDB(B1, 1, 1); PG8_SCHED; PG8_LDA(At, 1, 0); PG8_STAGE(PG8_SA(0, 1), a2, voffA1);
            PG8_WAIT_V(8); PG8_WAIT_L(0); PG8_BAR; PG8_MMA(0, 0, At, B0); PG8_MMA(0, 1, At, B1); PG8_BAR; PG8_SCHED;
            PG8_LDA(At, 1, 1); PG8_STAGE(PG8_SB(1, 0), b3, voffB); PG8_STAGE(PG8_SB(1, 1), b3 + hstep, voffB); PG8_STAGE(PG8_SA(1, 0), a3, voffA0);
            PG8_WAIT_V(8); PG8_WAIT_L(0); PG8_BAR; PG8_MMA(1, 0, At, B0); PG8_MMA(1, 1, At, B1); PG8_BAR; PG8_SCHED;
            }
        }
        if constexpr (ALIGN_EPI) { if (wr == 0) PG8_BAR; }
        if constexpr (ES == 1) asm volatile("s_nop 15\n\ts_nop 15\n\ts_nop 15" ::: "memory");
        if constexpr (!Epi::AFTER_DRAIN) { E(acc, cur, wr, wc, fr, fq, !has_next && Epi::NT_LAST); S.done(cur); }
        if (!has_next) break;
#pragma unroll
        for (int a = 0; a < 2; ++a)
#pragma unroll
            for (int b = 0; b < 2; ++b)
#pragma unroll
                for (int m = 0; m < 4; ++m)
#pragma unroll
                    for (int n = 0; n < 2; ++n) acc[a][b][m][n] = (f32x4){0.f, 0.f, 0.f, 0.f};
        cur = nxt; cA = nA; cB = nB; ++ui;
        if constexpr (ALIGN_EPI) { if (wr == 1) PG8_BAR; }
    }
    PG8_WAIT_V(0);
    if constexpr (!ALIGN_EPI) { if (wr == 0) PG8_BAR; }
    PG8_BAR;
    if constexpr (Epi::AFTER_DRAIN) { E.fused(acc, cur, wr, wc, fr, fq, lds, wid, lane); S.done(cur); }
#undef PG8_SA
#undef PG8_SB
#undef PG8_STAGE
#undef PG8_SETA
#undef PG8_LDA
#undef PG8_LDB
#undef PG8_MMA
#undef PG8_LD8
#undef PG8_WAIT_V
#undef PG8_WAIT_L
#undef PG8_BAR
#undef PG8_SCHED
}
}

#define GAS __attribute__((address_space(1)))
#define LAS __attribute__((address_space(3)))
typedef unsigned short bf16;
typedef unsigned v4u __attribute__((ext_vector_type(4)));
typedef float f32x4 __attribute__((ext_vector_type(4)));
typedef short bf16x8 __attribute__((ext_vector_type(8)));
typedef GAS unsigned gu32;
typedef GAS unsigned long long gu64;
#define RLX_AGENT __ATOMIC_RELAXED, __HIP_MEMORY_SCOPE_AGENT
#define LDS_WAIT() asm volatile("s_waitcnt lgkmcnt(0)" ::: "memory")
#define VM_WAIT() asm volatile("s_waitcnt vmcnt(0)" ::: "memory")
__device__ __forceinline__ unsigned long long rt() { return __builtin_amdgcn_s_memrealtime(); }
__device__ __forceinline__ unsigned f2bf(float f) { unsigned u = __builtin_bit_cast(unsigned, f); return (u + 0x7fffu + ((u >> 16) & 1u)) >> 16; }
__device__ __forceinline__ unsigned pk2(float lo, float hi) { return f2bf(lo) | (f2bf(hi) << 16); }

#define XB_TMO      128
#define XB_XCNT(j)  (256  + 64 * (j))
#define XB_XSUB(j)  (1280 + 64 * (j))
#define XB_XGEN(j)  (2304 + 64 * (j))
#define XB_TOP      3328
#define XB_TOPGEN   3392
#define XCD_BAR_WORDS 3456
#define XB_SPIN_CAP (1u << 18)

__device__ __forceinline__ unsigned xb_ld(unsigned* p)              { return __hip_atomic_load(p, __ATOMIC_RELAXED, __HIP_MEMORY_SCOPE_AGENT); }
__device__ __forceinline__ unsigned xb_add(unsigned* p, unsigned v) { return __hip_atomic_fetch_add(p, v, __ATOMIC_RELAXED, __HIP_MEMORY_SCOPE_AGENT); }
__device__ __forceinline__ unsigned xb_xcc_id() { return (unsigned)__builtin_amdgcn_s_getreg((3 << 11) | 20) & 0xFu; }
#define XB_SPIN(cond, bar) do { unsigned _sp = 0; while (cond) { __builtin_amdgcn_s_sleep(1); \
    if ((++_sp & 255u) == 0u) { if (xb_ld(&(bar)[XB_TMO])) break; if (_sp > XB_SPIN_CAP) { atomicAdd(&(bar)[XB_TMO], 1u); break; } } } } while (0)

struct XcdBarrier {
    unsigned* bar; unsigned x;
    volatile LAS unsigned* st;
};

__device__ __forceinline__ XcdBarrier xcd_barrier_post(unsigned* bar, volatile LAS unsigned* st) {
    XcdBarrier b; b.bar = bar; b.x = xb_xcc_id(); b.st = st;
    if (threadIdx.x == 0) (void)xb_add(&bar[XB_XCNT(b.x)], 1u);
    return b;
}
__device__ __forceinline__ void xcd_barrier_complete(unsigned* bar, unsigned x, unsigned& nloc, unsigned& nx) {
    const unsigned G = gridDim.x * gridDim.y * gridDim.z;
    unsigned sum, cnt, mine, sp = 0u;
    for (;;) {
        sum = 0u; cnt = 0u; mine = 0u;
#pragma unroll
        for (unsigned j = 0; j < 16; ++j) { const unsigned c = xb_ld(&bar[XB_XCNT(j)]); sum += c; cnt += (c > 0u) ? 1u : 0u; mine = (j == x) ? c : mine; }
        if (sum == G) break;
        __builtin_amdgcn_s_sleep(1);
        if ((++sp & 255u) == 0u) { if (xb_ld(&bar[XB_TMO])) break; if (sp > XB_SPIN_CAP) { atomicAdd(&bar[XB_TMO], 1u); break; } }
    }
    nloc = mine > 0u ? mine : 1u; nx = cnt > 0u ? cnt : 1u;
}

__device__ __forceinline__ void xcd_barrier(const XcdBarrier& b) {
    asm volatile("s_waitcnt vmcnt(0)" ::: "memory");
    __syncthreads();
    if (threadIdx.x == 0) {
        unsigned* bar = b.bar;
        __builtin_amdgcn_s_waitcnt(0);
        unsigned nloc = b.st[0], nx = b.st[1];
        if (nloc == 0u) { xcd_barrier_complete(bar, b.x, nloc, nx); b.st[0] = nloc; b.st[1] = nx; }
        const unsigned old = xb_add(&bar[XB_XSUB(b.x)], 1u);
        const unsigned gen = old / nloc;
        if (old + 1u == (gen + 1u) * nloc) {
            __builtin_amdgcn_fence(__ATOMIC_RELEASE, "agent");
            asm volatile("s_waitcnt vmcnt(0)" ::: "memory");
            const unsigned og = xb_add(&bar[XB_TOP], 1u);
            const unsigned tg = og / nx;
            if (og + 1u == (tg + 1u) * nx) xb_add(&bar[XB_TOPGEN], 1u);
            else XB_SPIN(xb_ld(&bar[XB_TOPGEN]) == tg, bar);
            __builtin_amdgcn_fence(__ATOMIC_ACQUIRE, "agent");
            xb_add(&bar[XB_XGEN(b.x)], 1u);
            asm volatile("s_waitcnt vmcnt(0)" ::: "memory");
        } else {
            XB_SPIN(xb_ld(&bar[XB_XGEN(b.x)]) == gen, bar);
            __builtin_amdgcn_fence(__ATOMIC_ACQUIRE, "agent");
            asm volatile("s_waitcnt vmcnt(0)" ::: "memory");
        }
    }
    __syncthreads();
}

__device__ __forceinline__ void xcd_arrive(const XcdBarrier& b, unsigned* bar2) {
    asm volatile("s_waitcnt vmcnt(0)" ::: "memory");
    __syncthreads();
    if (threadIdx.x == 0) {
        __builtin_amdgcn_s_waitcnt(0);
        const unsigned nloc = b.st[0], nx = b.st[1];
        const unsigned old = xb_add(&bar2[XB_XSUB(b.x)], 1u);
        const unsigned gen = old / nloc;
        if (old + 1u == (gen + 1u) * nloc) {
            __builtin_amdgcn_fence(__ATOMIC_RELEASE, "agent");
            asm volatile("s_waitcnt vmcnt(0)" ::: "memory");
            const unsigned og = xb_add(&bar2[XB_TOP], 1u);
            const unsigned tg = og / nx;
            if (og + 1u == (tg + 1u) * nx) xb_add(&bar2[XB_TOPGEN], 1u);
        }
    }
}
__device__ __forceinline__ void xcd_wait(const XcdBarrier& b, unsigned* bar2, const unsigned g) {
    if (threadIdx.x == 0) {
        XB_SPIN(xb_ld(&bar2[XB_TOPGEN]) < g, b.bar);
        __builtin_amdgcn_fence(__ATOMIC_ACQUIRE, "agent");
        asm volatile("s_waitcnt vmcnt(0)" ::: "memory");
    }
    __syncthreads();
}

__device__ __forceinline__ float bf2f(bf16 v) { return __builtin_bit_cast(float, (unsigned)v << 16); }
__device__ __forceinline__ float bfbits2f(unsigned bits) { return __builtin_bit_cast(float, bits << 16); }

constexpr int NWAVES = 8;
constexpr int BATCH = 8, SEQ = 2048, DM = 1024, MT = BATCH * SEQ;
constexpr int DINP = 3080, NPROJ = 3072;
constexpr int OQ = 0, OK_ = 512, OV = 1024, OZ = 1536, OXBC = 2048;
constexpr int NH = 8, HD = 64, SSTATE = 128;
constexpr int DFF = 2816, DFFE = 3584, NE = 8;
constexpr int MOE_ROWS = 2 * MT + NE * 256;
constexpr float EPS = 1e-5f;
constexpr int NE_PRO = 5;
constexpr float WU_SCALE = 32.f;
constexpr float WD_SCALE = 64.f;

constexpr size_t MiB = 1u << 20;
constexpr size_t WS_CTL = 0, CTL_ZERO_BYTES = 1 * MiB;
constexpr size_t WS_DTRAW = 1 * MiB, WS_DTV = WS_DTRAW + 512 * 1024;
constexpr size_t WS_TOKE = 2 * MiB, WS_TOKR = WS_TOKE + 128 * 1024, WS_TOKG = WS_TOKR + 128 * 1024, WS_TOKP = WS_TOKG + 128 * 1024;
constexpr size_t WS_ROWG = 2 * MiB + 512 * 1024, WS_ROWS = WS_ROWG + 160 * 1024, WS_PTAB = 3 * MiB, WS_WDT = 3 * MiB + 64 * 1024;
constexpr size_t WS_RTOKV = 1 * MiB, WS_RGV = 1 * MiB + 512 * 1024, WS_RSV = 3 * MiB + 256 * 1024;
constexpr size_t WS_RSS = 424 * MiB;
constexpr size_t WS_R1 = 4 * MiB;
constexpr size_t WS_WIN = 116 * MiB, WS_WOUT = 128 * MiB, WS_WDGU = 132 * MiB, WS_WDD = 143 * MiB;
constexpr size_t WS_AO = 149 * MiB;
constexpr size_t WS_R2 = 116 * MiB;
constexpr size_t WS_R3 = 184 * MiB;
constexpr size_t WS_PROJ = WS_R3, WS_HB = WS_R3, WS_XN = 428 * MiB;
constexpr size_t WS_XBCC = 312 * MiB, WS_ATTRAW = 328 * MiB, WS_XR = 344 * MiB, WS_YRAW = 376 * MiB;
constexpr size_t WS_ST2 = 408 * MiB;
constexpr size_t WS_END = 460 * MiB;
static_assert(WS_R3 + (size_t)MOE_ROWS * DFFE * 2 <= WS_END && WS_R2 + (size_t)MOE_ROWS * DM * 2 <= WS_R3 && WS_WDD + (size_t)DM * DFF * 2 <= WS_AO, "ws map");
constexpr int CW_TMO = 0, CW_CODE = 1, CW_BAR = 4096, CW_BAR2 = 8192, CW_ECNT = 16384;

constexpr int RING_OFF = 0, RING_BYTES = 159744;
constexpr int LDSCTL_OFF = RING_BYTES, MISC_OFF = LDSCTL_OFF + 320;
constexpr int TOK_TAB_OFF = 131072 + 15360, PAN_TAB_OFF = TOK_TAB_OFF + 7680;
constexpr int RS_TAB_OFF = 131072;
constexpr int LDS_BYTES = 163840;

typedef const float* cfp;
struct Args { const float* in[20]; float* out; unsigned char* ws; int ph_lo, ph_hi; };
static_assert(sizeof(Args) == 184, "Args layout");

template <int CTRL, int RMASK> __device__ __forceinline__ float dpp_addf(float v) {
    return v + __builtin_bit_cast(float, __builtin_amdgcn_update_dpp(0, __builtin_bit_cast(int, v), CTRL, RMASK, 0xf, true)); }
__device__ __forceinline__ float half_sums(float x) { x = dpp_addf<0xB1, 0xf>(x); x = dpp_addf<0x4E, 0xf>(x); x = dpp_addf<0x141, 0xf>(x); x = dpp_addf<0x140, 0xf>(x); return dpp_addf<0x142, 0xa>(x); }
__device__ __forceinline__ float wave_sum(float v) {
    const float x = half_sums(v);
    return __builtin_bit_cast(float, __builtin_amdgcn_readlane(__builtin_bit_cast(int, x), 31)) + __builtin_bit_cast(float, __builtin_amdgcn_readlane(__builtin_bit_cast(int, x), 63));
}
__device__ __forceinline__ void transpose_item(const float* W, int ldw, bf16* WT, int K, int k0, int n0, int drow0, LAS unsigned char* scr, int lane, const float* gk = nullptr) {
    const int kq = lane >> 4, n4 = lane & 15;
    const float* src = W + (size_t)(k0 + 16 * kq) * ldw + n0 + 4 * n4;
    f32x4 v[16];
#pragma unroll
    for (int i = 0; i < 16; ++i) v[i] = __builtin_nontemporal_load((const GAS f32x4*)(src + (size_t)i * ldw));
    if (gk) {
#pragma unroll
        for (int i = 0; i < 16; ++i) v[i] = v[i] * gk[k0 + 16 * kq + i]; }
#pragma unroll
    for (int j = 0; j < 4; ++j) {
        v4u a, b;
        a.x = pk2(v[0][j], v[1][j]); a.y = pk2(v[2][j], v[3][j]); a.z = pk2(v[4][j], v[5][j]); a.w = pk2(v[6][j], v[7][j]);
        b.x = pk2(v[8][j], v[9][j]); b.y = pk2(v[10][j], v[11][j]); b.z = pk2(v[12][j], v[13][j]); b.w = pk2(v[14][j], v[15][j]);
        LAS unsigned char* p = scr + (4 * n4 + j) * 144 + kq * 32;
        *(LAS v4u*)p = a; *(LAS v4u*)(p + 16) = b; }
    LDS_WAIT(); asm volatile("" ::: "memory");
#pragma unroll
    for (int i = 0; i < 8; ++i) { const int n = 8 * i + (lane >> 3), c = lane & 7;
        __builtin_nontemporal_store(*(const LAS v4u*)(scr + n * 144 + c * 16), (GAS v4u*)(WT + (size_t)(drow0 + n) * K + k0 + 8 * c)); }
    LDS_WAIT(); asm volatile("" ::: "memory");
}
__device__ __forceinline__ void transpose_item8(const float* W, int ldw, unsigned char* WT, int K, int k0, int n0, int drow0, float scale, LAS unsigned char* scr, int lane, const float* gk = nullptr) {
    const int kq = lane >> 4, n4 = lane & 15;
    const float* src = W + (size_t)(k0 + 16 * kq) * ldw + n0 + 4 * n4;
    f32x4 v[16];
#pragma unroll
    for (int i = 0; i < 16; ++i) v[i] = __builtin_nontemporal_load((const GAS f32x4*)(src + (size_t)i * ldw)) * (gk ? scale * gk[k0 + 16 * kq + i] : scale);
#pragma unroll
    for (int j = 0; j < 4; ++j) { int w[4];
#pragma unroll
        for (int q = 0; q < 4; ++q) { w[q] = __builtin_amdgcn_cvt_pk_fp8_f32(v[4 * q][j], v[4 * q + 1][j], 0, false); w[q] = __builtin_amdgcn_cvt_pk_fp8_f32(v[4 * q + 2][j], v[4 * q + 3][j], w[q], true); }
        *(LAS v4u*)(scr + (4 * n4 + j) * 80 + kq * 16) = (v4u){(unsigned)w[0], (unsigned)w[1], (unsigned)w[2], (unsigned)w[3]}; }
    LDS_WAIT(); asm volatile("" ::: "memory");
#pragma unroll
    for (int i = 0; i < 4; ++i) { const int idx = lane + 64 * i, n = idx >> 2, c = idx & 3;
        __builtin_nontemporal_store(*(const LAS v4u*)(scr + n * 80 + c * 16), (GAS v4u*)(WT + (size_t)(drow0 + n) * K + k0 + 16 * c)); }
    LDS_WAIT(); asm volatile("" ::: "memory");
}
__device__ __forceinline__ void conv_plain(const float* W, int ldw, int K, int N, bf16* WT, int it, LAS unsigned char* scr, int lane, const float* gk = nullptr) {
    const int nblk = N / 64, kb = it / nblk, nb = it % nblk;
    transpose_item(W, ldw, WT, K, 64 * kb, 64 * nb, 64 * nb, scr, lane, gk);
}
__device__ __forceinline__ void conv_gu(const float* Wg, const float* Wu, int K, int F, bf16* WT, int it, LAS unsigned char* scr, int lane, const float* gk = nullptr) {
    const int nblk = F / 64, per = (K / 64) * nblk, half = it / per, r = it % per, kb = r / nblk, nb = r % nblk, f0 = 64 * nb;
    transpose_item(half ? Wu : Wg, F, WT, K, 64 * kb, f0, (f0 / 128) * 256 + half * 128 + (f0 % 128), scr, lane, gk);
}

__device__ __forceinline__ void xb_rows(const float* Xf, const float* g, bf16* XBo, float* rss, int gw, int NGW, int lane) {
    f32x4 gv[4];
#pragma unroll
    for (int j = 0; j < 4; ++j) gv[j] = *((const GAS f32x4*)g + lane + 64 * j);
    for (int m0 = gw; m0 < MT; m0 += 4 * NGW) {
        f32x4 v[4][4];
#pragma unroll
        for (int k = 0; k < 4; ++k) { const int mc = min(m0 + k * NGW, MT - 1); const GAS f32x4* xr = (const GAS f32x4*)(Xf + (size_t)mc * DM) + lane;
#pragma unroll
            for (int j = 0; j < 4; ++j) v[k][j] = __builtin_nontemporal_load(xr + 64 * j); }
#pragma unroll
        for (int k = 0; k < 4; ++k) { const int m = m0 + k * NGW;
            if (m < MT) { float s = 0.f;
#pragma unroll
                for (int j = 0; j < 4; ++j) s += (v[k][j].x * v[k][j].x + v[k][j].y * v[k][j].y) + (v[k][j].z * v[k][j].z + v[k][j].w * v[k][j].w);
                s = wave_sum(s);
                GAS unsigned long long* o8 = (GAS unsigned long long*)(XBo + (size_t)m * DM) + lane;
#pragma unroll
                for (int j = 0; j < 4; ++j) o8[64 * j] = (unsigned long long)pk2(v[k][j].x, v[k][j].y) | ((unsigned long long)pk2(v[k][j].z, v[k][j].w) << 32);
                if (lane < 16) rss[(size_t)m * 16 + lane] = lane ? 0.f : s; } }
    }
}
__device__ __forceinline__ void route_rows(const bf16* XBi, const float* gain, const float* rss, const LAS float* tab, LAS int* lcnt, int* toke, int* tokr, int* rtokv, float* rgv, float* rsv, gu32* ecnt, int gw, int NGW, int lane, int tid) {
    const f32x4 ga0 = *(const GAS f32x4*)(gain + 8 * lane), ga1 = *(const GAS f32x4*)(gain + 8 * lane + 4), gb0 = *(const GAS f32x4*)(gain + 512 + 8 * lane), gb1 = *(const GAS f32x4*)(gain + 512 + 8 * lane + 4);
    f32x4 rt[8][4];
#pragma unroll
    for (int q = 0; q < 8; ++q) { const LAS float* t = tab + q * 1024 + 8 * lane; rt[q][0] = *(const LAS f32x4*)t; rt[q][1] = *(const LAS f32x4*)(t + 4); rt[q][2] = *(const LAS f32x4*)(t + 512); rt[q][3] = *(const LAS f32x4*)(t + 516); }
    for (int m0 = 0; m0 < MT; m0 += 8 * NGW) {
        if (tid < 16) lcnt[tid] = 0;
        LDS_WAIT(); __syncthreads();
        int ee[8], ll[8]; float gg[8], rr[8];
#pragma unroll
        for (int r = 0; r < 8; ++r) { const int m = m0 + r * NGW + gw; ee[r] = -1; ll[r] = 0; gg[r] = 0.f; rr[r] = 0.f;
            if (m < MT) {
        const v4u u0 = *(const GAS v4u*)(XBi + (size_t)m * DM + 8 * lane), u1 = *(const GAS v4u*)(XBi + (size_t)m * DM + 512 + 8 * lane);
        const float h0[8] = {bfbits2f(u0.x & 0xffffu) * ga0.x, bfbits2f(u0.x >> 16) * ga0.y, bfbits2f(u0.y & 0xffffu) * ga0.z, bfbits2f(u0.y >> 16) * ga0.w, bfbits2f(u0.z & 0xffffu) * ga1.x, bfbits2f(u0.z >> 16) * ga1.y, bfbits2f(u0.w & 0xffffu) * ga1.z, bfbits2f(u0.w >> 16) * ga1.w};
        const float h1[8] = {bfbits2f(u1.x & 0xffffu) * gb0.x, bfbits2f(u1.x >> 16) * gb0.y, bfbits2f(u1.y & 0xffffu) * gb0.z, bfbits2f(u1.y >> 16) * gb0.w, bfbits2f(u1.z & 0xffffu) * gb1.x, bfbits2f(u1.z >> 16) * gb1.y, bfbits2f(u1.w & 0xffffu) * gb1.z, bfbits2f(u1.w >> 16) * gb1.w};
        float d[8];
#pragma unroll
        for (int q = 0; q < 8; ++q) { const f32x4 a0 = rt[q][0], a1 = rt[q][1], b0 = rt[q][2], b1 = rt[q][3];
            d[q] = ((h0[0] * a0.x + h0[1] * a0.y) + (h0[2] * a0.z + h0[3] * a0.w)) + ((h0[4] * a1.x + h0[5] * a1.y) + (h0[6] * a1.z + h0[7] * a1.w))
                 + ((h1[0] * b0.x + h1[1] * b0.y) + (h1[2] * b0.z + h1[3] * b0.w)) + ((h1[4] * b1.x + h1[5] * b1.y) + (h1[6] * b1.z + h1[7] * b1.w)); }
#pragma unroll
        for (int q = 0; q < 8; ++q) d[q] = wave_sum(d[q]);
        if (lane == 0) {
            const float rstd = pg8::rstd_of(rss, m);
            int e1 = 0; float v1 = d[0];
#pragma unroll
            for (int q = 1; q < 8; ++q) if (d[q] > v1) { v1 = d[q]; e1 = q; }
            int e2 = -1; float v2 = -3.0e38f;
#pragma unroll
            for (int q = 0; q < 8; ++q) if (q != e1 && d[q] > v2) { v2 = d[q]; e2 = q; }
            const int l1 = __hip_atomic_fetch_add(lcnt + e1, 1, __ATOMIC_RELAXED, __HIP_MEMORY_SCOPE_WORKGROUP), l2 = __hip_atomic_fetch_add(lcnt + e2, 1, __ATOMIC_RELAXED, __HIP_MEMORY_SCOPE_WORKGROUP);
            ee[r] = e1 | (e2 << 4); ll[r] = l1 | (l2 << 16); gg[r] = 1.f / (1.f + expf((v2 - v1) * rstd)); rr[r] = rstd;
        } } }
        LDS_WAIT(); __syncthreads();
        if (tid < 8) lcnt[8 + tid] = (int)__hip_atomic_fetch_add(ecnt + 64 * tid, (unsigned)lcnt[tid], RLX_AGENT);
        LDS_WAIT(); __syncthreads();
        if (lane == 0) {
#pragma unroll
            for (int r = 0; r < 8; ++r) if (ee[r] >= 0) { const int m = m0 + r * NGW + gw, e1 = ee[r] & 15, e2 = ee[r] >> 4, r1 = lcnt[8 + e1] + (ll[r] & 0xffff), r2 = lcnt[8 + e2] + (ll[r] >> 16);
                const float g1 = gg[r], g2 = 1.f - g1, rstd = rr[r];
                toke[2 * m] = e1; toke[2 * m + 1] = e2; tokr[2 * m] = r1; tokr[2 * m + 1] = r2;
                rtokv[e1 * 16384 + r1] = m; rtokv[e2 * 16384 + r2] = m; rgv[e1 * 16384 + r1] = g1; rgv[e2 * 16384 + r2] = g2; rsv[e1 * 16384 + r1] = rstd; rsv[e2 * 16384 + r2] = rstd; } }
        LDS_WAIT(); __syncthreads();
    }
}
__device__ __forceinline__ void load_tab8(const float* W, int ldw, LAS float* tab, int tid) {
    for (int i = tid; i < 8192; i += NWAVES * 64) { const int k = i >> 3, j = i & 7; tab[j * 1024 + k] = W[(size_t)k * ldw + j]; }
    LDS_WAIT(); __syncthreads();
}

namespace sba {
typedef float f32x16 __attribute__((ext_vector_type(16)));
typedef short v4i16_t __attribute__((ext_vector_type(4)));
__device__ __forceinline__ v4i16_t vtr(const LAS char* p) { return __builtin_amdgcn_ds_read_tr16_b64_v4i16((LAS v4i16_t*)p); }
typedef float f32x2_t __attribute__((ext_vector_type(2))); typedef __bf16 bf16x2_t __attribute__((ext_vector_type(2)));
__device__ __forceinline__ unsigned cvtpk(float lo, float hi) { f32x2_t v = {lo, hi}; bf16x2_t b = __builtin_convertvector(v, bf16x2_t); return __builtin_bit_cast(unsigned, b); }
__device__ __forceinline__ float hsum32(float v) { auto rr = __builtin_amdgcn_permlane32_swap(__float_as_uint(v), __float_as_uint(v), false, false); return __uint_as_float(rr[0]) + __uint_as_float(rr[1]); }
constexpr int ATT_LDS = 131072 + 4096;
constexpr float RSTOP = 104.f * 1.4426950408889634f;
__device__ __forceinline__ void glds16(const void* gsrc, unsigned lds_dst) { unsigned keep;
    asm volatile("s_mov_b32 %0, m0\n\ts_mov_b32 m0, %2\n\ts_nop 0\n\tglobal_load_lds_dwordx4 %1, off\n\ts_mov_b32 m0, %0" : "=&s"(keep) : "v"(gsrc), "s"(lds_dst) : "memory"); }

__device__ __forceinline__ void attn_unit(const int b, const int qt2, const bf16* __restrict__ P, const float* __restrict__ gattn, bf16* __restrict__ AOo, LAS unsigned char* lds, const int wave, const int lane, const int parity) {
    const int h = wave, r32 = lane & 31, hi = lane >> 5;
    LAS char* vl = (LAS char*)lds + wave * 16384;
    LAS float* red = (LAS float*)(lds + 131072) + parity * 512;
    const size_t row0 = (size_t)b * SEQ;
    bf16x8 qa[4], qb[4];
#pragma unroll
    for (int ks = 0; ks < 4; ++ks) { qa[ks] = *(const bf16x8*)(P + (row0 + 64 * qt2 + r32) * NPROJ + OQ + h * 64 + 16 * ks + 8 * hi); qb[ks] = *(const bf16x8*)(P + (row0 + 64 * qt2 + 32 + r32) * NPROJ + OQ + h * 64 + 16 * ks + 8 * hi); }
    f32x16 oa0, oa1, ob0, ob1;
#pragma unroll
    for (int r = 0; r < 16; ++r) { oa0[r] = 0.f; oa1[r] = 0.f; ob0[r] = 0.f; ob1[r] = 0.f; }
    float Ra = 1.f, Rb = 1.f;
    const int grp = lane >> 4, i16 = lane & 15;
    const LAS char* vrd = vl + 4096 + (4 * (grp >> 1) + (i16 >> 2)) * 128 + (16 * (grp & 1) + 4 * (i16 & 3)) * 2;
    const LAS char* krd = vl + r32 * 128;
    const unsigned vdma = (unsigned)__builtin_amdgcn_readfirstlane((int)(unsigned)(uintptr_t)vl);
    const bf16* ksrc = P + (row0 + (lane >> 3)) * NPROJ + OK_ + h * 64 + (((lane & 7) ^ ((lane >> 3) & 7)) * 8);
    const bf16* vsrc = P + (row0 + (lane >> 3)) * NPROJ + OV + h * 64 + (lane & 7) * 8;
#define SBA_ISSUE(SLOT, kt_) do { const size_t ko_ = (size_t)(kt_) * 32 * NPROJ; \
        _Pragma("unroll") for (int i = 0; i < 4; ++i) glds16(ksrc + ko_ + (size_t)(8 * i) * NPROJ, vdma + (SLOT) * 8192 + i * 1024); \
        _Pragma("unroll") for (int i = 0; i < 4; ++i) glds16(vsrc + ko_ + (size_t)(8 * i) * NPROJ, vdma + (SLOT) * 8192 + 4096 + i * 1024); } while (0)
#define SBA_BLOCK(QR, O0, O1, R, DIAG) do { \
        f32x16 p; \
        _Pragma("unroll") for (int r = 0; r < 16; ++r) p[r] = 0.f; \
        _Pragma("unroll") for (int ks = 0; ks < 4; ++ks) p = __builtin_amdgcn_mfma_f32_32x32x16_bf16(kf[ks], QR[ks], p, 0, 0, 0); \
        if (DIAG) { _Pragma("unroll") for (int r = 0; r < 16; ++r) { const int kl = (r & 3) + 8 * (r >> 2) + 4 * hi; if (kl >= r32) p[r] = -1.0e30f; } } \
        float sg[16], qn[16], G[4], PG[4];                       \
        _Pragma("unroll") for (int r = 0; r < 16; ++r) { const float e = __builtin_amdgcn_exp2f(fminf(p[r], 126.f)); const float qq = __builtin_amdgcn_rcpf(1.f + e); qn[r] = qq; sg[r] = e * qq; } \
        _Pragma("unroll") for (int g = 0; g < 4; ++g) { G[g] = (qn[4 * g] * qn[4 * g + 1]) * (qn[4 * g + 2] * qn[4 * g + 3]); \
            auto rr_ = __builtin_amdgcn_permlane32_swap(__float_as_uint(G[g]), __float_as_uint(G[g]), false, false); PG[g] = __uint_as_float(hi ? rr_[0] : rr_[1]); }     \
        float base[4]; \
        { float acc = R; \
          _Pragma("unroll") for (int g = 3; g >= 0; --g) { base[g] = hi == 0 ? acc * PG[g] : acc; acc *= G[g] * PG[g]; } \
          R = acc; } \
        float w[16]; \
        _Pragma("unroll") for (int g = 0; g < 4; ++g) { float lat = base[g]; \
            _Pragma("unroll") for (int i = 3; i >= 0; --i) { const int r = 4 * g + i; w[r] = sg[r] * lat; lat *= qn[r]; } } \
        v4u pb0, pb1; \
        pb0.x = cvtpk(w[0], w[1]); pb0.y = cvtpk(w[2], w[3]); pb0.z = cvtpk(w[4], w[5]); pb0.w = cvtpk(w[6], w[7]); \
        pb1.x = cvtpk(w[8], w[9]); pb1.y = cvtpk(w[10], w[11]); pb1.z = cvtpk(w[12], w[13]); pb1.w = cvtpk(w[14], w[15]); \
        const bf16x8 b0 = __builtin_bit_cast(bf16x8, pb0), b1 = __builtin_bit_cast(bf16x8, pb1); \
        O0 = __builtin_amdgcn_mfma_f32_32x32x16_bf16(vf00, b0, O0, 0, 0, 0); O0 = __builtin_amdgcn_mfma_f32_32x32x16_bf16(vf01, b1, O0, 0, 0, 0); \
        O1 = __builtin_amdgcn_mfma_f32_32x32x16_bf16(vf10, b0, O1, 0, 0, 0); O1 = __builtin_amdgcn_mfma_f32_32x32x16_bf16(vf11, b1, O1, 0, 0, 0); \
    } while (0)
#define SBA_TILE(SLOT, kt_) do { \
        if ((kt_) >= 1) asm volatile("s_waitcnt vmcnt(8)" ::: "memory"); else asm volatile("s_waitcnt vmcnt(0)" ::: "memory");     \
        bf16x8 kf[4]; \
        _Pragma("unroll") for (int ks = 0; ks < 4; ++ks) kf[ks] = *(const LAS bf16x8*)(krd + (SLOT) * 8192 + (((2 * ks + hi) ^ (r32 & 7)) * 16)); \
        const LAS char* vr_ = vrd + (SLOT) * 8192; \
        const v4i16_t a00 = vtr(vr_), a01 = vtr(vr_ + 8 * 128), a02 = vtr(vr_ + 16 * 128), a03 = vtr(vr_ + 24 * 128); \
        const v4i16_t a10 = vtr(vr_ + 64), a11 = vtr(vr_ + 8 * 128 + 64), a12 = vtr(vr_ + 16 * 128 + 64), a13 = vtr(vr_ + 24 * 128 + 64); \
        asm volatile("s_waitcnt lgkmcnt(0)" ::: "memory");      \
        if ((kt_) >= 2) SBA_ISSUE(SLOT, (kt_) - 2); \
        const bf16x8 vf00 = {a00[0], a00[1], a00[2], a00[3], a01[0], a01[1], a01[2], a01[3]}, vf01 = {a02[0], a02[1], a02[2], a02[3], a03[0], a03[1], a03[2], a03[3]}; \
        const bf16x8 vf10 = {a10[0], a10[1], a10[2], a10[3], a11[0], a11[1], a11[2], a11[3]}, vf11 = {a12[0], a12[1], a12[2], a12[3], a13[0], a13[1], a13[2], a13[3]}; \
        if (!doneB) { SBA_BLOCK(qb, ob0, ob1, Rb, (kt_) == 2 * qt2 + 1); doneB = __all(Rb == 0.f); } \
        if ((kt_) <= 2 * qt2 && !doneA) { SBA_BLOCK(qa, oa0, oa1, Ra, (kt_) == 2 * qt2); doneA = __all(Ra == 0.f); } \
    } while (0)
    SBA_ISSUE(0, 2 * qt2 + 1); SBA_ISSUE(1, 2 * qt2);
    asm volatile("" : "+v"(qa[0]), "+v"(qa[1]), "+v"(qa[2]), "+v"(qa[3]), "+v"(qb[0]), "+v"(qb[1]), "+v"(qb[2]), "+v"(qb[3]));
    bool doneA = false, doneB = false;
    for (int kt = 2 * qt2 + 1;;) {
        SBA_TILE(0, kt); if (kt == 0 || (doneA && doneB)) break; --kt;
        SBA_TILE(1, kt); if (kt == 0 || (doneA && doneB)) break; --kt;
    }
    asm volatile("s_waitcnt vmcnt(0)" ::: "memory");
#undef SBA_TILE
#undef SBA_BLOCK
#undef SBA_ISSUE
    float ssa = 0.f, ssb = 0.f;
#pragma unroll
    for (int r = 0; r < 16; ++r) { ssa += oa0[r] * oa0[r] + oa1[r] * oa1[r]; ssb += ob0[r] * ob0[r] + ob1[r] * ob1[r]; }
    ssa = hsum32(ssa); ssb = hsum32(ssb);
    if (hi == 0) { red[h * 64 + r32] = ssa; red[h * 64 + 32 + r32] = ssb; }
    LDS_WAIT(); __syncthreads();
    float ta = 0.f, tb = 0.f;
#pragma unroll
    for (int j = 0; j < 8; ++j) { ta += red[j * 64 + r32]; tb += red[j * 64 + 32 + r32]; }
    const float rsa = 1.f / sqrtf(ta * (1.f / 512.f) + EPS), rsb = 1.f / sqrtf(tb * (1.f / 512.f) + EPS);
#pragma unroll
    for (int db = 0; db < 2; ++db)
#pragma unroll
        for (int g = 0; g < 4; ++g) { const int d = 32 * db + 8 * g + 4 * hi; const f32x4 gv = *(const f32x4*)(gattn + h * 64 + d);
            const f32x16& xa = db ? oa1 : oa0; const f32x16& xb = db ? ob1 : ob0;
            const unsigned la = cvtpk(xa[4 * g] * rsa * gv.x, xa[4 * g + 1] * rsa * gv.y), ha = cvtpk(xa[4 * g + 2] * rsa * gv.z, xa[4 * g + 3] * rsa * gv.w);
            const unsigned lb = cvtpk(xb[4 * g] * rsb * gv.x, xb[4 * g + 1] * rsb * gv.y), hb = cvtpk(xb[4 * g + 2] * rsb * gv.z, xb[4 * g + 3] * rsb * gv.w);
            *(LAS unsigned long long*)(vl + r32 * 128 + d * 2) = (unsigned long long)la | ((unsigned long long)ha << 32);
            *(LAS unsigned long long*)(vl + (32 + r32) * 128 + d * 2) = (unsigned long long)lb | ((unsigned long long)hb << 32); }
    LDS_WAIT();
#pragma unroll
    for (int i = 0; i < 8; ++i) { const int row = (lane >> 3) + 8 * i; const v4u v = *(const LAS v4u*)(vl + row * 128 + (lane & 7) * 16);
        *(v4u*)(AOo + (row0 + 64 * qt2 + row) * 1024 + h * 64 + (lane & 7) * 8) = v; }
    LDS_WAIT();
}
}
namespace ssd {
typedef float f32x16 __attribute__((ext_vector_type(16)));
typedef short v4i16_t __attribute__((ext_vector_type(4)));
constexpr int RS = 272, XRS = 528;
constexpr int OFF_B = 0, OFF_C = 128 * RS, OFF_X = 2 * 128 * RS, OFF_TAB = OFF_X + 128 * XRS, OFF_T = OFF_C;
constexpr int TAB_HEAD = 2048, TAB_ACUM = 0, TAB_DT = 512, TAB_CF = 1024, TAB_DECS = 1536;
constexpr int OFF_DTP = OFF_TAB + 4 * TAB_HEAD;
constexpr int LDS_NEED = OFF_DTP + 8192;
constexpr float LOG2E = 1.4426950408889634f;
__device__ __forceinline__ v4i16_t vtr(const LAS char* p) { return __builtin_amdgcn_ds_read_tr16_b64_v4i16((LAS v4i16_t*)p); }
typedef float f32x2_t __attribute__((ext_vector_type(2))); typedef __bf16 bf16x2_t __attribute__((ext_vector_type(2)));
__device__ __forceinline__ unsigned cvtpk(float lo, float hi) { f32x2_t v = {lo, hi}; bf16x2_t b = __builtin_convertvector(v, bf16x2_t); return __builtin_bit_cast(unsigned, b); }
__device__ __forceinline__ float bflo(unsigned u) { return __builtin_bit_cast(float, u << 16); }
__device__ __forceinline__ float bfhi(unsigned u) { return __builtin_bit_cast(float, u & 0xffff0000u); }
__device__ __forceinline__ float ex(float x) { return __builtin_amdgcn_exp2f(LOG2E * x); }
__device__ __forceinline__ int crow(int r, int hi) { return (r & 3) + 8 * (r >> 2) + 4 * hi; }

struct ATensors { const bf16* PROJ; const float* cw; const float* cb; const float* dtraw; const float* dtbias; const float* alog; const float* dskip;
                  bf16* YD; bf16* ST; bf16* CC; float* ACUM; };

__device__ __forceinline__ void phaseA_unit(const int b, const int c, const int g, const ATensors& T, LAS unsigned char* lds, const int wave, const int lane) {
    const int r32 = lane & 31, hi = lane >> 5, grp = lane >> 4, i16 = lane & 15;
    const int tok0 = b * SEQ + c * 128;
    LAS char* L = (LAS char*)lds;
    if (wave < 4) {
        const int h = g * 4 + wave; const float a = -expf(T.alog[h]), bias = T.dtbias[h];
        LAS float* tab = (LAS float*)(L + OFF_TAB + wave * TAB_HEAD);
        const int l0 = 2 * lane;
        float z0 = T.dtraw[(size_t)(tok0 + l0) * 8 + h] + bias, z1 = T.dtraw[(size_t)(tok0 + l0 + 1) * 8 + h] + bias;
        const float d0 = (z0 > 20.f) ? z0 : log1pf(expf(z0)), d1 = (z1 > 20.f) ? z1 : log1pf(expf(z1));
        const float a0 = d0 * a, a1 = d1 * a, ps = a0 + a1;
        float inc = ps;
#pragma unroll
        for (int o = 1; o < 64; o <<= 1) { const float t = __shfl_up(inc, o); if (lane >= o) inc += t; }
        const float exc = inc - ps, c0 = exc + a0, c1 = exc + ps;
        const float alast = __shfl(inc, 63);
        tab[TAB_ACUM / 4 + l0] = c0; tab[TAB_ACUM / 4 + l0 + 1] = c1; tab[TAB_DT / 4 + l0] = d0; tab[TAB_DT / 4 + l0 + 1] = d1;
        LDS_WAIT();
        const float eb = tab[TAB_ACUM / 4 + (l0 | 31)];
        tab[TAB_CF / 4 + l0] = ex(eb - c0) * d0; tab[TAB_CF / 4 + l0 + 1] = ex(eb - c1) * d1;
        tab[TAB_DECS / 4 + l0] = ex(alast - c0) * d0; tab[TAB_DECS / 4 + l0 + 1] = ex(alast - c1) * d1;
        T.ACUM[(size_t)(tok0 + l0) * 8 + h] = c0; T.ACUM[(size_t)(tok0 + l0 + 1) * 8 + h] = c1;
    }
    {
        const int scol = (lane < 32) ? (g * 256 + lane * 8) : (lane < 48) ? (512 + g * 128 + (lane - 32) * 8) : (768 + g * 128 + (lane - 48) * 8);
        float wt[4][8], bs[8];
#pragma unroll
        for (int k = 0; k < 4; ++k) { const f32x4 w0 = *(const f32x4*)(T.cw + k * 1024 + scol), w1 = *(const f32x4*)(T.cw + k * 1024 + scol + 4);
            wt[k][0] = w0.x; wt[k][1] = w0.y; wt[k][2] = w0.z; wt[k][3] = w0.w; wt[k][4] = w1.x; wt[k][5] = w1.y; wt[k][6] = w1.z; wt[k][7] = w1.w; }
        { const f32x4 b0 = *(const f32x4*)(T.cb + scol), b1 = *(const f32x4*)(T.cb + scol + 4); bs[0] = b0.x; bs[1] = b0.y; bs[2] = b0.z; bs[3] = b0.w; bs[4] = b1.x; bs[5] = b1.y; bs[6] = b1.z; bs[7] = b1.w; }
        const bf16* src = T.PROJ + (size_t)(tok0 + 16 * wave) * NPROJ + OXBC + scol;
        const bool first = (c == 0) && (wave == 0);
        v4u raw[19];
#pragma unroll
        for (int j = 0; j < 19; ++j) { const v4u zz = {0u, 0u, 0u, 0u}; raw[j] = (first && j < 3) ? zz : *(const v4u*)(src + (long)(j - 3) * NPROJ); }
        LAS char* dst = (lane < 32) ? (L + OFF_X + lane * 16) : (lane < 48) ? (L + OFF_B + (lane - 32) * 16) : (L + OFF_C + (lane - 48) * 16);
        const int drs = (lane < 32) ? XRS : RS;
#pragma unroll
        for (int j = 0; j < 16; ++j) {
            float o[8];
#pragma unroll
            for (int i = 0; i < 8; ++i) o[i] = bs[i];
#pragma unroll
            for (int k = 0; k < 4; ++k) { const v4u rv = raw[j + k];
                o[0] += wt[k][0] * bflo(rv.x); o[1] += wt[k][1] * bfhi(rv.x); o[2] += wt[k][2] * bflo(rv.y); o[3] += wt[k][3] * bfhi(rv.y);
                o[4] += wt[k][4] * bflo(rv.z); o[5] += wt[k][5] * bfhi(rv.z); o[6] += wt[k][6] * bflo(rv.w); o[7] += wt[k][7] * bfhi(rv.w); }
#pragma unroll
            for (int i = 0; i < 8; ++i) o[i] = o[i] * __builtin_amdgcn_rcpf(1.f + __builtin_amdgcn_exp2f(-LOG2E * o[i]));
            v4u pk; pk.x = cvtpk(o[0], o[1]); pk.y = cvtpk(o[2], o[3]); pk.z = cvtpk(o[4], o[5]); pk.w = cvtpk(o[6], o[7]);
            const int l = 16 * wave + j;
            *(LAS v4u*)(dst + l * drs) = pk;
            if (lane >= 48) *(v4u*)(T.CC + (size_t)(tok0 + l) * 256 + g * 128 + (lane - 48) * 8) = pk;
        }
    }
    LDS_WAIT(); __syncthreads();
    f32x16 t0, t1;
#pragma unroll
    for (int r = 0; r < 16; ++r) { t0[r] = 0.f; t1[r] = 0.f; }
    {
        const int ti = wave, lb = (ti >= 6) ? 3 : (ti >= 3) ? 2 : (ti >= 1) ? 1 : 0, sb = ti - lb * (lb + 1) / 2;
        const LAS char* ap = L + OFF_B + (32 * sb + r32) * RS + 16 * hi; const LAS char* bp = L + OFF_C + (32 * lb + r32) * RS + 16 * hi;
#pragma unroll
        for (int ks = 0; ks < 8; ++ks) t0 = __builtin_amdgcn_mfma_f32_32x32x16_bf16(*(const LAS bf16x8*)(ap + 32 * ks), *(const LAS bf16x8*)(bp + 32 * ks), t0, 0, 0, 0);
        if (wave < 2) { const int sb2 = 2 + wave;
            const LAS char* ap2 = L + OFF_B + (32 * sb2 + r32) * RS + 16 * hi; const LAS char* bp2 = L + OFF_C + (96 + r32) * RS + 16 * hi;
#pragma unroll
            for (int ks = 0; ks < 8; ++ks) t1 = __builtin_amdgcn_mfma_f32_32x32x16_bf16(*(const LAS bf16x8*)(ap2 + 32 * ks), *(const LAS bf16x8*)(bp2 + 32 * ks), t1, 0, 0, 0); }
    }
    LDS_WAIT(); __syncthreads();
    {
        LAS char* tp = L + OFF_T + wave * 2048 + lane * 32;
        v4u w0, w1; w0.x = cvtpk(t0[0], t0[1]); w0.y = cvtpk(t0[2], t0[3]); w0.z = cvtpk(t0[4], t0[5]); w0.w = cvtpk(t0[6], t0[7]);
        w1.x = cvtpk(t0[8], t0[9]); w1.y = cvtpk(t0[10], t0[11]); w1.z = cvtpk(t0[12], t0[13]); w1.w = cvtpk(t0[14], t0[15]);
        *(LAS v4u*)tp = w0; *(LAS v4u*)(tp + 16) = w1;
        if (wave < 2) { LAS char* tp2 = L + OFF_T + (8 + wave) * 2048 + lane * 32;
            w0.x = cvtpk(t1[0], t1[1]); w0.y = cvtpk(t1[2], t1[3]); w0.z = cvtpk(t1[4], t1[5]); w0.w = cvtpk(t1[6], t1[7]);
            w1.x = cvtpk(t1[8], t1[9]); w1.y = cvtpk(t1[10], t1[11]); w1.z = cvtpk(t1[12], t1[13]); w1.w = cvtpk(t1[14], t1[15]);
            *(LAS v4u*)tp2 = w0; *(LAS v4u*)(tp2 + 16) = w1; }
    }
    LDS_WAIT(); __syncthreads();
    const int hl = wave >> 1, ph = wave & 1, h = g * 4 + hl;
    const LAS float* tab = (const LAS float*)(L + OFF_TAB + hl * TAB_HEAD);
    const float Dh = T.dskip[h];
    bf16x8 xf[8];
    {
        const LAS char* xp = L + OFF_X + (4 * (grp >> 1) + (i16 >> 2)) * XRS + (hl * 64 + 32 * ph + 16 * (grp & 1) + 4 * (i16 & 3)) * 2;
#pragma unroll
        for (int ks = 0; ks < 8; ++ks) { const v4i16_t a0 = vtr(xp + (16 * ks) * XRS), a1 = vtr(xp + (16 * ks + 8) * XRS);
            xf[ks] = (bf16x8){a0[0], a0[1], a0[2], a0[3], a1[0], a1[1], a1[2], a1[3]}; }
    }
#pragma unroll
    for (int lb = 0; lb < 4; ++lb) {
        f32x16 y;
#pragma unroll
        for (int r = 0; r < 16; ++r) y[r] = 0.f;
        const float acl = tab[TAB_ACUM / 4 + 32 * lb + r32];
#pragma unroll
        for (int sb = 0; sb <= lb; ++sb) {
            const LAS char* tp = L + OFF_T + (lb * (lb + 1) / 2 + sb) * 2048 + lane * 32;
            const v4u q0 = *(const LAS v4u*)tp, q1 = *(const LAS v4u*)(tp + 16);
            float tv[16] = {bflo(q0.x), bfhi(q0.x), bflo(q0.y), bfhi(q0.y), bflo(q0.z), bfhi(q0.z), bflo(q0.w), bfhi(q0.w),
                            bflo(q1.x), bfhi(q1.x), bflo(q1.y), bfhi(q1.y), bflo(q1.z), bfhi(q1.z), bflo(q1.w), bfhi(q1.w)};
            float m[16];
            if (sb < lb) {
                const float rowf = ex(acl - tab[TAB_ACUM / 4 + 32 * sb + 31]);
#pragma unroll
                for (int q = 0; q < 4; ++q) { const f32x4 cf = *(const LAS f32x4*)(tab + TAB_CF / 4 + 32 * sb + 8 * q + 4 * hi);
                    m[4 * q] = tv[4 * q] * (rowf * cf.x); m[4 * q + 1] = tv[4 * q + 1] * (rowf * cf.y); m[4 * q + 2] = tv[4 * q + 2] * (rowf * cf.z); m[4 * q + 3] = tv[4 * q + 3] * (rowf * cf.w); }
            } else {
#pragma unroll
                for (int q = 0; q < 4; ++q) { const f32x4 as = *(const LAS f32x4*)(tab + TAB_ACUM / 4 + 32 * sb + 8 * q + 4 * hi), ds = *(const LAS f32x4*)(tab + TAB_DT / 4 + 32 * sb + 8 * q + 4 * hi);
                    const float asv[4] = {as.x, as.y, as.z, as.w}, dsv[4] = {ds.x, ds.y, ds.z, ds.w};
#pragma unroll
                    for (int i = 0; i < 4; ++i) { const int sl = 8 * q + 4 * hi + i;
                        const float f = (sl <= r32) ? ex(acl - asv[i]) * dsv[i] : 0.f;
                        m[4 * q + i] = tv[4 * q + i] * f + ((sl == r32) ? Dh : 0.f); } }
            }
            v4u p0, p1; p0.x = cvtpk(m[0], m[1]); p0.y = cvtpk(m[2], m[3]); p0.z = cvtpk(m[4], m[5]); p0.w = cvtpk(m[6], m[7]);
            p1.x = cvtpk(m[8], m[9]); p1.y = cvtpk(m[10], m[11]); p1.z = cvtpk(m[12], m[13]); p1.w = cvtpk(m[14], m[15]);
            y = __builtin_amdgcn_mfma_f32_32x32x16_bf16(__builtin_bit_cast(bf16x8, p0), xf[2 * sb], y, 0, 0, 0);
            y = __builtin_amdgcn_mfma_f32_32x32x16_bf16(__builtin_bit_cast(bf16x8, p1), xf[2 * sb + 1], y, 0, 0, 0);
        }
        v4u* yp = (v4u*)T.YD + ((size_t)((((b * 16 + c) * 2 + g) * 8 + wave) * 4 + lb) * 2) * 64 + lane;
#pragma unroll
        for (int rh = 0; rh < 2; ++rh) yp[rh * 64] = (v4u){cvtpk(y[8 * rh], y[8 * rh + 1]), cvtpk(y[8 * rh + 2], y[8 * rh + 3]), cvtpk(y[8 * rh + 4], y[8 * rh + 5]), cvtpk(y[8 * rh + 6], y[8 * rh + 7])};
    }
    {
        f32x16 xs[4];
#pragma unroll
        for (int nb = 0; nb < 4; ++nb)
#pragma unroll
            for (int r = 0; r < 16; ++r) xs[nb][r] = 0.f;
        const LAS char* bp = L + OFF_B + (4 * (grp >> 1) + (i16 >> 2)) * RS + (16 * (grp & 1) + 4 * (i16 & 3)) * 2;
#pragma unroll
        for (int ks = 0; ks < 8; ++ks) {
            const f32x4 e0 = *(const LAS f32x4*)(tab + TAB_DECS / 4 + 16 * ks + 4 * hi), e1 = *(const LAS f32x4*)(tab + TAB_DECS / 4 + 16 * ks + 8 + 4 * hi);
            const v4u xu = __builtin_bit_cast(v4u, xf[ks]);
            v4u su; su.x = cvtpk(bflo(xu.x) * e0.x, bfhi(xu.x) * e0.y); su.y = cvtpk(bflo(xu.y) * e0.z, bfhi(xu.y) * e0.w);
            su.z = cvtpk(bflo(xu.z) * e1.x, bfhi(xu.z) * e1.y); su.w = cvtpk(bflo(xu.w) * e1.z, bfhi(xu.w) * e1.w);
            const bf16x8 sx = __builtin_bit_cast(bf16x8, su);
#pragma unroll
            for (int nb = 0; nb < 4; ++nb) { const v4i16_t a0 = vtr(bp + (16 * ks) * RS + nb * 64), a1 = vtr(bp + (16 * ks + 8) * RS + nb * 64);
                xs[nb] = __builtin_amdgcn_mfma_f32_32x32x16_bf16((bf16x8){a0[0], a0[1], a0[2], a0[3], a1[0], a1[1], a1[2], a1[3]}, sx, xs[nb], 0, 0, 0); }
        }
        v4u* sp = (v4u*)T.ST + (size_t)((b * 16 + c) * 8 + h) * 1024 + (size_t)(ph * 8) * 64 + lane;
#pragma unroll
        for (int nb = 0; nb < 4; ++nb)
#pragma unroll
            for (int rh = 0; rh < 2; ++rh) sp[(nb * 2 + rh) * 64] = (v4u){cvtpk(xs[nb][8 * rh], xs[nb][8 * rh + 1]), cvtpk(xs[nb][8 * rh + 2], xs[nb][8 * rh + 3]), cvtpk(xs[nb][8 * rh + 4], xs[nb][8 * rh + 5]), cvtpk(xs[nb][8 * rh + 6], xs[nb][8 * rh + 7])};
    }
    LDS_WAIT(); __syncthreads();
}

__device__ __forceinline__ void scan_states(const bf16* ST, bf16* SF, const float* ACUM, const int gtid, const int nthr) {
    for (int e = gtid; e < BATCH * 8 * 1024; e += nthr) {
        const int bh = e >> 10, b = bh >> 3, h = bh & 7, q = e & 1023;
        float S[8];
#pragma unroll
        for (int j = 0; j < 8; ++j) S[j] = 0.f;
        v4u v[16]; float dc[16];
#pragma unroll
        for (int c = 0; c < 16; ++c) { v[c] = *((const v4u*)ST + (size_t)((b * 16 + c) * 8 + h) * 1024 + q); dc[c] = ACUM[(size_t)(b * SEQ + c * 128 + 127) * 8 + h]; }
#pragma unroll
        for (int c = 0; c < 16; ++c) {
            *((v4u*)SF + (size_t)((b * 16 + c) * 8 + h) * 1024 + q) = (v4u){cvtpk(S[0], S[1]), cvtpk(S[2], S[3]), cvtpk(S[4], S[5]), cvtpk(S[6], S[7])};
            const float d = ex(dc[c]);
            S[0] = S[0] * d + bflo(v[c].x); S[1] = S[1] * d + bfhi(v[c].x); S[2] = S[2] * d + bflo(v[c].y); S[3] = S[3] * d + bfhi(v[c].y);
            S[4] = S[4] * d + bflo(v[c].z); S[5] = S[5] * d + bfhi(v[c].z); S[6] = S[6] * d + bflo(v[c].w); S[7] = S[7] * d + bfhi(v[c].w); }
    }
}

struct BTensors { const bf16* PROJ; const bf16* YD; const bf16* SF; const bf16* CC; const float* ACUM; const float* gssd; bf16* AO; };

__device__ __forceinline__ void phaseB_unit(const int b, const int c, const int g, const BTensors& T, LAS unsigned char* lds, const int wave, const int lane, const int tid) {
    const int r32 = lane & 31, hi = lane >> 5;
    const int tok0 = b * SEQ + c * 128;
    LAS char* L = (LAS char*)lds;
#pragma unroll
    for (int i = 0; i < 4; ++i) { const int ch = tid + 512 * i, row = ch >> 4, cc = ch & 15;
        *(LAS v4u*)(L + OFF_C + row * RS + cc * 16) = *(const v4u*)(T.CC + (size_t)(tok0 + row) * 256 + g * 128 + cc * 8); }
    { const int hl = tid >> 7, l = tid & 127; ((LAS float*)(L + OFF_TAB))[hl * 128 + l] = ex(T.ACUM[(size_t)(tok0 + l) * 8 + g * 4 + hl]); }
    LDS_WAIT(); __syncthreads();
    const int hl = wave >> 1, ph = wave & 1, h = g * 4 + hl;
    bf16x8 sf[8];
    {
        const bf16x8* sp = (const bf16x8*)T.SF + (size_t)((((b * 16 + c) * 8 + h) * 2 + ph) * 8) * 64 + lane;
#pragma unroll
        for (int ks = 0; ks < 8; ++ks) sf[ks] = sp[ks * 64];
    }
    const LAS float* ea = (const LAS float*)(L + OFF_TAB) + hl * 128;
#pragma unroll
    for (int lb = 0; lb < 4; ++lb) {
        f32x16 y;
#pragma unroll
        for (int r = 0; r < 16; ++r) y[r] = 0.f;
        const LAS char* cp = L + OFF_C + (32 * lb + r32) * RS + 8 * hi;
#pragma unroll
        for (int ks = 0; ks < 8; ++ks) { const unsigned long long c0 = *(const LAS unsigned long long*)(cp + 32 * ks), c1 = *(const LAS unsigned long long*)(cp + 32 * ks + 16);
            v4u cu; cu.x = (unsigned)c0; cu.y = (unsigned)(c0 >> 32); cu.z = (unsigned)c1; cu.w = (unsigned)(c1 >> 32);
            y = __builtin_amdgcn_mfma_f32_32x32x16_bf16(__builtin_bit_cast(bf16x8, cu), sf[ks], y, 0, 0, 0); }
        const v4u* ydp = (const v4u*)T.YD + ((size_t)((((b * 16 + c) * 2 + g) * 8 + wave) * 4 + lb) * 2) * 64 + lane;
        LAS bf16* yl = (LAS bf16*)(L + OFF_X + (32 * lb + 4 * hi) * XRS) + hl * 64 + 32 * ph + r32;
#pragma unroll
        for (int rh = 0; rh < 2; ++rh) { const v4u yd = ydp[rh * 64];
            const f32x4 e0 = *(const LAS f32x4*)(ea + 32 * lb + 16 * rh + 4 * hi), e1 = *(const LAS f32x4*)(ea + 32 * lb + 16 * rh + 8 + 4 * hi);
            yl[(16 * rh + 0) * (XRS / 2)] = (bf16)f2bf(y[8 * rh] * e0.x + bflo(yd.x)); yl[(16 * rh + 1) * (XRS / 2)] = (bf16)f2bf(y[8 * rh + 1] * e0.y + bfhi(yd.x));
            yl[(16 * rh + 2) * (XRS / 2)] = (bf16)f2bf(y[8 * rh + 2] * e0.z + bflo(yd.y)); yl[(16 * rh + 3) * (XRS / 2)] = (bf16)f2bf(y[8 * rh + 3] * e0.w + bfhi(yd.y));
            yl[(16 * rh + 8) * (XRS / 2)] = (bf16)f2bf(y[8 * rh + 4] * e1.x + bflo(yd.z)); yl[(16 * rh + 9) * (XRS / 2)] = (bf16)f2bf(y[8 * rh + 5] * e1.y + bfhi(yd.z));
            yl[(16 * rh + 10) * (XRS / 2)] = (bf16)f2bf(y[8 * rh + 6] * e1.z + bflo(yd.w)); yl[(16 * rh + 11) * (XRS / 2)] = (bf16)f2bf(y[8 * rh + 7] * e1.w + bfhi(yd.w)); }
    }
    LDS_WAIT(); __syncthreads();
    {
        const int cl = lane & 15;
        const f32x4 g0 = *(const f32x4*)(T.gssd + g * 256 + cl * 8), g1 = *(const f32x4*)(T.gssd + g * 256 + cl * 8 + 4), g2 = *(const f32x4*)(T.gssd + g * 256 + 128 + cl * 8), g3 = *(const f32x4*)(T.gssd + g * 256 + 128 + cl * 8 + 4);
#pragma unroll
        for (int ps = 0; ps < 4; ++ps) { const int row = 16 * wave + 4 * ps + (lane >> 4);
            const v4u u0 = *(const LAS v4u*)(L + OFF_X + row * XRS + cl * 16), u1 = *(const LAS v4u*)(L + OFF_X + row * XRS + 256 + cl * 16);
            float a[16] = {bflo(u0.x), bfhi(u0.x), bflo(u0.y), bfhi(u0.y), bflo(u0.z), bfhi(u0.z), bflo(u0.w), bfhi(u0.w), bflo(u1.x), bfhi(u1.x), bflo(u1.y), bfhi(u1.y), bflo(u1.z), bfhi(u1.z), bflo(u1.w), bfhi(u1.w)};
            const bf16* zp = T.PROJ + (size_t)(tok0 + row) * NPROJ + OZ + g * 256 + cl * 8;
            const v4u z0 = *(const v4u*)zp, z1 = *(const v4u*)(zp + 128);
            const float zz[16] = {bflo(z0.x), bfhi(z0.x), bflo(z0.y), bfhi(z0.y), bflo(z0.z), bfhi(z0.z), bflo(z0.w), bfhi(z0.w), bflo(z1.x), bfhi(z1.x), bflo(z1.y), bfhi(z1.y), bflo(z1.z), bfhi(z1.z), bflo(z1.w), bfhi(z1.w)};
            float ss = 0.f;
#pragma unroll
            for (int i = 0; i < 16; ++i) { a[i] *= zz[i] * __builtin_amdgcn_rcpf(1.f + __builtin_amdgcn_exp2f(-LOG2E * zz[i])); ss += a[i] * a[i]; }
            ss += __shfl_xor(ss, 1); ss += __shfl_xor(ss, 2); ss += __shfl_xor(ss, 4); ss += __shfl_xor(ss, 8);
            const float rs = 1.f / sqrtf(ss * (1.f / 256.f) + EPS);
            v4u o0, o1; o0.x = cvtpk(a[0] * rs * g0.x, a[1] * rs * g0.y); o0.y = cvtpk(a[2] * rs * g0.z, a[3] * rs * g0.w); o0.z = cvtpk(a[4] * rs * g1.x, a[5] * rs * g1.y); o0.w = cvtpk(a[6] * rs * g1.z, a[7] * rs * g1.w);
            o1.x = cvtpk(a[8] * rs * g2.x, a[9] * rs * g2.y); o1.y = cvtpk(a[10] * rs * g2.z, a[11] * rs * g2.w); o1.z = cvtpk(a[12] * rs * g3.x, a[13] * rs * g3.y); o1.w = cvtpk(a[14] * rs * g3.z, a[15] * rs * g3.w);
            bf16* op = T.AO + (size_t)(tok0 + row) * 1024 + 512 + g * 256 + cl * 8;
            *(v4u*)op = o0; *(v4u*)(op + 128) = o1; }
    }
    LDS_WAIT(); __syncthreads();
}
}

__device__ __forceinline__ void dt_tail(const bf16* XBi, const bf16* WDTl, const float* rss, float* DTR, LAS unsigned char* lds, const int vcu, const int G, const int wave, const int lane, const int tid) {
    typedef float f32x16 __attribute__((ext_vector_type(16)));
    const int r32 = lane & 31, hi = lane >> 5;
    for (int p = vcu; p < MT / 64; p += G) {
        const int mb = wave & 1, kq = wave >> 1;
        f32x16 d;
#pragma unroll
        for (int r = 0; r < 16; ++r) d[r] = 0.f;
        const bf16* ap = XBi + (size_t)(64 * p + 32 * mb + r32) * DM + 256 * kq + 8 * hi;
        const bf16* bp = WDTl + (size_t)(r32 & 7) * DM + 256 * kq + 8 * hi;
        const bf16x8 zero8 = {0, 0, 0, 0, 0, 0, 0, 0};
        bf16x8 af[16], bq[16];
#pragma unroll
        for (int ks = 0; ks < 16; ++ks) { af[ks] = *(const bf16x8*)(ap + 16 * ks); bq[ks] = *(const bf16x8*)(bp + 16 * ks); }
#pragma unroll
        for (int ks = 0; ks < 16; ++ks) d = __builtin_amdgcn_mfma_f32_32x32x16_bf16(af[ks], (r32 < 8) ? bq[ks] : zero8, d, 0, 0, 0);
        LAS float* dp = (LAS float*)lds + ((kq * 64 + 32 * mb + 4 * hi) * 8 + r32);
        if (r32 < 8) {
#pragma unroll
            for (int r = 0; r < 16; ++r) dp[((r & 3) + 8 * (r >> 2)) * 8] = d[r]; }
        LDS_WAIT(); __syncthreads();
        { const int row = tid >> 3, j = tid & 7; const LAS float* q = (const LAS float*)lds + row * 8 + j;
          DTR[(size_t)(64 * p + row) * 8 + j] = ((q[0] + q[512]) + (q[1024] + q[1536])) * pg8::rstd_of(rss, 64 * p + row); }
        LDS_WAIT(); __syncthreads();
    }
}

__device__ __forceinline__ int moe_tables(LAS int* pan, gu32* ecnt, int tid) {
    int cnt[NE], ps[NE + 1]; ps[0] = 0;
#pragma unroll
    for (int e = 0; e < NE; ++e) { cnt[e] = (int)__hip_atomic_load(ecnt + 64 * e, RLX_AGENT); ps[e + 1] = ps[e] + ((cnt[e] + 255) >> 8); }
    if (tid < 256) { int e = 0, c = cnt[0], p0 = 0;
#pragma unroll
        for (int q = 1; q < NE; ++q) if (tid >= ps[q]) { e = q; c = cnt[q]; p0 = ps[q]; }
        const int j = tid - p0, real = min(256, c - 256 * j);
        if (tid < ps[NE]) pan[tid] = e | (j << 8) | ((real - 1) << 16); }
    LDS_WAIT(); __syncthreads();
    return ps[NE];
}
#define KARGP ((const __attribute__((address_space(4))) char*)__builtin_amdgcn_kernarg_segment_ptr())
enum { PH_PRO = 0, PH_L0 = 1, PH_FFNUP = 6, PH_FFNDN = 7, PH_L1 = 8, PH_ROUTE = 13, PH_MOEUP = 14, PH_MOEDN = 15, PH_FINAL = 16, PH_N = 17 };
#define ws (*(unsigned char* const __attribute__((address_space(4)))*)(KARGP + 168))
#define ctl ((gu32*)(ws + WS_CTL))
#define IN(k) (lo <= (k) && (k) < hi)
#ifndef PROBE_MASK
#define PROBE_MASK 0u
#endif
#define PB(k) _Pragma("unroll") for (int rep_ = 0; rep_ < (int)((PROBE_MASK >> (k)) & 1u) + 1; ++rep_) {
#define PE(k) if (rep_ + 1 < (int)((PROBE_MASK >> (k)) & 1u) + 1) xcd_barrier(bar); }
#define SEAM(k) do { if (IN(k) && IN((k) + 1)) xcd_barrier(bar); } while (0)
#define CSEAM(k, s_, g_) do { if (IN(k) && IN((k) + 1)) { xcd_arrive(bar, (unsigned*)(ctl + CW_BAR2)); seam_convert((s_), L, gw, NGW, wave, lane); xcd_wait(bar, (unsigned*)(ctl + CW_BAR2), (unsigned)(g_)); } } while (0)
#define KARG_F(i) (*(const float* const __attribute__((address_space(4)))*)(KARGP + 8 * (i)))
#define x_in KARG_F(0)
#define mix_g KARG_F(1)
#define w_in KARG_F(2)
#define attn_g KARG_F(8)
#define ssd_g KARG_F(9)
#define w_out KARG_F(10)
#define ffn_g KARG_F(11)
#define dwg KARG_F(12)
#define dwu KARG_F(13)
#define dwd KARG_F(14)
#define router_w KARG_F(15)
#define mwg KARG_F(16)
#define mwu KARG_F(17)
#define mwd KARG_F(18)
#define final_g KARG_F(19)
#define conv_w KARG_F(3)
#define conv_b KARG_F(4)
#define dt_bias KARG_F(5)
#define a_log KARG_F(6)
#define d_skip KARG_F(7)
#define OUTF (*(float* const __attribute__((address_space(4)))*)(KARGP + 160))
#define XR ((bf16*)(ws + WS_XR))
#define WIN_T ((bf16*)(ws + WS_WIN))
#define WOUT_T ((bf16*)(ws + WS_WOUT))
#define WDGU_T ((bf16*)(ws + WS_WDGU))
#define WDD_T ((bf16*)(ws + WS_WDD))
#define WDGU8 ((unsigned char*)(ws + WS_WDGU))
#define WDD8 ((unsigned char*)(ws + WS_WDD))
#define HB8 ((unsigned char*)(ws + WS_HB))
#define WMGU_T ((bf16*)(ws + WS_R1))
#define WMGU8 ((unsigned char*)(ws + WS_R1))
#define WMD8 ((unsigned char*)(ws + WS_R1 + 60 * MiB))
#define XB8 ((unsigned char*)(ws + WS_XBCC))
#define HID8 ((unsigned char*)(ws + WS_R3))
#define PROJ ((bf16*)(ws + WS_PROJ))
#define AO ((bf16*)(ws + WS_AO))
#define HB ((bf16*)(ws + WS_HB))
#define HPERM ((bf16*)(ws + WS_R2))
#define YB ((bf16*)(ws + WS_R2))
#define YPB ((bf16*)(ws + WS_XN))
#define HID ((bf16*)(ws + WS_R3))
#define RSS(s) ((float*)(ws + WS_RSS) + (size_t)(s) * MT * 16)
#define DTRAW ((float*)(ws + WS_DTRAW))
#define WDT ((bf16*)(ws + WS_WDT))
#define ROWTOK_V ((int*)(ws + WS_RTOKV))
#define ROWG_V ((float*)(ws + WS_RGV))
#define ROWS_V ((float*)(ws + WS_RSV))
#define ACUM ((float*)(ws + WS_DTV))
#define CCB ((bf16*)(ws + WS_XBCC))
#define YDB ((float*)(ws + WS_ATTRAW))
#define STB ((float*)(ws + WS_YRAW))
#define ST2B ((float*)(ws + WS_ST2))
#define TOKE ((int*)(ws + WS_TOKE))
#define TOKR ((int*)(ws + WS_TOKR))
#define TOKG ((float*)(ws + WS_TOKG))
#define TOKP ((int*)(ws + WS_TOKP))
#define ROWG ((float*)(ws + WS_ROWG))
#define PTAB ((int*)(ws + WS_PTAB))
#define ECNT (ctl + CW_ECNT)

struct ConvDesc { const float* src; unsigned char* dst; int gko, ldw, pitch; float scale; int fp8; };
constexpr int GT_MIX1 = 0, GT_FFN0 = DM, GT_FFN1 = 2 * DM, GT_ONE = 3 * DM, GT_N = 3 * DM + 64;
constexpr int CI_IN = (DM / 64) * (NPROJ / 64), CI_OUT = (DM / 64) * (DM / 64), CI_DGU = 2 * (DM / 64) * (DFF / 64), CI_DD = (DFF / 64) * (DM / 64), CI_MGU = 2 * (DM / 64) * (DFFE / 64), CI_MD = (DFFE / 64) * (DM / 64);
constexpr int CI_ALL = CI_IN + 2 * CI_OUT + CI_DGU + CI_DD + NE * CI_MGU + NE * CI_MD;
constexpr int CI_PRO = 320, CI_SEAM = 2048;
static_assert(CI_PRO + 12 * CI_SEAM >= CI_ALL, "seam chunks");
constexpr int CI_DONOR = CI_IN + 2 * CI_OUT + CI_DGU + CI_DD + NE * CI_MGU + NE_PRO * CI_MD;
__device__ __forceinline__ ConvDesc conv_decode(int r) {
    ConvDesc d; d.gko = GT_ONE; d.scale = 1.f; d.fp8 = 0;
    if (r < CI_IN) { const int kb = r / (NPROJ / 64), nb = r % (NPROJ / 64);
        d.src = w_in + (size_t)DM * DINP + (size_t)(64 * kb) * DINP + 64 * nb; d.ldw = DINP; d.gko = GT_MIX1 + 64 * kb; d.dst = (unsigned char*)(WIN_T + (size_t)NPROJ * DM + (size_t)(64 * nb) * DM + 64 * kb); d.pitch = DM * 2; return d; }
    r -= CI_IN;
    if (r < 2 * CI_OUT) { const int l = r / CI_OUT, q = r % CI_OUT, kb = q / (DM / 64), nb = q % (DM / 64);
        d.src = w_out + (size_t)l * DM * DM + (size_t)(64 * kb) * DM + 64 * nb; d.ldw = DM; d.dst = (unsigned char*)(WOUT_T + (size_t)l * DM * DM + (size_t)(64 * nb) * DM + 64 * kb); d.pitch = DM * 2; return d; }
    r -= 2 * CI_OUT;
    if (r < CI_DGU) { const int nblk = DFF / 64, per = (DM / 64) * nblk, half = r / per, q = r % per, kb = q / nblk, nb = q % nblk, f0 = 64 * nb, drow0 = (f0 / 128) * 256 + half * 128 + (f0 % 128);
        d.src = (half ? dwu : dwg) + (size_t)(64 * kb) * DFF + f0; d.ldw = DFF; d.gko = GT_FFN0 + 64 * kb; d.scale = WU_SCALE; d.fp8 = 1; d.dst = WDGU8 + (size_t)drow0 * DM + 64 * kb; d.pitch = DM; return d; }
    r -= CI_DGU;
    if (r < CI_DD) { const int kb = r / (DM / 64), nb = r % (DM / 64);
        d.src = dwd + (size_t)(64 * kb) * DM + 64 * nb; d.ldw = DM; d.scale = WD_SCALE; d.fp8 = 1; d.dst = WDD8 + (size_t)(64 * nb) * DFF + 64 * kb; d.pitch = DFF; return d; }
    r -= CI_DD;
    if (r < NE * CI_MGU) { const int e = r / CI_MGU, q = r % CI_MGU, nblk = DFFE / 64, per = (DM / 64) * nblk, half = q / per, qq = q % per, kb = qq / nblk, nb = qq % nblk, f0 = 64 * nb, drow0 = (f0 / 128) * 256 + half * 128 + (f0 % 128);
        d.src = (half ? mwu : mwg) + (size_t)e * DM * DFFE + (size_t)(64 * kb) * DFFE + f0; d.ldw = DFFE; d.gko = GT_FFN1 + 64 * kb; d.scale = WU_SCALE; d.fp8 = 1;
        d.dst = WMGU8 + (size_t)e * 2 * DFFE * DM + (size_t)drow0 * DM + 64 * kb; d.pitch = DM; return d; }
    r -= NE * CI_MGU;
    { const int e = ((NE - NE_PRO) + r / CI_MD) % NE, q = r % CI_MD, kb = q / (DM / 64), nb = q % (DM / 64);
        d.src = mwd + (size_t)e * DFFE * DM + (size_t)(64 * kb) * DM + 64 * nb; d.ldw = DM; d.scale = WD_SCALE; d.fp8 = 1; d.dst = WMD8 + (size_t)e * DM * DFFE + (size_t)(64 * nb) * DFFE + 64 * kb; d.pitch = DFFE; return d; }
}
__device__ __forceinline__ void conv_ld(const ConvDesc& d, f32x4 (&v)[16], int lane) {
    asm volatile("" : "+v"(lane));
    const float* s = d.src + (size_t)(16 * (lane >> 4)) * d.ldw + 4 * (lane & 15);
#pragma unroll
    for (int i = 0; i < 16; ++i) v[i] = __builtin_nontemporal_load((const GAS f32x4*)(s + (size_t)i * d.ldw));
}
__device__ __forceinline__ void conv_store(const ConvDesc& d, f32x4 (&v)[16], LAS unsigned char* scr, int lane);
__device__ __forceinline__ void conv_st(const ConvDesc& d, f32x4 (&v)[16], LAS unsigned char* scr, const LAS float* gtab, int lane) {
    asm volatile("" : "+v"(lane));
    const int kq = lane >> 4;
    { const LAS f32x4* gt = (const LAS f32x4*)(gtab + d.gko + 16 * kq);
#pragma unroll
      for (int q = 0; q < 4; ++q) { const f32x4 g4 = gt[q] * d.scale;
#pragma unroll
          for (int i = 0; i < 4; ++i) v[4 * q + i] = v[4 * q + i] * g4[i]; } }
    conv_store(d, v, scr, lane);
}
__device__ __forceinline__ void conv_one(const int r, LAS unsigned char* scr, int lane) {
    const ConvDesc d = conv_decode(r);
    f32x4 v[16]; conv_ld(d, v, lane);
    asm volatile("" : "+v"(lane));
    const int kq = lane >> 4;
    if (d.gko < GT_ONE) { const float* gp = (d.gko < DM ? mix_g + DM + d.gko : ffn_g + (d.gko - DM)) + 16 * kq;
#pragma unroll
        for (int q = 0; q < 4; ++q) { const f32x4 g4 = *(const GAS f32x4*)(gp + 4 * q) * d.scale;
#pragma unroll
            for (int i = 0; i < 4; ++i) v[4 * q + i] = v[4 * q + i] * g4[i]; } }
    else {
#pragma unroll
        for (int i = 0; i < 16; ++i) v[i] = v[i] * d.scale; }
    conv_store(d, v, scr, lane);
}
__device__ __forceinline__ void conv_store(const ConvDesc& d, f32x4 (&v)[16], LAS unsigned char* scr, int lane) {
    asm volatile("" : "+v"(lane));
    const int kq = lane >> 4, n4 = lane & 15;
    if (d.fp8) {
#pragma unroll
        for (int j = 0; j < 4; ++j) { int w[4];
#pragma unroll
            for (int q = 0; q < 4; ++q) { w[q] = __builtin_amdgcn_cvt_pk_fp8_f32(v[4 * q][j], v[4 * q + 1][j], 0, false); w[q] = __builtin_amdgcn_cvt_pk_fp8_f32(v[4 * q + 2][j], v[4 * q + 3][j], w[q], true); }
            *(LAS v4u*)(scr + (4 * n4 + j) * 80 + kq * 16) = (v4u){(unsigned)w[0], (unsigned)w[1], (unsigned)w[2], (unsigned)w[3]}; }
        LDS_WAIT(); asm volatile("" ::: "memory");
#pragma unroll
        for (int i = 0; i < 4; ++i) { const int idx = lane + 64 * i, n = idx >> 2, c = idx & 3;
            __builtin_nontemporal_store(*(const LAS v4u*)(scr + n * 80 + c * 16), (GAS v4u*)(d.dst + (size_t)n * d.pitch + 16 * c)); }
        LDS_WAIT(); asm volatile("" ::: "memory");
    } else {
#pragma unroll
        for (int j = 0; j < 4; ++j) { v4u a, b;
            a.x = sba::cvtpk(v[0][j], v[1][j]); a.y = sba::cvtpk(v[2][j], v[3][j]); a.z = sba::cvtpk(v[4][j], v[5][j]); a.w = sba::cvtpk(v[6][j], v[7][j]);
            b.x = sba::cvtpk(v[8][j], v[9][j]); b.y = sba::cvtpk(v[10][j], v[11][j]); b.z = sba::cvtpk(v[12][j], v[13][j]); b.w = sba::cvtpk(v[14][j], v[15][j]);
            LAS unsigned char* p = scr + (4 * n4 + j) * 144 + kq * 32;
            *(LAS v4u*)p = a; *(LAS v4u*)(p + 16) = b; }
        LDS_WAIT(); asm volatile("" ::: "memory");
#pragma unroll
        for (int i = 0; i < 8; ++i) { const int n = 8 * i + (lane >> 3), c = lane & 7;
            __builtin_nontemporal_store(*(const LAS v4u*)(scr + n * 144 + c * 16), (GAS v4u*)(d.dst + (size_t)n * d.pitch + 16 * c)); }
        LDS_WAIT(); asm volatile("" ::: "memory");
    }
}
__device__ __forceinline__ void seam_convert(const int s_, LAS unsigned char* L, const int gw, const int NGW, const int wave, const int lane) {
    const int rb = CI_PRO + (s_ - 1) * CI_SEAM, re = min(rb + CI_SEAM, CI_ALL);
    LAS unsigned char* scr = L + wave * 16384;
    for (int it = rb + gw; it < re; it += NGW) conv_one(it, scr, lane);
}
__device__ __forceinline__ void donor_convert(LAS unsigned char* lds, const int w0, const int nw, const int wave, const int lane, const int tid, const int rb, const int re) {
    LAS float* gtab = (LAS float*)(lds + NWAVES * 16384); LAS unsigned char* scr = lds + wave * 16384;
    for (int i = tid; i < GT_N; i += NWAVES * 64) gtab[i] = (i < DM) ? mix_g[DM + i] : (i < 3 * DM) ? ffn_g[i - DM] : 1.f;
    LDS_WAIT(); __syncthreads();
    f32x4 va[16], vb[16];
    conv_ld(conv_decode(min(rb + w0, re - 1)), va, lane);
    for (int r = rb + w0; r < re; r += 2 * nw) {
        const int r2 = r + nw, r3 = r + 2 * nw;
        conv_ld(conv_decode(min(r2, re - 1)), vb, lane);
        conv_st(conv_decode(r), va, scr, gtab, lane);
        conv_ld(conv_decode(min(r3, re - 1)), va, lane);
        if (r2 < re) conv_st(conv_decode(r2), vb, scr, gtab, lane);
    }
    asm volatile("" :: "v"(va[0]), "v"(va[15]));
}

template <int layer>
__device__ __forceinline__ void layer_phases(LAS unsigned char* L, const XcdBarrier& bar, const int lo, const int hi, const int tid, const int lane, const int wave, const int G, const int bx, const int gw, const int NGW) {
        const int pb = layer ? PH_L1 : PH_L0;
        if (IN(pb + 0)) {
            PB(pb + 0)
            const int GG = G;
            if (bx < GG) {
            pg8::Gemm g{XR, WIN_T + (size_t)layer * NPROJ * DM, MT, NPROJ, DM, DM}; pg8::StaticOrder S; S.init(MT, NPROJ, GG, bx);
            pg8::fill_rs<1>((LAS float*)(L + RS_TAB_OFF), S, RSS(layer ? 2 : 0), tid);
            pg8::EpiBf16 E{PROJ, NPROJ, 512, 0.125f * 1.4426950408889634f, (const LAS float*)(L + RS_TAB_OFF)};
            pg8::gemm_phase<pg8::EpiBf16, pg8::StaticOrder, true, true>(L + RING_OFF, g, S, E);
            dt_tail(XR, WDT + layer * 8 * DM, RSS(layer ? 2 : 0), DTRAW, L + RING_OFF, (GG % 8 == 0) ? (bx % 8) * (GG / 8) + bx / 8 : bx, GG, wave, lane, tid);
            } else { if constexpr (layer == 0) donor_convert(L + RING_OFF, (bx - GG) * NWAVES + wave, (G - GG) * NWAVES, wave, lane, tid, 0, CI_DONOR); }
            PE(pb + 0)
        }
        CSEAM(pb + 0, layer ? 7 : 1, (layer ? 7 : 0) + 1);
        if (IN(pb + 1)) {
            PB(pb + 1)
            const ssd::ATensors T{PROJ, conv_w + layer * 4096, conv_b + layer * 1024, DTRAW, dt_bias + layer * 8, a_log + layer * 8, d_skip + layer * 8, (bf16*)YDB, (bf16*)STB, CCB, ACUM};
            for (int u = ((G % 8 == 0) ? (bx % 8) * (G / 8) + bx / 8 : bx); u < BATCH * 16 * 2; u += G) ssd::phaseA_unit(u >> 5, (u >> 1) & 15, u & 1, T, L + RING_OFF, wave, lane);
            PE(pb + 1)
        }
        const bool split12 = IN(pb + 1) && IN(pb + 2);
        if (split12) xcd_arrive(bar, (unsigned*)(ctl + CW_BAR2));
        if (IN(pb + 2)) {
            PB(pb + 2)
            int par = 0;
            for (int u = ((G % 8 == 0) ? (bx % 8) * (G / 8) + bx / 8 : bx); u < BATCH * (SEQ / 64); u += G) { sba::attn_unit(u >> 5, (SEQ / 64 - 1) - (u & 31), PROJ, attn_g + layer * 512, AO, L + RING_OFF, wave, lane, par); par ^= 1; }
            if (split12) xcd_wait(bar, (unsigned*)(ctl + CW_BAR2), (unsigned)((layer ? 7 : 0) + 2));
            ssd::scan_states((const bf16*)STB, (bf16*)ST2B, ACUM, bx * (NWAVES * 64) + tid, G * NWAVES * 64);
            PE(pb + 2)
        }
        CSEAM(pb + 2, layer ? 8 : 2, (layer ? 7 : 0) + 3);
        if (IN(pb + 3)) {
            PB(pb + 3)
            const ssd::BTensors T{PROJ, (const bf16*)YDB, (const bf16*)ST2B, CCB, ACUM, ssd_g + layer * 512, AO};
            for (int u = ((G % 8 == 0) ? (bx % 8) * (G / 8) + bx / 8 : bx); u < BATCH * 16 * 2; u += G) ssd::phaseB_unit(u >> 5, (u >> 1) & 15, u & 1, T, L + RING_OFF, wave, lane, tid);
            PE(pb + 3)
        }
        CSEAM(pb + 3, layer ? 9 : 3, (layer ? 7 : 0) + 4);
        if (IN(pb + 4)) {
            PB(pb + 4)
            pg8::Gemm g{AO, WOUT_T + (size_t)layer * DM * DM, MT, DM, DM, DM}; pg8::StaticOrder S; S.init(MT, DM, G, bx, 8);
            pg8::EpiResAddNorm E{XR, DM, RSS(layer ? 3 : 1), XB8, 1.f};
            pg8::gemm_phase<pg8::EpiResAddNorm, pg8::StaticOrder, true, true>(L + RING_OFF, g, S, E);
            PE(pb + 4)
        }
        CSEAM(pb + 4, layer ? 10 : 4, (layer ? 7 : 0) + 5);
    }
__global__ void __launch_bounds__(NWAVES * 64, 2) mk_fwd(Args args) {
    extern __shared__ __attribute__((aligned(16))) unsigned char lds[];
    LAS unsigned char* L = (LAS unsigned char*)lds;
    const int tid = threadIdx.x, lane = tid & 63, wave = __builtin_amdgcn_readfirstlane(tid >> 6);
    const int G = gridDim.x; const int bx = blockIdx.x; const int vcu = (G % 8 == 0) ? (bx % 8) * (G / 8) + bx / 8 : bx;
    const int gw = vcu * NWAVES + wave, NGW = G * NWAVES;
    for (int u = tid; u < (LDS_BYTES - LDSCTL_OFF) / 4; u += NWAVES * 64) ((LAS unsigned*)(L + LDSCTL_OFF))[u] = 0u;
    __syncthreads();
    const int lo = *(const __attribute__((address_space(4))) int*)(KARGP + 176), hi = *(const __attribute__((address_space(4))) int*)(KARGP + 180);
    XcdBarrier bar; bar.bar = (unsigned*)(ctl + CW_BAR); bar.x = 0; bar.st = nullptr;
    if (hi - lo > 1) bar = xcd_barrier_post((unsigned*)(ctl + CW_BAR), (volatile LAS unsigned*)(L + MISC_OFF) + 8);
    if (IN(PH_PRO)) {
        PB(PH_PRO)
        LAS unsigned char* scr = L + RING_OFF + wave * 16384;
        for (int it = gw; it < CI_IN; it += NGW) conv_plain(w_in, DINP, DM, NPROJ, WIN_T, it, scr, lane, mix_g);
        for (int it = gw; it < CI_PRO; it += NGW) conv_one(it, scr, lane);
        xb_rows(x_in, mix_g, XR, RSS(0), gw, NGW, lane);
        { const int idx = bx * (NWAVES * 64) + tid; if (idx < 2 * 8 * DM) { const int l = idx >> 13, j = (idx >> 10) & 7, k = idx & 1023; WDT[idx] = (bf16)f2bf(w_in[(size_t)l * DM * DINP + (size_t)k * DINP + NPROJ + j] * mix_g[l * DM + k]); } }
        PE(PH_PRO)
    }
    SEAM(PH_PRO);
    layer_phases<0>(L, bar, lo, hi, tid, lane, wave, G, bx, gw, NGW);
    if (IN(PH_FFNUP)) {
        PB(PH_FFNUP)
        pg8::Gemm g{(const pg8::bf16_t*)XB8, (const pg8::bf16_t*)WDGU8, MT, 2 * DFF, DM, DM}; pg8::StaticOrder S; S.init(MT, 2 * DFF, G, bx);
        pg8::fill_rs<1>((LAS float*)(L + RS_TAB_OFF), S, RSS(1), tid, 1.f / WU_SCALE);
        pg8::EpiSwiGLU8 E{HB8, DFF, (const LAS float*)(L + RS_TAB_OFF)};
        pg8::gemm_phase<pg8::EpiSwiGLU8, pg8::StaticOrder, true, true, 1>(L + RING_OFF, g, S, E);
        PE(PH_FFNUP)
    }
    CSEAM(PH_FFNUP, 5, 6);
    if (IN(PH_FFNDN)) {
        PB(PH_FFNDN)
        pg8::Gemm g{(const pg8::bf16_t*)HB8, (const pg8::bf16_t*)WDD8, MT, DM, DFF, DFF}; pg8::StaticOrder S; S.init(MT, DM, G, bx, 8);
        pg8::EpiResAddNorm E{XR, DM, RSS(2), nullptr, 1.f / WD_SCALE};
        pg8::gemm_phase<pg8::EpiResAddNorm, pg8::StaticOrder, true, true, 1>(L + RING_OFF, g, S, E);
        PE(PH_FFNDN)
    }
    CSEAM(PH_FFNDN, 6, 7);
    layer_phases<1>(L, bar, lo, hi, tid, lane, wave, G, bx, gw, NGW);
    if (IN(PH_ROUTE)) {
        PB(PH_ROUTE)
        LAS float* tab = (LAS float*)(L + RING_OFF);
        load_tab8(router_w, 8, tab, tid);
        route_rows(XR, ffn_g + DM, RSS(3), tab, (LAS int*)(L + RING_OFF + 32768), TOKE, TOKR, ROWTOK_V, ROWG_V, ROWS_V, ECNT, gw, NGW, lane, tid);
        PE(PH_ROUTE)
    }
    CSEAM(PH_ROUTE, 11, 13);
    if (IN(PH_MOEUP)) {
        PB(PH_MOEUP)
        const int P = moe_tables((LAS int*)(L + PAN_TAB_OFF), ECNT, tid);
        pg8::Gemm g{(const pg8::bf16_t*)XB8, (const pg8::bf16_t*)WMGU8, P * 256, 2 * DFFE, DM, DM}; pg8::GroupedOrder<true> S; S.init(P, 2 * DFFE / 256, G, bx, (const LAS int*)(L + PAN_TAB_OFF), (const LAS unsigned short*)(L + TOK_TAB_OFF), (long)2 * DFFE * DM);
        pg8::fill_grouped((LAS float*)(L + RS_TAB_OFF), (LAS unsigned short*)(L + TOK_TAB_OFF), S, ROWS_V, ROWTOK_V, tid, 1.f / WU_SCALE);
        pg8::EpiSwiGLU8 E{HID8, DFFE, (const LAS float*)(L + RS_TAB_OFF)};
        pg8::gemm_phase<pg8::EpiSwiGLU8, pg8::GroupedOrder<true>, true, true, 1>(L + RING_OFF, g, S, E);
        PE(PH_MOEUP)
    }
    if (IN(PH_MOEUP) && IN(PH_MOEDN)) seam_convert(12, L, gw, NGW, wave, lane);
    SEAM(PH_MOEUP);
    if (IN(PH_MOEDN)) {
        PB(PH_MOEDN)
        const int P = moe_tables((LAS int*)(L + PAN_TAB_OFF), ECNT, tid);
        {
            pg8::Gemm g{(const pg8::bf16_t*)HID8, (const pg8::bf16_t*)WMD8, 128 * 256, DM, DFFE, DFFE}; pg8::GroupedOrder<false> S; S.init(128, DM / 256, G, bx, (const LAS int*)(L + PAN_TAB_OFF), nullptr, (long)DM * DFFE, 8);
            pg8::fill_grouped((LAS float*)(L + RS_TAB_OFF), (LAS unsigned short*)nullptr, S, ROWG_V, nullptr, tid, 1.f / WD_SCALE);
            pg8::EpiRowScaleBf16 E{YB, DM, (const LAS float*)(L + RS_TAB_OFF)};
            pg8::gemm_phase<pg8::EpiRowScaleBf16, pg8::GroupedOrder<false>, true, true, 1>(L + RING_OFF, g, S, E);
        }
        if (P > 128) {
            pg8::Gemm g{(const pg8::bf16_t*)HID8, (const pg8::bf16_t*)WMD8, P * 256, DM, 512, DFFE}; pg8::TailOrder S; S.init(P, G, bx, (const LAS int*)(L + PAN_TAB_OFF), (long)DM * DFFE, 1);
            pg8::fill_grouped((LAS float*)(L + RS_TAB_OFF), (LAS unsigned short*)nullptr, S, ROWG_V, nullptr, tid, 1.f / WD_SCALE);
            pg8::EpiRowScaleBf16 E{YPB, DM, (const LAS float*)(L + RS_TAB_OFF)};
            pg8::gemm_phase<pg8::EpiRowScaleBf16, pg8::TailOrder, true, true, 1>(L + RING_OFF, g, S, E);
        }
        PE(PH_MOEDN)
    }
    SEAM(PH_MOEDN);
    if (IN(PH_FINAL)) {
        PB(PH_FINAL)
        int off[NE + 1]; off[0] = 0;
#pragma unroll
        for (int e = 0; e < NE; ++e) { const int c = (int)__hip_atomic_load(ECNT + 64 * e, RLX_AGENT); off[e + 1] = off[e] + ((c + 255) & ~255); }
        f32x4 gv[4];
#pragma unroll
        for (int j = 0; j < 4; ++j) gv[j] = *((const GAS f32x4*)final_g + lane + 64 * j);
#define ADD4(v_, a_) do { v_.x += bfbits2f((unsigned)(a_) & 0xffffu); v_.y += bfbits2f((unsigned)(a_) >> 16); v_.z += bfbits2f((unsigned)((a_) >> 32) & 0xffffu); v_.w += bfbits2f((unsigned)((a_) >> 48)); } while (0)
        for (int m0 = gw; m0 < MT; m0 += 8 * NGW) {
            int pa[8], pc[8];
#pragma unroll
            for (int k = 0; k < 8; ++k) { const int m = m0 + k * NGW; pa[k] = 0; pc[k] = 0;
                if (m < MT) { const int ea = TOKE[2 * m], ec = TOKE[2 * m + 1]; int oa = 0, oc = 0;
#pragma unroll
                    for (int q = 0; q < NE; ++q) { oa = (ea == q) ? off[q] : oa; oc = (ec == q) ? off[q] : oc; }
                    pa[k] = oa + TOKR[2 * m]; pc[k] = oc + TOKR[2 * m + 1]; } }
#pragma unroll
            for (int k = 0; k < 8; k += 2) {
                unsigned long long xa[2][4], ya[2][4], yc[2][4];
#pragma unroll
                for (int h = 0; h < 2; ++h) { const int m = m0 + (k + h) * NGW;
                    if (m < MT) { const GAS unsigned long long* xb = (const GAS unsigned long long*)(XR + (size_t)m * DM) + lane;
#pragma unroll
                        for (int j = 0; j < 4; ++j) xa[h][j] = xb[64 * j];
                        if (pa[k + h] < 32768) { const GAS unsigned long long* y = (const GAS unsigned long long*)(YB + (size_t)pa[k + h] * DM) + lane;
#pragma unroll
                            for (int j = 0; j < 4; ++j) ya[h][j] = y[64 * j]; }
                        if (pc[k + h] < 32768) { const GAS unsigned long long* y = (const GAS unsigned long long*)(YB + (size_t)pc[k + h] * DM) + lane;
#pragma unroll
                            for (int j = 0; j < 4; ++j) yc[h][j] = y[64 * j]; } } }
#pragma unroll
                for (int h = 0; h < 2; ++h) { const int m = m0 + (k + h) * NGW;
                    if (m < MT) { GAS f32x4* xr = (GAS f32x4*)(OUTF + (size_t)m * DM) + lane;
                        f32x4 v[4]; float s = 0.f;
#pragma unroll
                        for (int j = 0; j < 4; ++j) { const unsigned long long a = xa[h][j]; v[j] = (f32x4){bfbits2f((unsigned)a & 0xffffu), bfbits2f((unsigned)a >> 16), bfbits2f((unsigned)(a >> 32) & 0xffffu), bfbits2f((unsigned)(a >> 48))}; }
#pragma unroll
                        for (int side = 0; side < 2; ++side) { const int pos = side ? pc[k + h] : pa[k + h];
                            if (pos < 32768) {
#pragma unroll
                                for (int j = 0; j < 4; ++j) { const unsigned long long a = side ? yc[h][j] : ya[h][j]; ADD4(v[j], a); } }
                            else { unsigned long long tp[7][4];
#pragma unroll
                                for (int sl = 0; sl < 7; ++sl) { const GAS unsigned long long* y = (const GAS unsigned long long*)(YPB + ((size_t)sl * 2048 + (pos - 32768)) * DM) + lane;
#pragma unroll
                                    for (int j = 0; j < 4; ++j) tp[sl][j] = y[64 * j]; }
#pragma unroll
                                for (int sl = 0; sl < 7; ++sl) {
#pragma unroll
                                    for (int j = 0; j < 4; ++j) ADD4(v[j], tp[sl][j]); } } }
#pragma unroll
                        for (int j = 0; j < 4; ++j) s += (v[j].x * v[j].x + v[j].y * v[j].y) + (v[j].z * v[j].z + v[j].w * v[j].w);
                        const float rstd = 1.f / sqrtf(wave_sum(s) * (1.f / DM) + EPS);
#pragma unroll
                        for (int j = 0; j < 4; ++j) xr[64 * j] = v[j] * rstd * gv[j]; } }
            }
        }
#undef ADD4
        PE(PH_FINAL)
    }
#undef IN
}

#undef ws
#undef ctl
#undef X
extern "C" void kernel_launch(void* const* d_in, const int* in_sizes, int n_in, void* d_out, int out_size, void* d_ws, size_t ws_size, hipStream_t stream) {
    static int grid = 0;
    if (grid == 0) {
        if (n_in != 20 || in_sizes[0] != MT * DM || out_size != MT * DM || ws_size < WS_END) { fprintf(stderr, "kernel_launch: unexpected shapes / workspace (n_in %d, ws %zu < %zu); nothing launched\n", n_in, ws_size, (size_t)WS_END); grid = -1; return; }
        int dev = 0, cus = 0;
        if (hipGetDevice(&dev) != hipSuccess || hipDeviceGetAttribute(&cus, hipDeviceAttributeMultiprocessorCount, dev) != hipSuccess) { grid = -1; return; }
        if (hipFuncSetAttribute((const void*)mk_fwd, hipFuncAttributeMaxDynamicSharedMemorySize, LDS_BYTES) != hipSuccess) { fprintf(stderr, "kernel_launch: hipFuncSetAttribute failed\n"); grid = -1; return; }
        int per_cu = 0;
        if (hipOccupancyMaxActiveBlocksPerMultiprocessor(&per_cu, (const void*)mk_fwd, NWAVES * 64, LDS_BYTES) != hipSuccess || per_cu < 1) { fprintf(stderr, "kernel_launch: occupancy query reports %d workgroups per CU for %d B of LDS; the grid would not be resident; nothing launched\n", per_cu, LDS_BYTES); grid = -1; return; }
        (void)hipGetLastError();
        grid = cus;
    }
    if (grid < 0) return;
    (void)hipMemsetAsync((char*)d_ws + WS_CTL, 0, CTL_ZERO_BYTES, stream);
    Args a{};
    for (int i = 0; i < 20; ++i) a.in[i] = (const float*)d_in[i];
    a.out = (float*)d_out; a.ws = (unsigned char*)d_ws;
    auto run = [&](int lo, int hi) { a.ph_lo = lo; a.ph_hi = hi; hipLaunchKernelGGL(mk_fwd, dim3(grid), dim3(NWAVES * 64), LDS_BYTES, stream, a); };
    run(PH_PRO, PH_N);
}
```
